# Optimizing an MI355X kernel written in HIP

```python
import math
import jax, jax.numpy as jnp
from jax import lax
import numpy as np

D_MODEL = 4096
BATCH = 4
SEQ = 2048
DEPTH = 1
DEC_BATCH = 128
DEC_SEQ = 8
PAST_LEN = 8192
PAGE_SIZE = 128

RWKV_HEADS = 32
RWKV_HEAD_SIZE = 64
RWKV_W = RWKV_HEADS * RWKV_HEAD_SIZE
DECAY_LORA = 128
AAA_LORA = 128
SHIFT_W = 3 * RWKV_W + DECAY_LORA + AAA_LORA
GN_EPS = 64e-5
N_Q_HEADS = 32
N_KV_HEADS = 4
HEAD_DIM = 64
GROUP = N_Q_HEADS // N_KV_HEADS
ATT_W = N_Q_HEADS * HEAD_DIM
KV_W = N_KV_HEADS * HEAD_DIM
WINDOW = 128
ROT_DIM = HEAD_DIM // 4
ROPE_THETA = 500000.0
_OFF_SHIFT = SHIFT_W
_OFF_GR = _OFF_SHIFT + RWKV_W
_OFF_Q = _OFF_GR + ATT_W
_OFF_K = _OFF_Q + KV_W
_OFF_V = _OFF_K + KV_W
_OFF_GA = _OFF_V + ATT_W
IN_SPLITS = (_OFF_SHIFT, _OFF_GR, _OFF_Q, _OFF_K, _OFF_V, _OFF_GA)
N_IN = _OFF_GA + 2 * D_MODEL
ALPHA = (2.0 * DEPTH) ** 0.25
BETA = (8.0 * DEPTH) ** -0.25
LN_EPS = 1e-5

kernel_name = "rwkv7_swa_sink_gated_hybrid_step"


def _layernorm(h, g, b):
    hf = h.astype(jnp.float32)
    m = hf.mean(-1, keepdims=True)
    var = jnp.square(hf - m).mean(-1, keepdims=True)
    return ((hf - m) * lax.rsqrt(var + LN_EPS) * g.astype(jnp.float32) + b.astype(jnp.float32)).astype(h.dtype)


def _rope_partial(x, pos):
    half = ROT_DIM // 2
    inv = ROPE_THETA ** (-jnp.arange(half, dtype=jnp.float32) * 2.0 / ROT_DIM)
    ang = pos.astype(jnp.float32)[:, None] * inv[None, :]
    cos = jnp.cos(ang)[:, None, :].astype(x.dtype)
    sin = jnp.sin(ang)[:, None, :].astype(x.dtype)
    x1, x2, rest = x[..., :half], x[..., half:ROT_DIM], x[..., ROT_DIM:]
    return jnp.concatenate([x1 * cos - x2 * sin, x2 * cos + x1 * sin, rest], axis=-1)


def _sink_attention(q, k, v, mask, sinks):
    qg = q.reshape(q.shape[:-2] + (N_KV_HEADS, GROUP, HEAD_DIM))
    s = jnp.einsum("...qhgd,...shd->...hgqs", qg, k).astype(jnp.float32) / math.sqrt(HEAD_DIM)
    s = jnp.where(mask[..., None, None, :, :], s, -1e30)
    sink = jnp.broadcast_to(sinks.astype(jnp.float32).reshape(N_KV_HEADS, GROUP, 1, 1), s.shape[:-1] + (1,))
    p = jax.nn.softmax(jnp.concatenate([s, sink], axis=-1), axis=-1)[..., :-1].astype(v.dtype)
    o = jnp.einsum("...hgqs,...shd->...qhgd", p, v)
    return o.reshape(o.shape[:-3] + (ATT_W,))


def _window_attention_prompt(q, k, v, sinks):
    B, T = q.shape[0], q.shape[1]
    nb = T // WINDOW
    qb = q.reshape(B, nb, WINDOW, N_Q_HEADS, HEAD_DIM)
    kb = k.reshape(B, nb, WINDOW, N_KV_HEADS, HEAD_DIM)
    vb = v.reshape(B, nb, WINDOW, N_KV_HEADS, HEAD_DIM)
    prev = lambda t: jnp.concatenate([jnp.zeros_like(t[:, :1]), t[:, :-1]], axis=1)
    kcat = jnp.concatenate([prev(kb), kb], axis=2)
    vcat = jnp.concatenate([prev(vb), vb], axis=2)
    qi = jnp.arange(WINDOW)[:, None]
    kj = jnp.arange(2 * WINDOW)[None, :]
    rel = WINDOW + qi - kj
    band = (rel >= 0) & (rel < WINDOW)
    valid = (jnp.arange(nb)[:, None, None] > 0) | (kj >= WINDOW)[None]
    mask = band[None] & valid
    o = _sink_attention(qb, kcat, vcat, mask, sinks)
    return o.reshape(B, T, ATT_W)


def _window_attention_sample(q, k_new, v_new, win_k, win_v, sinks):
    T = q.shape[1]
    kcat = jnp.concatenate([win_k.astype(k_new.dtype), k_new], axis=1)
    vcat = jnp.concatenate([win_v.astype(v_new.dtype), v_new], axis=1)
    qpos = jnp.arange(T) + WINDOW
    kpos = jnp.arange(WINDOW + T)
    rel = qpos[:, None] - kpos[None, :]
    mask = (rel >= 0) & (rel < WINDOW)
    o = _sink_attention(q, kcat, vcat, mask, sinks)
    return o, kcat[:, -WINDOW:], vcat[:, -WINDOW:]


def _rwkv7_branch(zs, g, shift_prev, S0, mu, w0, w_up, a0, a_up, k_k, k_a, r_k, gn_w, gn_b):
    B, T = zs.shape[0], zs.shape[1]
    prev = jnp.concatenate([shift_prev[:, None].astype(zs.dtype), zs[:, :-1]], axis=1)
    xs = zs + mu * (prev - zs)
    r, k, v, wd, ad = jnp.split(xs, [RWKV_W, 2 * RWKV_W, 3 * RWKV_W, 3 * RWKV_W + DECAY_LORA], axis=-1)
    wlog = -jax.nn.softplus(-(w0 + jnp.tanh(wd) @ w_up).astype(jnp.float32)) - 0.5
    decay = jnp.exp(-jnp.exp(wlog))
    a = jax.nn.sigmoid((a0 + ad @ a_up).astype(jnp.float32))
    heads = lambda t: t.astype(jnp.float32).reshape(B, T, RWKV_HEADS, RWKV_HEAD_SIZE)
    r_h, k_h, v_h, dec_h, a_h = heads(r), heads(k), heads(v), heads(decay), heads(a)
    kk = heads(k * k_k)
    kk = kk / jnp.maximum(jnp.sqrt(jnp.sum(kk * kk, axis=-1, keepdims=True)), 1e-12)
    k_h = k_h * (1.0 + (a_h - 1.0) * k_a.astype(jnp.float32).reshape(RWKV_HEADS, RWKV_HEAD_SIZE))

    def step(S, inp):
        r_t, k_t, v_t, w_t, kk_t, a_t = inp
        sa = jnp.einsum("bhvk,bhk->bhv", S, -kk_t)
        S = S * w_t[:, :, None, :] + sa[..., None] * (kk_t * a_t)[:, :, None, :] + v_t[..., None] * k_t[:, :, None, :]
        return S, jnp.einsum("bhvk,bhk->bhv", S, r_t)

    tm = lambda t: jnp.swapaxes(t, 0, 1)
    S_fin, ys = lax.scan(step, S0.astype(jnp.float32), (tm(r_h), tm(k_h), tm(v_h), tm(dec_h), tm(kk), tm(a_h)))
    y = tm(ys)
    m = y.mean(-1, keepdims=True)
    var = jnp.square(y - m).mean(-1, keepdims=True)
    y = ((y - m) * lax.rsqrt(var + GN_EPS)).reshape(B, T, RWKV_W) * gn_w.astype(jnp.float32) + gn_b.astype(jnp.float32)
    bonus = (jnp.sum(r_h * k_h * r_k.astype(jnp.float32), axis=-1, keepdims=True) * v_h).reshape(B, T, RWKV_W)
    out = (y + bonus).astype(zs.dtype) * jax.nn.silu(g)
    return out, S_fin.astype(S0.dtype), zs[:, -1]


def _hybrid_layer(x, pos, S0, shift0, win_k, win_v, p):
    (w_in, mu_shift, w0, w_decay_up, a0, w_aaa_up, k_k, k_a, r_k, gn_w, gn_b,
     sinks, w_branch_rwkv, w_branch_attn, w_out, ln_g, ln_b) = p
    B, T = x.shape[0], x.shape[1]
    z = jnp.einsum("btd,dn->btn", x, w_in)
    zs, g_r, q, k, v, g_a, gates = jnp.split(z, IN_SPLITS, axis=-1)
    y_r, S_new, shift_new = _rwkv7_branch(zs, g_r, shift0, S0, mu_shift, w0, w_decay_up, a0, w_aaa_up,
                                          k_k, k_a, r_k, gn_w, gn_b)
    q = _rope_partial(q.reshape(B, T, N_Q_HEADS, HEAD_DIM), pos)
    k = _rope_partial(k.reshape(B, T, N_KV_HEADS, HEAD_DIM), pos)
    v = v.reshape(B, T, N_KV_HEADS, HEAD_DIM)
    if win_k is None:
        o = _window_attention_prompt(q, k, v, sinks)
        k_buf, v_buf = k[:, -WINDOW:], v[:, -WINDOW:]
    else:
        o, k_buf, v_buf = _window_attention_sample(q, k, v, win_k, win_v, sinks)
    y_a = o * jax.nn.silu(g_a)
    m_r, m_a = jnp.split(gates, 2, axis=-1)
    mix = jax.nn.sigmoid(m_r) * (y_r @ w_branch_rwkv) + jax.nn.sigmoid(m_a) * (y_a @ w_branch_attn)
    out = mix @ w_out
    y = _layernorm(ALPHA * x + out, ln_g, ln_b)
    return y, S_new, shift_new, k_buf, v_buf


def setup_inputs(seed: int = 0) -> dict:
    key = jax.random.key(seed)
    ks = jax.random.split(key, 24)
    nrm = jax.random.normal
    L = DEPTH
    return {
        "x_prompt": nrm(ks[0], (BATCH, SEQ, D_MODEL), jnp.float32),
        "x_sample": nrm(ks[1], (DEC_BATCH, DEC_SEQ, D_MODEL), jnp.float32),
        "state_wkv": 0.2 * nrm(ks[2], (L, DEC_BATCH, RWKV_HEADS, RWKV_HEAD_SIZE, RWKV_HEAD_SIZE), jnp.float32),
        "state_shift": nrm(ks[3], (L, DEC_BATCH, SHIFT_W), jnp.float32),
        "cache_win_k": nrm(ks[4], (L, DEC_BATCH, WINDOW, N_KV_HEADS, HEAD_DIM), jnp.float32),
        "cache_win_v": nrm(ks[5], (L, DEC_BATCH, WINDOW, N_KV_HEADS, HEAD_DIM), jnp.float32),
        "w_in": nrm(ks[6], (L, D_MODEL, N_IN), jnp.float32) * D_MODEL ** -0.5,
        "mu_shift": jax.random.uniform(ks[7], (L, SHIFT_W), jnp.float32),
        "w0": jax.random.uniform(ks[8], (L, RWKV_W), jnp.float32, minval=-4.0, maxval=1.0),
        "w_decay_up": 0.5 * nrm(ks[9], (L, DECAY_LORA, RWKV_W), jnp.float32) * DECAY_LORA ** -0.5,
        "a0": 0.1 * nrm(ks[10], (L, RWKV_W), jnp.float32),
        "w_aaa_up": 0.5 * nrm(ks[11], (L, AAA_LORA, RWKV_W), jnp.float32) * AAA_LORA ** -0.5,
        "k_k": 0.85 + 0.05 * nrm(ks[12], (L, RWKV_W), jnp.float32),
        "k_a": 1.0 + 0.05 * nrm(ks[13], (L, RWKV_W), jnp.float32),
        "r_k": 0.1 * nrm(ks[14], (L, RWKV_HEADS, RWKV_HEAD_SIZE), jnp.float32),
        "gn_w": 1.0 + 0.05 * nrm(ks[15], (L, RWKV_W), jnp.float32),
        "gn_b": 0.02 * nrm(ks[16], (L, RWKV_W), jnp.float32),
        "sinks": 0.5 * nrm(ks[17], (L, N_Q_HEADS), jnp.float32),
        "w_branch_rwkv": nrm(ks[18], (L, RWKV_W, D_MODEL), jnp.float32) * RWKV_W ** -0.5 * BETA,
        "w_branch_attn": nrm(ks[19], (L, ATT_W, D_MODEL), jnp.float32) * ATT_W ** -0.5 * BETA,
        "w_out": nrm(ks[20], (L, D_MODEL, D_MODEL), jnp.float32) * D_MODEL ** -0.5 * BETA,
        "ln_g": 1.0 + 0.05 * nrm(ks[21], (L, D_MODEL), jnp.float32),
        "ln_b": 0.02 * nrm(ks[22], (L, D_MODEL), jnp.float32),
    }


def reference(x_prompt, x_sample, state_wkv, state_shift, cache_win_k, cache_win_v,
              w_in, mu_shift, w0, w_decay_up, a0, w_aaa_up, k_k, k_a, r_k, gn_w, gn_b,
              sinks, w_branch_rwkv, w_branch_attn, w_out, ln_g, ln_b):
    Bp, Tp = x_prompt.shape[0], x_prompt.shape[1]
    Ts = x_sample.shape[1]
    past = state_wkv.shape[0] * 0 + PAST_LEN
    pos_p = jnp.arange(Tp)
    pos_s = past + jnp.arange(Ts)
    yp, ys = x_prompt, x_sample
    wkv_p, sh_p, kp_l, vp_l, wkv_s, sh_s, ks_l, vs_l = [], [], [], [], [], [], [], []
    for l in range(DEPTH):
        p = (w_in[l], mu_shift[l], w0[l], w_decay_up[l], a0[l], w_aaa_up[l], k_k[l], k_a[l], r_k[l],
             gn_w[l], gn_b[l], sinks[l], w_branch_rwkv[l], w_branch_attn[l], w_out[l], ln_g[l], ln_b[l])
        S0 = jnp.zeros((Bp, RWKV_HEADS, RWKV_HEAD_SIZE, RWKV_HEAD_SIZE), x_prompt.dtype)
        sh0 = jnp.zeros((Bp, SHIFT_W), x_prompt.dtype)
        yp, a1, a2, a3, a4 = _hybrid_layer(yp, pos_p, S0, sh0, None, None, p)
        ys, b1, b2, b3, b4 = _hybrid_layer(ys, pos_s, state_wkv[l], state_shift[l], cache_win_k[l], cache_win_v[l], p)
        wkv_p.append(a1); sh_p.append(a2); kp_l.append(a3); vp_l.append(a4)
        wkv_s.append(b1); sh_s.append(b2); ks_l.append(b3); vs_l.append(b4)
    new_wkv_p = jnp.stack(wkv_p)
    new_shift_p = jnp.stack(sh_p)
    new_k_p = jnp.stack(kp_l)
    new_v_p = jnp.stack(vp_l)
    new_wkv_s = jnp.stack(wkv_s)
    new_shift_s = jnp.stack(sh_s)
    new_k_s = jnp.stack(ks_l)
    new_v_s = jnp.stack(vs_l)
    return (yp, ys, new_wkv_p, new_shift_p, new_k_p, new_v_p, new_wkv_s, new_shift_s, new_k_s, new_v_s)
```

```cpp
#include <hip/hip_runtime.h>
#include <hip/hip_cooperative_groups.h>
#include <cstdio>
#include <cstdint>
namespace cg = cooperative_groups;

#ifndef MK_FUSED
#define MK_FUSED 0
#endif

#define LAS __attribute__((address_space(3)))
typedef unsigned short bf16_t;
typedef short bf16x8 __attribute__((ext_vector_type(8)));
typedef short s16x4 __attribute__((ext_vector_type(4)));
typedef float f32x4 __attribute__((ext_vector_type(4)));
typedef float f32x2 __attribute__((ext_vector_type(2)));
typedef unsigned u32x4 __attribute__((ext_vector_type(4)));
typedef unsigned u32x2 __attribute__((ext_vector_type(2)));

constexpr int D = 4096, M_P = 8192, M_S = 1024, M = M_P + M_S;
constexpr int TP = 2048, TS = 8, NB_S = 128, NB_P = 4;
constexpr int NZ = 21248, LDZ = NZ;
constexpr int RW = 2048, SHIFT_W = 6400, NH = 32, HS = 64;
constexpr int OFF_WD = 6144, OFF_GR = 6400, OFF_Q = 8448, OFF_K = 10496, OFF_V = 10752, OFF_GA = 11008, OFF_MR = 13056, OFF_MA = 17152;
constexpr float ALPHA = 1.189207115002721f;
constexpr float LN_EPS = 1e-5f, GN_EPS = 64e-5f;
constexpr size_t O_Y = 0, O_WKVP = 37748736, O_SHP = 38273024, O_WKP = 38298624, O_WVP = 38429696, O_WKVS = 38560768, O_SHS = 55337984, O_WKS = 56157184, O_WVS = 60351488, O_END = 64545792;
constexpr size_t al1m(size_t x) { return (x + ((1u << 20) - 1)) & ~(size_t)((1u << 20) - 1); }
constexpr size_t WS_ROPE = 1u << 20;
constexpr size_t WS_XB = 2u << 20;
constexpr size_t WS_W1T = al1m(WS_XB + (size_t)M * D * 2);
constexpr size_t WS_W2T = al1m(WS_W1T + (size_t)NZ * D * 2);
constexpr size_t WS_W3T = al1m(WS_W2T + (size_t)D * D * 2);
constexpr size_t WS_WLT = al1m(WS_W3T + (size_t)D * D * 2);
constexpr size_t WS_Z = al1m(WS_WLT + (size_t)4096 * 256 * 2);
constexpr size_t WS_AL = al1m(WS_Z + (size_t)M * NZ * 2);
constexpr size_t WS_DW = al1m(WS_AL + (size_t)M * 256 * 2);
constexpr size_t WS_AA = al1m(WS_DW + (size_t)M * 2048 * 4);
constexpr size_t WS_Y = al1m(WS_AA + (size_t)M * 2048 * 4);
constexpr size_t WS_MIX = al1m(WS_Y + (size_t)M * D * 2);
constexpr size_t WS_END = al1m(WS_MIX + (size_t)M * D * 2);

constexpr int LDS_BYTES = 147456;
constexpr int NTHREADS = 512;

__device__ __forceinline__ unsigned f2bf(float f) { unsigned u = __builtin_bit_cast(unsigned, f); return (u + 0x7fffu + ((u >> 16) & 1u)) >> 16; }
__device__ __forceinline__ float bf2f(unsigned short b) { return __builtin_bit_cast(float, ((unsigned)b) << 16); }
__device__ __forceinline__ float bfs2f(short b) { return __builtin_bit_cast(float, ((unsigned)(unsigned short)b) << 16); }
__device__ __forceinline__ unsigned pk2(float lo, float hi) { return f2bf(lo) | (f2bf(hi) << 16); }
__device__ __forceinline__ float wave_sum(float v) {
#pragma unroll
    for (int o = 1; o < 64; o <<= 1) v += __shfl_xor(v, o);
    return v;
}
__device__ __forceinline__ float sigmoidf_(float x) { return 1.0f / (1.0f + __expf(-x)); }
#define LDS_WAIT() asm volatile("s_waitcnt lgkmcnt(0)" ::: "memory")
#define VM_WAIT() asm volatile("s_waitcnt vmcnt(0)" ::: "memory")

namespace pg8 {
constexpr int BM = 256, BK = 64, HALF = 128, HTB = HALF * BK * 2  , STAGE_BYTES = 8 * HTB, NXCD = 8, WGM = 8;
__host__ __device__ __forceinline__ int lds_byte(int r, int c) { const int st = (r >> 4) * 2 + (c >> 5), rr = r & 15, cc = c & 31, ob = rr * 64 + cc * 2; return st * 1024 + (ob ^ (((ob >> 9) & 1) << 5)); }
__host__ __device__ __forceinline__ void stage_rc(int b, int& R, int& C) { const int st = b / 1024, sb = b % 1024, swz = sb ^ (((sb >> 9) & 1) << 5); R = (st >> 1) * 16 + swz / 64; C = (st & 1) * 32 + (swz % 64) / 2; }
__host__ __device__ __forceinline__ int perm32(int rho) { const int n = rho >> 4, i = rho & 15; return 8 * (i >> 2) + 4 * n + (i & 3); }

struct Unit { int pm, pn, kt0, mode; };
struct Gemm { const bf16_t* A; const bf16_t* Bt; int lda, ldb, nt; };

struct TileOrder {
    int nM, nN, nwg, G, c, halves, nth;
    __device__ void init(int M_, int N_, int G_, int c_, int halves_, int nth_) { nM = M_ / BM; nN = N_ / BM; nwg = nM * nN; G = G_; c = c_; halves = halves_; nth = nth_; }
    __device__ bool next(int i, Unit& u) const {
        const int ti = (halves == 2) ? (i >> 1) : i, hf = (halves == 2) ? (i & 1) : 0;
        const long L = (long)ti * G + c; if (L >= nwg) return false;
        int wgid = (int)L; { const int q = nwg / NXCD, r = nwg % NXCD, xcd = wgid % NXCD, off = wgid / NXCD; wgid = (xcd < r ? xcd * (q + 1) : r * (q + 1) + (xcd - r) * q) + off; }
        const int nig = WGM * nN, gid = wgid / nig, fm = gid * WGM, gsz = (nM - fm) < WGM ? (nM - fm) : WGM;
        u.pm = fm + ((wgid % nig) % gsz); u.pn = (wgid % nig) / gsz; u.kt0 = hf * nth; u.mode = (halves == 2) ? hf : 2; return true;
    }
};

__device__ __forceinline__ unsigned cvt_pk_bf16(float lo, float hi) { unsigned r; asm volatile("v_cvt_pk_bf16_f32 %0, %1, %2" : "=v"(r) : "v"(lo), "v"(hi)); return r; }

template <class Epi, bool ALIGN_EPI, bool SP2>
__device__ __forceinline__ void gemm_phase(LAS unsigned char* lds, const Gemm g, const TileOrder& S, const Epi& E) {
    const int tid = threadIdx.x, wid = __builtin_amdgcn_readfirstlane(tid >> 6), lane = tid & 63, wr = wid >> 2, wc = wid & 3, fr = lane & 15, fq = lane >> 4;
    const int nt = g.nt;
    unsigned voffA[2], voffB[2];
#pragma unroll
    for (int i = 0; i < 2; ++i) { int R, C; stage_rc(tid * 16 + i * 8192, R, C); const int Rb = Epi::PERM ? ((R & ~31) + perm32(R & 31)) : R;
        voffA[i] = (unsigned)(R * g.lda + C) * 2u; voffB[i] = (unsigned)(Rb * g.ldb + C) * 2u; }
    const size_t kstep = (size_t)(BK * 2);
    const size_t hstepA = (size_t)HALF * g.lda * 2, hstepB = (size_t)HALF * g.ldb * 2;
    const size_t tstepA = 2 * hstepA, tstepB = 2 * hstepB;
    const unsigned ldsw = (unsigned)wid * 1024u;
    const int aoff = lds_byte(wr * 64 + fr, fq * 8), boff = lds_byte(wc * 32 + fr, fq * 8);
#define PG8_SA(b, h) (((b) * 2 + (h)) * HTB)
#define PG8_SB(b, h) ((4 + (b) * 2 + (h)) * HTB)
#define PG8_STAGE(bufoff, gbase, voff) do { _Pragma("unroll") for (int _i = 0; _i < 2; ++_i) \
        __builtin_amdgcn_global_load_lds((const unsigned*)((const char*)(gbase) + (voff)[_i]), (LAS unsigned*)(lds + (bufoff) + ldsw + _i * 8192), 16, 0, 0); } while (0)
#define PG8_LDA(dst, b, h) do { _Pragma("unroll") for (int m = 0; m < 4; ++m) _Pragma("unroll") for (int k = 0; k < 2; ++k) dst[m][k] = *(const LAS bf16x8*)(lds + PG8_SA(b, h) + aoff + m * 2048 + k * 1024); } while (0)
#define PG8_LDB(dst, b, h) do { _Pragma("unroll") for (int n = 0; n < 2; ++n) _Pragma("unroll") for (int k = 0; k < 2; ++k) dst[n][k] = *(const LAS bf16x8*)(lds + PG8_SB(b, h) + boff + n * 2048 + k * 1024); } while (0)
#define PG8_MMA(ai, bj, At, Bt) do { __builtin_amdgcn_s_setprio(1); _Pragma("unroll") for (int m = 0; m < 4; ++m) _Pragma("unroll") for (int n = 0; n < 2; ++n) _Pragma("unroll") for (int k = 0; k < 2; ++k) \
        acc[ai][bj][m][n] = __builtin_amdgcn_mfma_f32_16x16x32_bf16(Bt[n][k], At[m][k], acc[ai][bj][m][n], 0, 0, 0); __builtin_amdgcn_s_setprio(0); } while (0)
#define PG8_WAIT_V(n) asm volatile("s_waitcnt vmcnt(" #n ")" ::: "memory")
#define PG8_WAIT_L(n) asm volatile("s_waitcnt lgkmcnt(" #n ")" ::: "memory")
#define PG8_BAR __builtin_amdgcn_s_barrier()
#define PG8_SCHED __builtin_amdgcn_sched_barrier(0)
    Unit cur, nxt; int ui = 0;
    if (!S.next(0, cur)) return;
    f32x4 acc[2][2][4][2];
#pragma unroll
    for (int a = 0; a < 2; ++a)
#pragma unroll
        for (int b = 0; b < 2; ++b)
#pragma unroll
            for (int m = 0; m < 4; ++m)
#pragma unroll
                for (int n = 0; n < 2; ++n) acc[a][b][m][n] = (f32x4){0.f, 0.f, 0.f, 0.f};
    bf16x8 At[4][2], B0[2][2], B1[2][2];
    const char* cA = (const char*)g.A + (size_t)cur.pm * tstepA + (size_t)cur.kt0 * kstep; const char* cB = (const char*)g.Bt + (size_t)cur.pn * tstepB + (size_t)cur.kt0 * kstep;
    if constexpr (SP2) {
        PG8_STAGE(PG8_SB(0, 0), cB, voffB); PG8_STAGE(PG8_SB(0, 1), cB + hstepB, voffB); PG8_STAGE(PG8_SA(0, 0), cA, voffA); PG8_STAGE(PG8_SA(0, 1), cA + hstepA, voffA);
        if (wr == 1) PG8_BAR;
        PG8_WAIT_V(2); PG8_BAR;
        PG8_STAGE(PG8_SB(1, 0), cB + kstep, voffB); PG8_STAGE(PG8_SA(1, 0), cA + kstep, voffA); PG8_STAGE(PG8_SB(1, 1), cB + hstepB + kstep, voffB);
        PG8_WAIT_V(6); PG8_BAR;
    } else {
        PG8_STAGE(PG8_SB(0, 0), cB, voffB); PG8_STAGE(PG8_SA(0, 0), cA, voffA); PG8_STAGE(PG8_SB(0, 1), cB + hstepB, voffB); PG8_STAGE(PG8_SA(0, 1), cA + hstepA, voffA);
        if (wr == 1) PG8_BAR;
        PG8_WAIT_V(4); PG8_BAR;
        PG8_STAGE(PG8_SB(1, 0), cB + kstep, voffB); PG8_STAGE(PG8_SA(1, 0), cA + kstep, voffA); PG8_STAGE(PG8_SB(1, 1), cB + hstepB + kstep, voffB);
        PG8_WAIT_V(6); PG8_BAR;
    }
    for (;;) {
        const bool has_next = S.next(ui + 1, nxt);
        const char* nA = has_next ? (const char*)g.A + (size_t)nxt.pm * tstepA + (size_t)nxt.kt0 * kstep : cA; const char* nB = has_next ? (const char*)g.Bt + (size_t)nxt.pn * tstepB + (size_t)nxt.kt0 * kstep : cB;
        for (int t = 0; t < nt; t += 2) {
            const bool last = (t == nt - 2);
            const char* a1 = cA + (size_t)(t + 1) * kstep;
            const char* a2 = last ? nA : cA + (size_t)(t + 2) * kstep; const char* b2 = last ? nB : cB + (size_t)(t + 2) * kstep;
            const char* a3 = a2 + kstep; const char* b3 = b2 + kstep;
            if constexpr (SP2) {
            PG8_LDB(B0, 0, 0); PG8_LDB(B1, 0, 1); PG8_SCHED; PG8_LDA(At, 0, 0); PG8_STAGE(PG8_SA(1, 1), a1 + hstepA, voffA);
            PG8_WAIT_V(8); PG8_WAIT_L(0); PG8_BAR; PG8_MMA(0, 0, At, B0); PG8_MMA(0, 1, At, B1); PG8_BAR; PG8_SCHED;
            PG8_LDA(At, 0, 1); PG8_STAGE(PG8_SB(0, 0), b2, voffB); PG8_STAGE(PG8_SB(0, 1), b2 + hstepB, voffB); PG8_STAGE(PG8_SA(0, 0), a2, voffA);
            PG8_WAIT_V(8); PG8_WAIT_L(0); PG8_BAR; PG8_MMA(1, 0, At, B0); PG8_MMA(1, 1, At, B1); PG8_BAR; PG8_SCHED;
            PG8_LDB(B0, 1, 0); PG8_LDB(B1, 1, 1); PG8_SCHED; PG8_LDA(At, 1, 0); PG8_STAGE(PG8_SA(0, 1), a2 + hstepA, voffA);
            PG8_WAIT_V(8); PG8_WAIT_L(0); PG8_BAR; PG8_MMA(0, 0, At, B0); PG8_MMA(0, 1, At, B1); PG8_BAR; PG8_SCHED;
            PG8_LDA(At, 1, 1); PG8_STAGE(PG8_SB(1, 0), b3, voffB); PG8_STAGE(PG8_SB(1, 1), b3 + hstepB, voffB); PG8_STAGE(PG8_SA(1, 0), a3, voffA);
            PG8_WAIT_V(8); PG8_WAIT_L(0); PG8_BAR; PG8_MMA(1, 0, At, B0); PG8_MMA(1, 1, At, B1); PG8_BAR; PG8_SCHED;
            } else {
            PG8_LDB(B0, 0, 0); PG8_SCHED; PG8_LDA(At, 0, 0); PG8_STAGE(PG8_SA(1, 1), a1 + hstepA, voffA);
            PG8_WAIT_L(8); PG8_BAR; PG8_WAIT_L(0); PG8_MMA(0, 0, At, B0); PG8_BAR; PG8_SCHED;
            PG8_LDB(B1, 0, 1); PG8_STAGE(PG8_SB(0, 0), b2, voffB);
            PG8_BAR; PG8_WAIT_L(0); PG8_MMA(0, 1, At, B1); PG8_BAR;
            PG8_LDA(At, 0, 1); PG8_STAGE(PG8_SA(0, 0), a2, voffA);
            PG8_BAR; PG8_WAIT_L(0); PG8_MMA(1, 0, At, B0); PG8_BAR; PG8_SCHED;
            PG8_STAGE(PG8_SB(0, 1), b2 + hstepB, voffB);
            PG8_WAIT_V(6); PG8_BAR; PG8_MMA(1, 1, At, B1); PG8_BAR;
            PG8_LDB(B0, 1, 0); PG8_SCHED; PG8_LDA(At, 1, 0); PG8_STAGE(PG8_SA(0, 1), a2 + hstepA, voffA);
            PG8_WAIT_L(8); PG8_BAR; PG8_WAIT_L(0); PG8_MMA(0, 0, At, B0); PG8_BAR; PG8_SCHED;
            PG8_LDB(B1, 1, 1); PG8_STAGE(PG8_SB(1, 0), b3, voffB);
            PG8_BAR; PG8_WAIT_L(0); PG8_MMA(0, 1, At, B1); PG8_BAR;
            PG8_LDA(At, 1, 1); PG8_STAGE(PG8_SA(1, 0), a3, voffA);
            PG8_BAR; PG8_WAIT_L(0); PG8_MMA(1, 0, At, B0); PG8_BAR; PG8_SCHED;
            PG8_STAGE(PG8_SB(1, 1), b3 + hstepB, voffB);
            PG8_WAIT_V(6); PG8_BAR; PG8_MMA(1, 1, At, B1); PG8_BAR;
            }
        }
        if constexpr (ALIGN_EPI) { if (wr == 0) PG8_BAR; }
        E(acc, cur, wr, wc, fr, fq);
        if (!has_next) break;
        if (cur.mode != 0) {
#pragma unroll
        for (int a = 0; a < 2; ++a)
#pragma unroll
            for (int b = 0; b < 2; ++b)
#pragma unroll
                for (int m = 0; m < 4; ++m)
#pragma unroll
                    for (int n = 0; n < 2; ++n) acc[a][b][m][n] = (f32x4){0.f, 0.f, 0.f, 0.f};
        }
        cur = nxt; cA = nA; cB = nB; ++ui;
        if constexpr (ALIGN_EPI) { if (wr == 1) PG8_BAR; }
    }
    PG8_WAIT_V(0);
    if constexpr (!ALIGN_EPI) { if (wr == 0) PG8_BAR; }
    PG8_BAR;
#undef PG8_SA
#undef PG8_SB
#undef PG8_STAGE
#undef PG8_LDA
#undef PG8_LDB
#undef PG8_MMA
#undef PG8_WAIT_V
#undef PG8_WAIT_L
#undef PG8_BAR
#undef PG8_SCHED
}

struct EpiZ {
    static constexpr bool PERM = true;
    bf16_t* O; int ldc;
    __device__ __forceinline__ void operator()(f32x4 (&acc)[2][2][4][2], const Unit& u, int wr, int wc, int fr, int fq) const {
        const int row0 = u.pm * BM + wr * 64 + fr, col0 = u.pn * BM + wc * 32 + 8 * fq;
#pragma unroll
        for (int ai = 0; ai < 2; ++ai)
#pragma unroll
            for (int m = 0; m < 4; ++m) { bf16_t* rowp = O + (size_t)(row0 + ai * HALF + m * 16) * ldc + col0;
#pragma unroll
                for (int bj = 0; bj < 2; ++bj) { const f32x4 v0 = acc[ai][bj][m][0], v1 = acc[ai][bj][m][1];
                    u32x4 w; w.x = cvt_pk_bf16(v0[0], v0[1]); w.y = cvt_pk_bf16(v0[2], v0[3]); w.z = cvt_pk_bf16(v1[0], v1[1]); w.w = cvt_pk_bf16(v1[2], v1[3]);
                    *(u32x4*)(rowp + bj * HALF) = w; } }
    }
};
struct EpiLora {
    static constexpr bool PERM = false;
    float* DW; float* AA; const float* w0; const float* a0;
    __device__ __forceinline__ void operator()(f32x4 (&acc)[2][2][4][2], const Unit& u, int wr, int wc, int fr, int fq) const {
        const int row0 = u.pm * BM + wr * 64 + fr; const bool isw = u.pn < 8; const int colt = (isw ? u.pn : u.pn - 8) * BM + wc * 32 + 4 * fq;
        float* outp = isw ? DW : AA; const float* bias = isw ? w0 : a0;
        f32x4 bv[2][2];
#pragma unroll
        for (int bj = 0; bj < 2; ++bj)
#pragma unroll
            for (int n = 0; n < 2; ++n) bv[bj][n] = *(const f32x4*)(bias + colt + bj * HALF + n * 16);
#pragma unroll
        for (int ai = 0; ai < 2; ++ai)
#pragma unroll
            for (int m = 0; m < 4; ++m) { float* rowp = outp + (size_t)(row0 + ai * HALF + m * 16) * RW + colt;
#pragma unroll
                for (int bj = 0; bj < 2; ++bj)
#pragma unroll
                    for (int n = 0; n < 2; ++n) { const f32x4 x = acc[ai][bj][m][n] + bv[bj][n]; f32x4 o;
#pragma unroll
                        for (int j = 0; j < 4; ++j) { const float sg = 1.0f / (1.0f + __expf(-x[j])); o[j] = isw ? __expf(-0.6065306597126334f * sg) : sg; }
                        *(f32x4*)(rowp + bj * HALF + n * 16) = o; } }
    }
};
struct EpiMix {
    static constexpr bool PERM = true;
    const bf16_t* Z; bf16_t* O;
    __device__ __forceinline__ void operator()(f32x4 (&acc)[2][2][4][2], const Unit& u, int wr, int wc, int fr, int fq) const {
        const int row0 = u.pm * BM + wr * 64 + fr, col0 = u.pn * BM + wc * 32 + 8 * fq;
#pragma unroll
        for (int ai = 0; ai < 2; ++ai)
#pragma unroll
            for (int m = 0; m < 4; ++m) { const size_t r = (size_t)(row0 + ai * HALF + m * 16); const bf16_t* zr = Z + r * LDZ + col0;
#pragma unroll
                for (int bj = 0; bj < 2; ++bj) {
                    const bf16x8 ga = *(const bf16x8*)(zr + OFF_MA + bj * HALF);
                    if (u.mode == 0) {
                        const bf16x8 gr = *(const bf16x8*)(zr + OFF_MR + bj * HALF);
#pragma unroll
                        for (int n = 0; n < 2; ++n)
#pragma unroll
                            for (int j = 0; j < 4; ++j) { const float ea = __expf(-bfs2f(ga[4 * n + j])), er = __expf(-bfs2f(gr[4 * n + j])); acc[ai][bj][m][n][j] *= (1.0f + ea) / (1.0f + er); }
                    } else {
                        float v[8];
#pragma unroll
                        for (int n = 0; n < 2; ++n)
#pragma unroll
                            for (int j = 0; j < 4; ++j) v[4 * n + j] = acc[ai][bj][m][n][j] / (1.0f + __expf(-bfs2f(ga[4 * n + j])));
                        u32x4 w; w.x = cvt_pk_bf16(v[0], v[1]); w.y = cvt_pk_bf16(v[2], v[3]); w.z = cvt_pk_bf16(v[4], v[5]); w.w = cvt_pk_bf16(v[6], v[7]);
                        *(u32x4*)(O + r * D + col0 + bj * HALF) = w;
                    } } }
    }
};
struct EpiH {
    static constexpr bool PERM = false;
    const float* xp; const float* xs; float* H;
    __device__ __forceinline__ void operator()(f32x4 (&acc)[2][2][4][2], const Unit& u, int wr, int wc, int fr, int fq) const {
        const int row0 = u.pm * BM + wr * 64 + fr, col0 = u.pn * BM + wc * 32 + 4 * fq;
#pragma unroll
        for (int ai = 0; ai < 2; ++ai)
#pragma unroll
            for (int m = 0; m < 4; ++m) { const int r = row0 + ai * HALF + m * 16; const float* xr = (r < M_P) ? xp + (size_t)r * D : xs + (size_t)(r - M_P) * D; float* hr = H + (size_t)r * D;
#pragma unroll
                for (int bj = 0; bj < 2; ++bj)
#pragma unroll
                    for (int n = 0; n < 2; ++n) { const int c = col0 + bj * HALF + n * 16; const f32x4 xv = *(const f32x4*)(xr + c); *(f32x4*)(hr + c) = xv * ALPHA + acc[ai][bj][m][n]; }
                asm volatile("" ::: "memory"); }
    }
};
}

struct Args { const float* in[23]; float* out; unsigned char* ws; int ph_lo, ph_hi; };

__device__ __forceinline__ void p0_transpose_item(const float* W, int N, bf16_t* WT, int ldt, int koff, int row_off, LAS float* scr, int kb, int nb, int lane) {
    const int k0 = 64 * kb, n0 = 32 * nb;
#pragma unroll 8
    for (int i = 0; i < 32; ++i) { const int kk = 2 * i + (lane >> 5); scr[kk * 33 + (lane & 31)] = W[(size_t)(k0 + kk) * N + n0 + (lane & 31)]; }
    LDS_WAIT();
    const int c = lane & 7;
#pragma unroll
    for (int j = 0; j < 4; ++j) { const int n = (lane >> 3) + 8 * j; const LAS float* s = scr + (8 * c) * 33 + n;
        u32x4 o; o.x = pk2(s[0 * 33], s[1 * 33]); o.y = pk2(s[2 * 33], s[3 * 33]); o.z = pk2(s[4 * 33], s[5 * 33]); o.w = pk2(s[6 * 33], s[7 * 33]);
        *(u32x4*)(WT + (size_t)(row_off + n0 + n) * ldt + koff + k0 + 8 * c) = o; }
    LDS_WAIT();
}

__device__ __forceinline__ void phase_convert(const Args& a, LAS unsigned char* lds) {
    const int tid = threadIdx.x, lane = tid & 63, wave = tid >> 6, G = gridDim.x;
    unsigned char* ws = a.ws;
    bf16_t* XB = (bf16_t*)(ws + WS_XB); bf16_t* W1T = (bf16_t*)(ws + WS_W1T); bf16_t* W2T = (bf16_t*)(ws + WS_W2T); bf16_t* W3T = (bf16_t*)(ws + WS_W3T); bf16_t* WLT = (bf16_t*)(ws + WS_WLT);
    LAS float* scr = (LAS float*)(lds + wave * 8704);
    const int gw = blockIdx.x * 8 + wave, NGW = G * 8;
    constexpr int I1 = 64 * 664, I2 = 32 * 128, I3 = 32 * 128, I4 = 64 * 128, I5 = 2 * 64, I6 = 2 * 64, NIT = I1 + I2 + I3 + I4 + I5 + I6;
    for (int it = gw; it < NIT; it += NGW) {
        int r = it;
        if (r < I1) { p0_transpose_item(a.in[6], NZ, W1T, D, 0, 0, scr, r / 664, r % 664, lane); continue; } r -= I1;
        if (r < I2) { p0_transpose_item(a.in[18], D, W2T, D, 0, 0, scr, r / 128, r % 128, lane); continue; } r -= I2;
        if (r < I3) { p0_transpose_item(a.in[19], D, W2T, D, 2048, 0, scr, r / 128, r % 128, lane); continue; } r -= I3;
        if (r < I4) { p0_transpose_item(a.in[20], D, W3T, D, 0, 0, scr, r / 128, r % 128, lane); continue; } r -= I4;
        if (r < I5) { p0_transpose_item(a.in[9], RW, WLT, 256, 0, 0, scr, r / 64, r % 64, lane); continue; } r -= I5;
        p0_transpose_item(a.in[11], RW, WLT, 256, 128, 2048, scr, r / 64, r % 64, lane);
    }
    const size_t gt = (size_t)blockIdx.x * NTHREADS + tid, NGT = (size_t)G * NTHREADS;
    for (size_t i = gt; i < (size_t)4096 * 16; i += NGT) { const int n = (int)(i >> 4), c = (int)(i & 15); *(u32x4*)(WLT + (size_t)n * 256 + (n < 2048 ? 128 : 0) + 8 * c) = (u32x4){0u, 0u, 0u, 0u}; }
    const float* xp = a.in[0]; const float* xs = a.in[1];
    for (size_t i = gt; i < (size_t)M * D / 8; i += NGT) { const size_t e = i * 8; const float* src = (e < (size_t)M_P * D) ? xp + e : xs + (e - (size_t)M_P * D);
        const f32x4 v0 = *(const f32x4*)src, v1 = *(const f32x4*)(src + 4); u32x4 o; o.x = pk2(v0[0], v0[1]); o.y = pk2(v0[2], v0[3]); o.z = pk2(v1[0], v1[1]); o.w = pk2(v1[2], v1[3]); *(u32x4*)(XB + e) = o; }
    f32x2* rope = (f32x2*)(ws + WS_ROPE);
    for (size_t i = gt; i < (size_t)2056 * 8; i += NGT) { const int p = (int)(i >> 3), ii = (int)(i & 7); const double pos = (p < 2048) ? (double)p : (double)(8192 + p - 2048);
        const double inv = pow(500000.0, -(double)ii / 8.0), ang = pos * inv; rope[i] = (f32x2){(float)cos(ang), (float)sin(ang)}; }
}

__device__ __forceinline__ void lora_a_panel(const Args& a, int pm) {
    const bf16_t* Z = (const bf16_t*)(a.ws + WS_Z); bf16_t* AL = (bf16_t*)(a.ws + WS_AL); const float* mu = a.in[7] + OFF_WD; const float* sh = a.in[3];
    for (int it = threadIdx.x; it < 256 * 32; it += NTHREADS) {
        const int r = pm * 256 + (it >> 5), c = (it & 31) * 8;
        const bf16x8 cur = *(const bf16x8*)(Z + (size_t)r * LDZ + OFF_WD + c);
        float pv[8]; bool first;
        if (r < M_P) first = (r & (TP - 1)) == 0; else first = ((r - M_P) & (TS - 1)) == 0;
        if (!first) { const bf16x8 p = *(const bf16x8*)(Z + (size_t)(r - 1) * LDZ + OFF_WD + c);
#pragma unroll
            for (int j = 0; j < 8; ++j) pv[j] = bfs2f(p[j]); }
        else if (r >= M_P) { const float* s = sh + (size_t)((r - M_P) >> 3) * SHIFT_W + OFF_WD + c;
#pragma unroll
            for (int j = 0; j < 8; ++j) pv[j] = s[j]; }
        else {
#pragma unroll
            for (int j = 0; j < 8; ++j) pv[j] = 0.f; }
        float o[8];
#pragma unroll
        for (int j = 0; j < 8; ++j) { const float z = bfs2f(cur[j]); const float x = z + mu[c + j] * (pv[j] - z); o[j] = (c < 128) ? tanhf(x) : x; }
        u32x4 w; w.x = pk2(o[0], o[1]); w.y = pk2(o[2], o[3]); w.z = pk2(o[4], o[5]); w.w = pk2(o[6], o[7]);
        *(u32x4*)(AL + (size_t)r * 256 + c) = w;
    }
}

namespace att {
constexpr int KT_STRIDE = 144, KT_ROWS = 272, VT_STRIDE = 552;
constexpr int KT_OFF = 0, VT_OFF = KT_ROWS * KT_STRIDE, SC_OFF = VT_OFF + 64 * VT_STRIDE, SC_STRIDE = 68, SC_WAVE = 16 * SC_STRIDE * 4;
static_assert(SC_OFF + 8 * SC_WAVE <= 131072 && VT_OFF % 16 == 0 && SC_OFF % 16 == 0, "attention LDS map");

__device__ __forceinline__ bf16x8 rope8(bf16x8 own, bf16x8 oth, const f32x2* tab, int c) {
    bf16x8 o;
#pragma unroll
    for (int j = 0; j < 8; ++j) { const f32x2 cs = tab[j]; const float x = bfs2f(own[j]), y = bfs2f(oth[j]); const float r = (c == 0) ? x * cs.x - y * cs.y : x * cs.x + y * cs.y; o[j] = (short)f2bf(r); }
    return o;
}

template <class RowFn>
__device__ __forceinline__ void attn_group(LAS unsigned char* lds, int wave, int lane, const RowFn& rf, int T0, bool prev_valid, const float* sinks, const bf16_t* Z, bf16_t* Y, const f32x2* rope) {
    const int qi = lane & 15, g = lane >> 4;
    int row, head, qpos2, ridx; rf(qi, row, head, qpos2, ridx);
    const bf16_t* qp = Z + (size_t)row * LDZ + OFF_Q + head * 64;
    bf16x8 q0 = *(const bf16x8*)(qp + 8 * g), q1 = *(const bf16x8*)(qp + 32 + 8 * g);
    { const bf16x8 oth = *(const bf16x8*)(qp + 8 * (g ^ 1)); if (g < 2) q0 = rope8(q0, oth, rope + (size_t)ridx * 8, g); }
    float s[10][4];
#pragma unroll
    for (int tl = 0; tl < 10; ++tl) {
        const LAS unsigned char* kp = lds + KT_OFF + ((T0 + tl) * 16 + qi) * KT_STRIDE + 16 * g;
        const bf16x8 k0 = *(const LAS bf16x8*)kp, k1 = *(const LAS bf16x8*)(kp + 64);
        f32x4 a = (f32x4){0.f, 0.f, 0.f, 0.f};
        a = __builtin_amdgcn_mfma_f32_16x16x32_bf16(k0, q0, a, 0, 0, 0);
        a = __builtin_amdgcn_mfma_f32_16x16x32_bf16(k1, q1, a, 0, 0, 0);
#pragma unroll
        for (int r = 0; r < 4; ++r) s[tl][r] = a[r] * 0.125f;
    }
    const float sink = sinks[head];
    float mx = sink;
#pragma unroll
    for (int tl = 0; tl < 10; ++tl)
#pragma unroll
        for (int r = 0; r < 4; ++r) { const int kpos = (T0 + tl) * 16 + 4 * g + r, rel = qpos2 - kpos; const bool ok = (rel >= 0) && (rel < 128) && (prev_valid || kpos >= 128);
            s[tl][r] = ok ? s[tl][r] : -1e30f; mx = fmaxf(mx, s[tl][r]); }
    mx = fmaxf(mx, __shfl_xor(mx, 16)); mx = fmaxf(mx, __shfl_xor(mx, 32));
    float sum = 0.f;
#pragma unroll
    for (int tl = 0; tl < 10; ++tl)
#pragma unroll
        for (int r = 0; r < 4; ++r) { s[tl][r] = __expf(s[tl][r] - mx); sum += s[tl][r]; }
    sum += __shfl_xor(sum, 16); sum += __shfl_xor(sum, 32);
    const float inv = 1.0f / (sum + __expf(sink - mx));
    bf16x8 pa[5];
#pragma unroll
    for (int pr = 0; pr < 5; ++pr)
#pragma unroll
        for (int j = 0; j < 4; ++j) { pa[pr][j] = (short)f2bf(s[2 * pr][j] * inv); pa[pr][4 + j] = (short)f2bf(s[2 * pr + 1][j] * inv); }
    f32x4 o[4];
#pragma unroll
    for (int n = 0; n < 4; ++n) { o[n] = (f32x4){0.f, 0.f, 0.f, 0.f};
#pragma unroll
        for (int pr = 0; pr < 5; ++pr) {
            const LAS unsigned char* vp = lds + VT_OFF + (16 * n + qi) * VT_STRIDE + ((T0 + 2 * pr) * 16 + 4 * g) * 2;
            const s16x4 lo = *(const LAS s16x4*)vp, hi = *(const LAS s16x4*)(vp + 32);
            bf16x8 vf; vf[0] = lo[0]; vf[1] = lo[1]; vf[2] = lo[2]; vf[3] = lo[3]; vf[4] = hi[0]; vf[5] = hi[1]; vf[6] = hi[2]; vf[7] = hi[3];
            o[n] = __builtin_amdgcn_mfma_f32_16x16x32_bf16(pa[pr], vf, o[n], 0, 0, 0);
        } }
    LAS float* sc = (LAS float*)(lds + SC_OFF + wave * SC_WAVE);
#pragma unroll
    for (int n = 0; n < 4; ++n)
#pragma unroll
        for (int r = 0; r < 4; ++r) sc[(4 * g + r) * SC_STRIDE + 16 * n + qi] = o[n][r];
    LDS_WAIT();
    const int q = lane >> 2, ch = lane & 3;
    int row2, head2, d0, d1; rf(q, row2, head2, d0, d1);
    const LAS float* sr = sc + q * SC_STRIDE + ch * 16;
    const bf16_t* gp = Z + (size_t)row2 * LDZ + OFF_GA + head2 * 64 + ch * 16;
    const bf16x8 g0 = *(const bf16x8*)gp, g1 = *(const bf16x8*)(gp + 8);
    float v[16];
#pragma unroll
    for (int i = 0; i < 4; ++i) { const f32x4 x = *(const LAS f32x4*)(sr + 4 * i); v[4 * i] = x[0]; v[4 * i + 1] = x[1]; v[4 * i + 2] = x[2]; v[4 * i + 3] = x[3]; }
#pragma unroll
    for (int j = 0; j < 8; ++j) { const float ga = bfs2f(g0[j]), gb = bfs2f(g1[j]); v[j] *= ga / (1.0f + __expf(-ga)); v[8 + j] *= gb / (1.0f + __expf(-gb)); }
    u32x4 w0, w1; w0.x = pk2(v[0], v[1]); w0.y = pk2(v[2], v[3]); w0.z = pk2(v[4], v[5]); w0.w = pk2(v[6], v[7]); w1.x = pk2(v[8], v[9]); w1.y = pk2(v[10], v[11]); w1.z = pk2(v[12], v[13]); w1.w = pk2(v[14], v[15]);
    bf16_t* yp = Y + (size_t)row2 * D + 2048 + head2 * 64 + ch * 16;
    *(u32x4*)yp = w0; *(u32x4*)(yp + 8) = w1;
    LDS_WAIT();
}

struct PromptRows { int rowbase, hq, q0, posbase; __device__ __forceinline__ void operator()(int i, int& row, int& head, int& qpos2, int& ridx) const { row = rowbase + q0 + i; head = hq; qpos2 = 128 + q0 + i; ridx = posbase + q0 + i; } };
struct SampleRows { int rowbase, h0; __device__ __forceinline__ void operator()(int i, int& row, int& head, int& qpos2, int& ridx) const { const int t = i & 7; row = rowbase + t; head = h0 + (i >> 3); qpos2 = 128 + t; ridx = 2048 + t; } };

__device__ __forceinline__ void store8f(float* p, bf16x8 v) { f32x4 a, b;
#pragma unroll
    for (int j = 0; j < 4; ++j) { a[j] = bfs2f(v[j]); b[j] = bfs2f(v[4 + j]); } *(f32x4*)p = a; *(f32x4*)(p + 4) = b; }

__device__ __forceinline__ void unit_prompt(const Args& a, LAS unsigned char* lds, int u) {
    const int tid = threadIdx.x, lane = tid & 63, wave = tid >> 6;
    const int kvh = u & 3, nb = (u >> 2) & 15, b = u >> 6;
    const bf16_t* Z = (const bf16_t*)(a.ws + WS_Z); bf16_t* Y = (bf16_t*)(a.ws + WS_Y); const f32x2* rope = (const f32x2*)(a.ws + WS_ROPE);
    float* wk = a.out + O_WKP; float* wv = a.out + O_WVP;
    for (int it = tid; it < KT_ROWS * 8; it += NTHREADS) {
        const int key = it >> 3, c = it & 7;
        bf16x8 kv = (bf16x8){0, 0, 0, 0, 0, 0, 0, 0}, vv = kv;
        const bool valid = key < 256 && (key >= 128 || nb > 0);
        if (valid) {
            const int tok = (nb - 1) * 128 + key; const size_t row = (size_t)b * TP + tok;
            const bf16_t* kp = Z + row * LDZ + OFF_K + kvh * 64;
            kv = *(const bf16x8*)(kp + 8 * c);
            if (c < 2) { const bf16x8 oth = *(const bf16x8*)(kp + 8 * (c ^ 1)); kv = rope8(kv, oth, rope + (size_t)tok * 8, c); }
            vv = *(const bf16x8*)(Z + row * LDZ + OFF_V + kvh * 64 + 8 * c);
            if (nb == 15 && key >= 128) { const size_t o = (((size_t)b * 128 + (key - 128)) * 4 + kvh) * 64 + 8 * c; store8f(wk + o, kv); store8f(wv + o, vv); }
        }
        *(LAS bf16x8*)(lds + KT_OFF + key * KT_STRIDE + 16 * c) = kv;
#pragma unroll
        for (int j = 0; j < 8; ++j) *(LAS short*)(lds + VT_OFF + (8 * c + j) * VT_STRIDE + key * 2) = vv[j];
    }
    __syncthreads();
    PromptRows rf; rf.rowbase = b * TP + nb * 128; rf.hq = kvh * 8 + wave; rf.posbase = nb * 128;
    for (int grp = 0; grp < 8; ++grp) { rf.q0 = 16 * grp; attn_group(lds, wave, lane, rf, grp, nb > 0, a.in[17], Z, Y, rope); }
    __syncthreads();
}

__device__ __forceinline__ void unit_sample(const Args& a, LAS unsigned char* lds, int u) {
    const int tid = threadIdx.x, lane = tid & 63, wave = tid >> 6;
    const int kvh = u & 3, b = u >> 2;
    const bf16_t* Z = (const bf16_t*)(a.ws + WS_Z); bf16_t* Y = (bf16_t*)(a.ws + WS_Y); const f32x2* rope = (const f32x2*)(a.ws + WS_ROPE);
    const float* ck = a.in[4]; const float* cv = a.in[5]; float* wk = a.out + O_WKS; float* wv = a.out + O_WVS;
    for (int it = tid; it < 160 * 8; it += NTHREADS) {
        const int key = it >> 3, c = it & 7;
        bf16x8 kv = (bf16x8){0, 0, 0, 0, 0, 0, 0, 0}, vv = kv;
        if (key < 128) {
            const size_t so = (((size_t)b * 128 + key) * 4 + kvh) * 64 + 8 * c;
            const f32x4 k0 = *(const f32x4*)(ck + so), k1 = *(const f32x4*)(ck + so + 4), v0 = *(const f32x4*)(cv + so), v1 = *(const f32x4*)(cv + so + 4);
#pragma unroll
            for (int j = 0; j < 4; ++j) { kv[j] = (short)f2bf(k0[j]); kv[4 + j] = (short)f2bf(k1[j]); vv[j] = (short)f2bf(v0[j]); vv[4 + j] = (short)f2bf(v1[j]); }
            if (key >= 8) { const size_t o = (((size_t)b * 128 + (key - 8)) * 4 + kvh) * 64 + 8 * c; *(f32x4*)(wk + o) = k0; *(f32x4*)(wk + o + 4) = k1; *(f32x4*)(wv + o) = v0; *(f32x4*)(wv + o + 4) = v1; }
        } else if (key < 136) {
            const int t = key - 128; const size_t row = (size_t)M_P + b * TS + t;
            const bf16_t* kp = Z + row * LDZ + OFF_K + kvh * 64;
            kv = *(const bf16x8*)(kp + 8 * c);
            if (c < 2) { const bf16x8 oth = *(const bf16x8*)(kp + 8 * (c ^ 1)); kv = rope8(kv, oth, rope + (size_t)(2048 + t) * 8, c); }
            vv = *(const bf16x8*)(Z + row * LDZ + OFF_V + kvh * 64 + 8 * c);
            const size_t o = (((size_t)b * 128 + (120 + t)) * 4 + kvh) * 64 + 8 * c; store8f(wk + o, kv); store8f(wv + o, vv);
        }
        *(LAS bf16x8*)(lds + KT_OFF + key * KT_STRIDE + 16 * c) = kv;
#pragma unroll
        for (int j = 0; j < 8; ++j) *(LAS short*)(lds + VT_OFF + (8 * c + j) * VT_STRIDE + key * 2) = vv[j];
    }
    __syncthreads();
    if (wave < 4) { SampleRows rf; rf.rowbase = M_P + b * TS; rf.h0 = kvh * 8 + 2 * wave; attn_group(lds, wave, lane, rf, 0, true, a.in[17], Z, Y, rope); }
    __syncthreads();
}
}

namespace scan {
constexpr int CT = 32, IN_STRIDE = 1536, IN_BYTES = CT * IN_STRIDE, YB_OFF = 2 * IN_BYTES, RK_OFF = YB_OFF + CT * 64 * 4;
static_assert(RK_OFF + CT * 4 <= 131072, "scan LDS map");
struct Chunk { int row0, nsteps, h, first, last, kind, seq; };
struct Raw { unsigned short zr[4], zk[4], zv[4], pr[4], pk[4], pv[4], g[4]; float dw[4], aa[4], fix[3]; };

__device__ __forceinline__ float red16(float x) {
    x += __builtin_bit_cast(float, __builtin_amdgcn_update_dpp(0, __builtin_bit_cast(int, x), 0xB1, 0xF, 0xF, true));
    x += __builtin_bit_cast(float, __builtin_amdgcn_update_dpp(0, __builtin_bit_cast(int, x), 0x4E, 0xF, 0xF, true));
    x += __builtin_bit_cast(float, __builtin_amdgcn_update_dpp(0, __builtin_bit_cast(int, x), 0x141, 0xF, 0xF, true));
    x += __builtin_bit_cast(float, __builtin_amdgcn_update_dpp(0, __builtin_bit_cast(int, x), 0x140, 0xF, 0xF, true));
    return x;
}

__device__ __forceinline__ bool get_chunk(int j, Chunk& C) {
    const int w = blockIdx.x, G = gridDim.x;
    const int np = (w < 128) ? (128 - w + G - 1) / G : 0;
    if (j < np * 64) { const int p = w + (j >> 6) * G, c = j & 63; C.kind = 0; C.seq = p >> 5; C.h = p & 31; C.row0 = C.seq * TP + c * CT; C.nsteps = CT; C.first = (c == 0); C.last = (c == 63); return true; }
    const int js = j - np * 64; int s;
    if (G > 128) { if (w < 128) return false; s = (w - 128) + js * (G - 128); } else s = w + js * G;
    if (s >= NB_S * NH) return false;
    C.kind = 1; C.seq = s >> 5; C.h = s & 31; C.row0 = M_P + C.seq * TS; C.nsteps = TS; C.first = 1; C.last = 1; return true;
}

__device__ __forceinline__ void phase_scan(const Args& a, LAS unsigned char* lds) {
    const int tid = threadIdx.x, lane = tid & 63, wave = tid >> 6;
    const bf16_t* Z = (const bf16_t*)(a.ws + WS_Z); const float* DW = (const float*)(a.ws + WS_DW); const float* AA = (const float*)(a.ws + WS_AA); bf16_t* Y = (bf16_t*)(a.ws + WS_Y);
    const float* mu = a.in[7]; const float* k_k = a.in[12]; const float* k_a = a.in[13]; const float* r_k = a.in[14]; const float* gn_w = a.in[15]; const float* gn_b = a.in[16];
    const int kq = lane & 15, rp = lane >> 4, srow = wave * 8 + rp * 2;
    const int pk = lane, tq = wave;
    LAS float* ybuf = (LAS float*)(lds + YB_OFF); LAS float* rkbuf = (LAS float*)(lds + RK_OFF);
    Chunk C, CN; Raw R;
    int j = 0;
    if (!get_chunk(0, C)) return;
    f32x4 S0 = (f32x4){0.f, 0.f, 0.f, 0.f}, S1 = S0, N0 = S0, N1 = S0;
    unsigned short gcur[4] = {0, 0, 0, 0};

#define SCAN_PREFETCH(CC) do { const int col = (CC).h * 64 + pk; \
        _Pragma("unroll") for (int i = 0; i < 4; ++i) if (8 * i < (CC).nsteps) { const size_t row = (size_t)((CC).row0 + tq + 8 * i); const size_t rprev = row > 0 ? row - 1 : 0; \
            const bf16_t* zp = Z + row * LDZ + col; const bf16_t* pp = Z + rprev * LDZ + col; \
            R.zr[i] = zp[0]; R.zk[i] = zp[2048]; R.zv[i] = zp[4096]; R.g[i] = zp[OFF_GR]; R.pr[i] = pp[0]; R.pk[i] = pp[2048]; R.pv[i] = pp[4096]; \
            R.dw[i] = DW[row * RW + col]; R.aa[i] = AA[row * RW + col]; } \
        R.fix[0] = 0.f; R.fix[1] = 0.f; R.fix[2] = 0.f; \
        if ((CC).first && (CC).kind == 1 && tq == 0) { const float* sp = a.in[3] + (size_t)(CC).seq * SHIFT_W + col; R.fix[0] = sp[0]; R.fix[1] = sp[2048]; R.fix[2] = sp[4096]; } } while (0)
#define SCAN_LOADS0(CC, A0, A1) do { if ((CC).kind == 1) { const float* sp = a.in[2] + (((size_t)(CC).seq * NH + (CC).h) * 64 + srow) * 64 + 4 * kq; A0 = *(const f32x4*)sp; A1 = *(const f32x4*)(sp + 64); } \
        else { A0 = (f32x4){0.f, 0.f, 0.f, 0.f}; A1 = A0; } } while (0)
#define SCAN_PROCESS(CC, INB) do { const int col = (CC).h * 64 + pk; const float mur = mu[col], muk = mu[2048 + col], muv = mu[4096 + col], kkc = k_k[col], kac = k_a[col], rkc = r_k[col]; \
        _Pragma("unroll") for (int i = 0; i < 4; ++i) if (8 * i < (CC).nsteps) { const int t = tq + 8 * i; \
            const float zr = bf2f(R.zr[i]), zk = bf2f(R.zk[i]), zv = bf2f(R.zv[i]); float pr = bf2f(R.pr[i]), pkk = bf2f(R.pk[i]), pv = bf2f(R.pv[i]); \
            if ((CC).first && t == 0) { pr = R.fix[0]; pkk = R.fix[1]; pv = R.fix[2]; } \
            const float xr = zr + mur * (pr - zr), xk = zk + muk * (pkk - zk), xv = zv + muv * (pv - zv); const float av = R.aa[i]; \
            const float kkv = xk * kkc; const float ss = wave_sum(kkv * kkv); const float kkn = kkv / fmaxf(sqrtf(ss), 1e-12f); \
            const float kh = xk * (1.0f + (av - 1.0f) * kac); const float rk = wave_sum(xr * kh * rkc); \
            LAS float* ib = (LAS float*)((INB) + t * IN_STRIDE); ib[pk] = R.dw[i]; ib[64 + pk] = -kkn; ib[128 + pk] = kkn * av; ib[192 + pk] = kh; ib[256 + pk] = xr; ib[320 + pk] = xv; \
            if (pk == 0) rkbuf[t] = rk; gcur[i] = R.g[i]; } } while (0)

    SCAN_PREFETCH(C);
    SCAN_LOADS0(C, S0, S1);
    SCAN_PROCESS(C, lds);
    __syncthreads();
    for (;;) {
        const bool haveN = get_chunk(j + 1, CN);
        LAS unsigned char* inb = lds + (j & 1) * IN_BYTES;
        if (haveN) { SCAN_PREFETCH(CN); if (CN.first) SCAN_LOADS0(CN, N0, N1); }
        {
            const LAS unsigned char* ib = inb + kq * 16;
            const LAS unsigned char* vb = inb + 1280 + srow * 4;
            const int ns = C.nsteps;
#pragma unroll 4
            for (int t = 0; t < ns; ++t) {
                const f32x4 w = *(const LAS f32x4*)(ib + t * IN_STRIDE), nk = *(const LAS f32x4*)(ib + t * IN_STRIDE + 256), bb = *(const LAS f32x4*)(ib + t * IN_STRIDE + 512),
                            kh = *(const LAS f32x4*)(ib + t * IN_STRIDE + 768), rr = *(const LAS f32x4*)(ib + t * IN_STRIDE + 1024);
                const f32x2 vv = *(const LAS f32x2*)(vb + t * IN_STRIDE);
                float sa0 = (S0[0] * nk[0] + S0[1] * nk[1]) + (S0[2] * nk[2] + S0[3] * nk[3]);
                float sa1 = (S1[0] * nk[0] + S1[1] * nk[1]) + (S1[2] * nk[2] + S1[3] * nk[3]);
                sa0 = red16(sa0); sa1 = red16(sa1);
                S0 = S0 * w + bb * sa0 + kh * vv[0];
                S1 = S1 * w + bb * sa1 + kh * vv[1];
                float y0 = (S0[0] * rr[0] + S0[1] * rr[1]) + (S0[2] * rr[2] + S0[3] * rr[3]);
                float y1 = (S1[0] * rr[0] + S1[1] * rr[1]) + (S1[2] * rr[2] + S1[3] * rr[3]);
                y0 = red16(y0); y1 = red16(y1);
                if (kq == 0) *(LAS f32x2*)(ybuf + t * 64 + srow) = (f32x2){y0, y1};
            }
        }
        if (C.last) { float* op = a.out + (C.kind == 0 ? O_WKVP : O_WKVS) + (((size_t)C.seq * NH + C.h) * 64 + srow) * 64 + 4 * kq; *(f32x4*)op = S0; *(f32x4*)(op + 64) = S1; }
        __syncthreads();
        {
            const int col = C.h * 64 + pk; const float gw = gn_w[col], gb = gn_b[col];
#pragma unroll
            for (int i = 0; i < 4; ++i) if (8 * i < C.nsteps) { const int t = tq + 8 * i;
                const float y = ybuf[t * 64 + pk]; const float mean = wave_sum(y) * (1.0f / 64.0f); const float d = y - mean; const float var = wave_sum(d * d) * (1.0f / 64.0f);
                const float yn = d * rsqrtf(var + GN_EPS) * gw + gb; const float bonus = rkbuf[t] * ((const LAS float*)(inb + t * IN_STRIDE))[320 + pk];
                const float gt = bf2f(gcur[i]); const float o = (yn + bonus) * (gt / (1.0f + __expf(-gt)));
                Y[(size_t)(C.row0 + t) * D + col] = (bf16_t)f2bf(o); }
        }
        if (haveN) SCAN_PROCESS(CN, lds + ((j + 1) & 1) * IN_BYTES);
        __syncthreads();
        if (!haveN) break;
        C = CN; ++j; if (C.first) { S0 = N0; S1 = N1; }
    }
#undef SCAN_PREFETCH
#undef SCAN_LOADS0
#undef SCAN_PROCESS
}
}

__device__ __forceinline__ void phase_ln(const Args& a) {
    const int lane = threadIdx.x & 63, wave = threadIdx.x >> 6; const int gw = blockIdx.x * 8 + wave, NGW = gridDim.x * 8;
    const float* lg = a.in[21]; const float* lb = a.in[22];
    for (int m = gw; m < M; m += NGW) {
        f32x4* hr = (f32x4*)(a.out + (size_t)m * D) + lane; f32x4 v[16]; float s = 0.f;
#pragma unroll
        for (int jj = 0; jj < 16; ++jj) { v[jj] = hr[64 * jj]; s += (v[jj][0] + v[jj][1]) + (v[jj][2] + v[jj][3]); }
        const float mean = wave_sum(s) * (1.0f / D); float s2 = 0.f;
#pragma unroll
        for (int jj = 0; jj < 16; ++jj) { v[jj] = v[jj] - mean; s2 += (v[jj][0] * v[jj][0] + v[jj][1] * v[jj][1]) + (v[jj][2] * v[jj][2] + v[jj][3] * v[jj][3]); }
        const float rstd = rsqrtf(wave_sum(s2) * (1.0f / D) + LN_EPS);
#pragma unroll
        for (int jj = 0; jj < 16; ++jj) { const f32x4 gg = *((const f32x4*)lg + lane + 64 * jj), bb = *((const f32x4*)lb + lane + 64 * jj); hr[64 * jj] = v[jj] * rstd * gg + bb; }
    }
}

template <bool COOP>
__global__ void __launch_bounds__(NTHREADS, 2) fwd_kernel(Args a) {
    extern __shared__ __attribute__((aligned(16))) unsigned char lds_raw[];
    LAS unsigned char* lds = (LAS unsigned char*)lds_raw;
    const int lo = a.ph_lo, hi = a.ph_hi;
    unsigned char* ws = a.ws;
#define IN(k) (lo <= (k) && (k) < hi)
#define SEAM(k) do { if (COOP && IN(k) && IN((k) + 1)) { cg::this_grid().sync(); } } while (0)
    if (IN(0)) { phase_convert(a, lds); }
    SEAM(0);
    if (IN(1)) {
        pg8::Gemm g{(const bf16_t*)(ws + WS_XB), (const bf16_t*)(ws + WS_W1T), D, D, D / 64}; pg8::TileOrder S; S.init(M, NZ, gridDim.x, blockIdx.x, 1, D / 64);
        pg8::EpiZ E{(bf16_t*)(ws + WS_Z), LDZ};
        pg8::gemm_phase<pg8::EpiZ, true, true>(lds, g, S, E);
    }
    SEAM(1);
    if (IN(2)) {
        { const bf16_t* Z = (const bf16_t*)(ws + WS_Z);
          for (size_t i = (size_t)blockIdx.x * NTHREADS + threadIdx.x; i < (size_t)(NB_P + NB_S) * SHIFT_W; i += (size_t)gridDim.x * NTHREADS) {
              const int r = (int)(i / SHIFT_W), c = (int)(i % SHIFT_W);
              if (r < NB_P) a.out[O_SHP + (size_t)r * SHIFT_W + c] = bf2f(Z[((size_t)r * TP + TP - 1) * LDZ + c]);
              else a.out[O_SHS + (size_t)(r - NB_P) * SHIFT_W + c] = bf2f(Z[((size_t)M_P + (size_t)(r - NB_P) * TS + TS - 1) * LDZ + c]); } }
        pg8::TileOrder S; S.init(M, 4096, gridDim.x, blockIdx.x, 1, 4);
        { pg8::Unit u; int lastpm = -1; for (int i = 0; S.next(i, u); ++i) if (u.pm != lastpm) { lora_a_panel(a, u.pm); lastpm = u.pm; } }
        VM_WAIT(); __syncthreads();
        { pg8::Gemm g{(const bf16_t*)(ws + WS_AL), (const bf16_t*)(ws + WS_WLT), 256, 256, 4};
          pg8::EpiLora E{(float*)(ws + WS_DW), (float*)(ws + WS_AA), a.in[8], a.in[10]};
          pg8::gemm_phase<pg8::EpiLora, true, true>(lds, g, S, E); }
        __syncthreads();
        for (int u = blockIdx.x; u < 256 + 512; u += gridDim.x) { if (u < 256) att::unit_prompt(a, lds, u); else att::unit_sample(a, lds, u - 256); }
    }
    SEAM(2);
    if (IN(3)) { scan::phase_scan(a, lds); }
    SEAM(3);
    if (IN(4)) {
        pg8::Gemm g{(const bf16_t*)(ws + WS_Y), (const bf16_t*)(ws + WS_W2T), D, D, 32}; pg8::TileOrder S; S.init(M, D, gridDim.x, blockIdx.x, 2, 32);
        pg8::EpiMix E{(const bf16_t*)(ws + WS_Z), (bf16_t*)(ws + WS_MIX)};
        pg8::gemm_phase<pg8::EpiMix, true, true>(lds, g, S, E);
    }
    SEAM(4);
    if (IN(5)) {
        pg8::Gemm g{(const bf16_t*)(ws + WS_MIX), (const bf16_t*)(ws + WS_W3T), D, D, D / 64}; pg8::TileOrder S; S.init(M, D, gridDim.x, blockIdx.x, 1, D / 64);
        pg8::EpiH E{a.in[0], a.in[1], a.out + O_Y};
        pg8::gemm_phase<pg8::EpiH, true, true>(lds, g, S, E);
    }
    SEAM(5);
    if (IN(6)) { phase_ln(a); }
#undef IN
#undef SEAM
}

extern "C" void kernel_launch(void* const* d_in, const int* in_sizes, int n_in, void* d_out, int out_size, void* d_ws, size_t ws_size, hipStream_t stream) {
    static int grid = 0;
    if (grid == 0) {
        if (n_in != 23 || out_size != (int)O_END || ws_size < WS_END) { fprintf(stderr, "kernel_launch: unexpected shapes: n_in %d out %d ws %zu (need %zu)\n", n_in, out_size, ws_size, (size_t)WS_END); grid = -1; return; }
        int dev = 0, cus = 0, per_cu = 0;
        if (hipGetDevice(&dev) != hipSuccess || hipDeviceGetAttribute(&cus, hipDeviceAttributeMultiprocessorCount, dev) != hipSuccess) { grid = -1; return; }
        if (hipFuncSetAttribute((const void*)fwd_kernel<(MK_FUSED != 0)>, hipFuncAttributeMaxDynamicSharedMemorySize, LDS_BYTES) != hipSuccess) { fprintf(stderr, "kernel_launch: hipFuncSetAttribute failed\n"); grid = -1; return; }
        if (hipOccupancyMaxActiveBlocksPerMultiprocessor(&per_cu, (const void*)fwd_kernel<(MK_FUSED != 0)>, NTHREADS, LDS_BYTES) != hipSuccess || per_cu < 1) { fprintf(stderr, "kernel_launch: occupancy query says %d\n", per_cu); per_cu = 1; }
        (void)hipGetLastError();
        grid = cus;
    }
    if (grid < 0) return;
    Args a{};
    for (int i = 0; i < 23; ++i) a.in[i] = (const float*)d_in[i];
    a.out = (float*)d_out; a.ws = (unsigned char*)d_ws;
#if MK_FUSED
    a.ph_lo = 0; a.ph_hi = 7;
    void* args[] = {&a};
    hipError_t e = hipLaunchCooperativeKernel((const void*)fwd_kernel<true>, dim3(grid), dim3(NTHREADS), args, LDS_BYTES, stream);
    if (e != hipSuccess) fprintf(stderr, "cooperative launch failed: %s (grid %d)\n", hipGetErrorString(e), grid);
#else
    for (int p = 0; p < 7; ++p) { a.ph_lo = p; a.ph_hi = p + 1; hipLaunchKernelGGL(fwd_kernel<false>, dim3(grid), dim3(NTHREADS), LDS_BYTES, stream, a); }
#endif
}
```

```cpp
#include <hip/hip_runtime.h>
#include <hip/hip_cooperative_groups.h>
#include <cstdio>
#include <cstdint>
namespace cg = cooperative_groups;

#ifndef MK_FUSED
#define MK_FUSED 1
#endif

#ifndef PROBE_REP
#define PROBE_REP -1
#endif
#define LAS __attribute__((address_space(3)))
typedef unsigned short bf16_t;
typedef short bf16x8 __attribute__((ext_vector_type(8)));
typedef short s16x4 __attribute__((ext_vector_type(4)));
typedef float f32x4 __attribute__((ext_vector_type(4)));
typedef float f32x2 __attribute__((ext_vector_type(2)));
typedef unsigned u32x4 __attribute__((ext_vector_type(4)));
typedef unsigned u32x2 __attribute__((ext_vector_type(2)));

constexpr int D = 4096, M_P = 8192, M_S = 1024, M = M_P + M_S;
constexpr int TP = 2048, TS = 8, NB_S = 128, NB_P = 4;
constexpr int NZ = 21248, LDZ = 13056;
constexpr int RW = 2048, SHIFT_W = 6400, NH = 32, HS = 64;
constexpr int N_BF = 4864, N_BFX = 2048, N_F8 = 16384, M_X = 256;
constexpr int OFF_WD = 6144, OFF_GR = 6400, OFF_Q = 8448, OFF_K = 10496, OFF_V = 10752, OFF_GA = 11008, OFF_MR = 13056, OFF_MA = 17152;
constexpr float ALPHA = 1.189207115002721f;
constexpr float LN_EPS = 1e-5f, GN_EPS = 64e-5f;
constexpr size_t O_Y = 0, O_WKVP = 37748736, O_SHP = 38273024, O_WKP = 38298624, O_WVP = 38429696, O_WKVS = 38560768, O_SHS = 55337984, O_WKS = 56157184, O_WVS = 60351488, O_END = 64545792;
constexpr size_t al1m(size_t x) { return (x + ((1u << 20) - 1)) & ~(size_t)((1u << 20) - 1); }
constexpr size_t WS_BAR = 0;
constexpr size_t WS_TCNT = 32768;
constexpr size_t WS_ROPE = 1u << 20;
constexpr size_t WS_XB = 2u << 20;
constexpr size_t WS_W1T = al1m(WS_XB + (size_t)(M + M_X) * D * 2);
constexpr size_t WS_W2T = al1m(WS_W1T + (size_t)NZ * D * 2);
constexpr size_t WS_W3T = al1m(WS_W2T + (size_t)D * D * 2);
constexpr size_t WS_WLT = al1m(WS_W3T + (size_t)D * D * 2);
constexpr size_t WS_Z = al1m(WS_WLT + (size_t)4096 * 256 * 2);
constexpr size_t WS_AL = al1m(WS_Z + (size_t)(M + M_X) * LDZ * 2);
constexpr size_t WS_DW = al1m(WS_AL + (size_t)M * 256 * 2);
constexpr size_t WS_AA = al1m(WS_DW + (size_t)M * 2048 * 4);
constexpr size_t WS_Y = al1m(WS_AA + (size_t)M * 2048 * 4);
constexpr size_t WS_MIX = al1m(WS_Y + (size_t)M * D * 2);
constexpr size_t WS_CB = al1m(WS_MIX + (size_t)M * D * 2);
constexpr size_t WS_XB8 = al1m(WS_CB + (size_t)16384 * 14336);
constexpr size_t WS_W8T = al1m(WS_XB8 + (size_t)M * D);
constexpr size_t WS_G = al1m(WS_W8T + (size_t)N_F8 * D);
constexpr size_t GTILE = 131072;
constexpr size_t WS_END = al1m(WS_G + (size_t)(M / 256) * 32 * GTILE);

constexpr int LDS_BYTES = 147456;
constexpr int NTHREADS = 512;
constexpr int LDS_MISC = 131072;

typedef __bf16 bf16x2_t __attribute__((ext_vector_type(2)));
__device__ __forceinline__ unsigned pk2(float lo, float hi) { const f32x2 v = {lo, hi}; return __builtin_bit_cast(unsigned, __builtin_convertvector(v, bf16x2_t)); }
__device__ __forceinline__ unsigned f2bf(float f) { return pk2(f, 0.f) & 0xffffu; }
__device__ __forceinline__ unsigned pk4_fp8(float a, float b, float c, float d) { int p = __builtin_amdgcn_cvt_pk_fp8_f32(a, b, 0, false); p = __builtin_amdgcn_cvt_pk_fp8_f32(c, d, p, true); return (unsigned)p; }
__device__ __forceinline__ float frcp(float x) { return __builtin_amdgcn_rcpf(x); }
__device__ __forceinline__ float bf2f(unsigned short b) { return __builtin_bit_cast(float, ((unsigned)b) << 16); }
__device__ __forceinline__ float bfs2f(short b) { return __builtin_bit_cast(float, ((unsigned)(unsigned short)b) << 16); }
__device__ __forceinline__ float wave_sum(float v) {
#pragma unroll
    for (int o = 1; o < 64; o <<= 1) v += __shfl_xor(v, o);
    return v;
}
__device__ __forceinline__ float sigmoidf_(float x) { return frcp(1.0f + __expf(-x)); }
__device__ __forceinline__ int lane_id_opaque() { int l; asm volatile("v_mbcnt_lo_u32_b32 %0, -1, 0\n\tv_mbcnt_hi_u32_b32 %0, -1, %0" : "=v"(l)); return l; }
#define LDS_WAIT() asm volatile("s_waitcnt lgkmcnt(0)" ::: "memory")
#define VM_WAIT() asm volatile("s_waitcnt vmcnt(0)" ::: "memory")

namespace pg8 {
constexpr int BM = 256, BK = 64, HALF = 128, HTB = HALF * BK * 2  , STAGE_BYTES = 8 * HTB, NXCD = 8, WGM = 8;
__host__ __device__ __forceinline__ int lds_byte(int r, int c) { const int st = (r >> 4) * 2 + (c >> 5), rr = r & 15, cc = c & 31, ob = rr * 64 + cc * 2; return st * 1024 + (ob ^ (((ob >> 9) & 1) << 5)); }
__host__ __device__ __forceinline__ void stage_rc(int b, int& R, int& C) { const int st = b / 1024, sb = b % 1024, swz = sb ^ (((sb >> 9) & 1) << 5); R = (st >> 1) * 16 + swz / 64; C = (st & 1) * 32 + (swz % 64) / 2; }
__host__ __device__ __forceinline__ int perm32(int rho) { const int n = rho >> 4, i = rho & 15; return 8 * (i >> 2) + 4 * n + (i & 3); }

struct Unit { int pm, pn, kt0, mode, nt, tt; };
struct Gemm { const bf16_t* A; const bf16_t* Bt; int lda, ldb, nt, ablk, bblk; };

struct TileOrder {
    int nM, nN, nwg, G, c, halves, nth, nfull, part;
    int khalf_pn;
    int nextra, ex_pm, ex_pn0;
    int gA, tA, nBt;
    __device__ __forceinline__ void init(int M_, int N_, int G_, int c_, int halves_, int nth_, bool split_tail = false, int part_ = 0) { part = part_; gA = 0; tA = 0; nBt = 0; nextra = 0; ex_pm = 0; ex_pn0 = 0; khalf_pn = 0; nM = M_ / BM; nN = N_ / BM; nwg = nM * nN; G = G_; c = c_; halves = halves_; nth = nth_;
        nfull = (split_tail && G == 256 && (nwg % 256) == 64) ? nwg - 64 : nwg; }
    __device__ __forceinline__ void tile(long L, Unit& u) const {
        int wgid = (int)L; { const int q = nwg / NXCD, r = nwg % NXCD, xcd = wgid % NXCD, off = wgid / NXCD; wgid = (xcd < r ? xcd * (q + 1) : r * (q + 1) + (xcd - r) * q) + off; }
        const int nig = WGM * nN, gid = wgid / nig, fm = gid * WGM, gsz = (nM - fm) < WGM ? (nM - fm) : WGM;
        u.pm = fm + ((wgid % nig) % gsz); u.pn = (wgid % nig) / gsz; }
    __device__ __forceinline__ bool next(int i, Unit& u) const {
        const int ti = (halves == 2) ? (i >> 1) : i, hf = (halves == 2) ? (i & 1) : 0;
        if (gA > 0) { int L2; if (c >= gA) { L2 = i * (G - gA) + (c - gA); if (L2 >= nBt) return false; } else { if (i >= tA) return false; L2 = nBt + i * gA + c; }
            tile(L2, u); u.kt0 = 0; u.mode = 2; u.nt = nth; u.tt = 0; return true; }
        const int L = ti * G + c;
        if (part == 0) { if (L >= nfull + nextra) return false; if (L >= nfull) { u.pm = ex_pm; u.pn = ex_pn0 + (L - nfull); } else tile(L, u); u.kt0 = hf * nth + ((khalf_pn > 0 && u.pn >= khalf_pn) ? nth : 0); u.mode = (halves == 2) ? hf : 2; u.nt = nth; u.tt = 0; return true; }
        if (nfull == nwg || i != 0) return false;
        const int xcd = c & 7, j = c >> 3, q = j & 3; u.tt = xcd + 8 * (j >> 2);
        tile((long)nfull + u.tt, u); u.nt = (halves * nth) / 4; u.kt0 = q * u.nt; u.mode = 4 + q; return true;
    }
};

struct TailCtx { float* slabs; unsigned* cnt; volatile LAS unsigned* flag; };
__device__ __forceinline__ void tail_exchange(f32x4 (&acc)[2][2][4][2], const Unit& u, const TailCtx& T, int wid, int lane) {
    const int q = u.mode - 4;
    float* base = T.slabs + (size_t)u.tt * 4 * 65536 + (size_t)(wid * 32) * 256 + lane * 4;
    { float* my = base + (size_t)q * 65536;
#pragma unroll
      for (int ai = 0; ai < 2; ++ai)
#pragma unroll
        for (int bj = 0; bj < 2; ++bj) if (ai * 2 + bj != q) {
#pragma unroll
            for (int m = 0; m < 4; ++m)
#pragma unroll
                for (int n = 0; n < 2; ++n) *(f32x4*)(my + (((ai * 2 + bj) * 4 + m) * 2 + n) * 256) = acc[ai][bj][m][n]; } }
    asm volatile("s_waitcnt vmcnt(0)" ::: "memory");
    __builtin_amdgcn_s_barrier();
    if (wid == 0 && lane == 0) {
        __builtin_amdgcn_fence(__ATOMIC_RELEASE, "agent");
        asm volatile("s_waitcnt vmcnt(0)" ::: "memory");
        (void)__hip_atomic_fetch_add(T.cnt + 16 * u.tt, 1u, __ATOMIC_RELAXED, __HIP_MEMORY_SCOPE_AGENT);
        unsigned sp = 0;
        while (__hip_atomic_load(T.cnt + 16 * u.tt, __ATOMIC_RELAXED, __HIP_MEMORY_SCOPE_AGENT) < 4u) { __builtin_amdgcn_s_sleep(2); if (++sp > (1u << 22)) break; }
        __builtin_amdgcn_fence(__ATOMIC_ACQUIRE, "agent");
        asm volatile("s_waitcnt vmcnt(0)" ::: "memory");
    }
    asm volatile("s_waitcnt vmcnt(0) lgkmcnt(0)" ::: "memory");
    __builtin_amdgcn_s_barrier();
    asm volatile("" ::: "memory");
#pragma unroll
    for (int ai = 0; ai < 2; ++ai)
#pragma unroll
        for (int bj = 0; bj < 2; ++bj) if (ai * 2 + bj == q) {
            f32x4 tv[3][4][2];
#pragma unroll
            for (int o = 0; o < 3; ++o) { const int qq = (q + 1 + o) & 3; const float* ot = base + (size_t)qq * 65536;
#pragma unroll
                for (int m = 0; m < 4; ++m)
#pragma unroll
                    for (int n = 0; n < 2; ++n) tv[o][m][n] = *(const f32x4*)(ot + (((ai * 2 + bj) * 4 + m) * 2 + n) * 256); }
#pragma unroll
            for (int m = 0; m < 4; ++m)
#pragma unroll
                for (int n = 0; n < 2; ++n) acc[ai][bj][m][n] += (tv[0][m][n] + tv[1][m][n]) + tv[2][m][n];
        }
}

__device__ __forceinline__ unsigned cvt_pk_bf16(float lo, float hi) { unsigned r; asm volatile("v_cvt_pk_bf16_f32 %0, %1, %2" : "=v"(r) : "v"(lo), "v"(hi)); return r; }

typedef int i32x4_t __attribute__((ext_vector_type(4))); typedef int i32x8_t __attribute__((ext_vector_type(8)));
__device__ __forceinline__ i32x8_t cat8(bf16x8 lo, bf16x8 hi) { return __builtin_shufflevector(__builtin_bit_cast(i32x4_t, lo), __builtin_bit_cast(i32x4_t, hi), 0, 1, 2, 3, 4, 5, 6, 7); }
template <class Epi, bool ALIGN_EPI, bool SP2, bool F8 = false>
__device__ __forceinline__ void gemm_phase(LAS unsigned char* lds, const Gemm g, const TileOrder& S, const Epi& E, const int tid) {
    const int wid = __builtin_amdgcn_readfirstlane(tid >> 6), lane = tid & 63, wr = wid >> 2, wc = wid & 3, fr = lane & 15, fq = lane >> 4;
    unsigned voffA[2], voffB[2];
#pragma unroll
    for (int i = 0; i < 2; ++i) { int R, C; stage_rc(tid * 16 + i * 8192, R, C); const int Rb = Epi::PERM ? ((R & ~31) + perm32(R & 31)) : R;
        voffA[i] = g.ablk ? (unsigned)(tid * 16 + i * 8192) : (unsigned)(R * g.lda + C) * 2u; voffB[i] = g.bblk ? (unsigned)(tid * 16 + i * 8192) : (unsigned)(Rb * g.ldb + C) * 2u; }
    const size_t kstepA = g.ablk ? (size_t)HTB : (size_t)(BK * 2), kstepB = g.bblk ? (size_t)HTB : (size_t)(BK * 2);
    const size_t hstepA = g.ablk ? (size_t)g.ablk * HTB : (size_t)HALF * g.lda * 2, hstepB = g.bblk ? (size_t)g.bblk * HTB : (size_t)HALF * g.ldb * 2;
    const size_t tstepA = 2 * hstepA, tstepB = 2 * hstepB;
    const unsigned ldsw = (unsigned)wid * 1024u;
    const int aoff = lds_byte(wr * 64 + fr, fq * 8), boff = lds_byte(wc * 32 + fr, fq * 8);
#define PG8_SA(b, h) (((b) * 2 + (h)) * HTB)
#define PG8_SB(b, h) ((4 + (b) * 2 + (h)) * HTB)
#define PG8_STAGE(bufoff, gbase, voff) do { _Pragma("unroll") for (int _i = 0; _i < 2; ++_i) { unsigned vo_ = (voff)[_i]; asm volatile("" : "+v"(vo_));     \
        __builtin_amdgcn_global_load_lds((const unsigned*)((const char*)(gbase) + vo_), (LAS unsigned*)(lds + (bufoff) + ldsw + _i * 8192), 16, 0, 0); } } while (0)
#define PG8_LDA(dst, b, h) do { _Pragma("unroll") for (int m = 0; m < 4; ++m) { const i32x4_t l0_ = *(const LAS i32x4_t*)(lds + PG8_SA(b, h) + aoff + m * 2048), l1_ = *(const LAS i32x4_t*)(lds + PG8_SA(b, h) + aoff + m * 2048 + 1024); \
        dst[m] = __builtin_shufflevector(l0_, l1_, 0, 1, 2, 3, 4, 5, 6, 7); } } while (0)
#define PG8_LDB(dst, b, h) do { _Pragma("unroll") for (int n = 0; n < 2; ++n) { const i32x4_t l0_ = *(const LAS i32x4_t*)(lds + PG8_SB(b, h) + boff + n * 2048), l1_ = *(const LAS i32x4_t*)(lds + PG8_SB(b, h) + boff + n * 2048 + 1024); \
        dst[n] = __builtin_shufflevector(l0_, l1_, 0, 1, 2, 3, 4, 5, 6, 7); } } while (0)
#define PG8_H(x, k) __builtin_bit_cast(bf16x8, __builtin_shufflevector(x, x, 4 * (k), 4 * (k) + 1, 4 * (k) + 2, 4 * (k) + 3))
#define PG8_MMA(ai, bj, At, Bt) do { __builtin_amdgcn_s_setprio(1); _Pragma("unroll") for (int m = 0; m < 4; ++m) _Pragma("unroll") for (int n = 0; n < 2; ++n) { \
        if constexpr (F8) acc[ai][bj][m][n] = __builtin_amdgcn_mfma_scale_f32_16x16x128_f8f6f4(Bt[n], At[m], acc[ai][bj][m][n], 0, 0, 0, 0x7F7F7F7F, 0, 0x7F7F7F7F); \
        else { acc[ai][bj][m][n] = __builtin_amdgcn_mfma_f32_16x16x32_bf16(PG8_H(Bt[n], 0), PG8_H(At[m], 0), acc[ai][bj][m][n], 0, 0, 0); \
               acc[ai][bj][m][n] = __builtin_amdgcn_mfma_f32_16x16x32_bf16(PG8_H(Bt[n], 1), PG8_H(At[m], 1), acc[ai][bj][m][n], 0, 0, 0); } } \
        __builtin_amdgcn_s_setprio(0); } while (0)
#define PG8_WAIT_V(n) asm volatile("s_waitcnt vmcnt(" #n ")" ::: "memory")
#define PG8_WAIT_L(n) asm volatile("s_waitcnt lgkmcnt(" #n ")" ::: "memory")
#define PG8_BAR __builtin_amdgcn_s_barrier()
#define PG8_SCHED __builtin_amdgcn_sched_barrier(0)
    Unit cur, nxt; int ui = 0;
    if (!S.next(0, cur)) return;
    f32x4 acc[2][2][4][2];
#pragma unroll
    for (int a = 0; a < 2; ++a)
#pragma unroll
        for (int b = 0; b < 2; ++b)
#pragma unroll
            for (int m = 0; m < 4; ++m)
#pragma unroll
                for (int n = 0; n < 2; ++n) acc[a][b][m][n] = (f32x4){0.f, 0.f, 0.f, 0.f};
    i32x8_t At[4], B0[2], B1[2];
    const char* cA = (const char*)g.A + (size_t)cur.pm * tstepA + (size_t)cur.kt0 * kstepA; const char* cB = (const char*)g.Bt + (size_t)cur.pn * tstepB + (size_t)cur.kt0 * kstepB;
    if constexpr (SP2) {
        PG8_STAGE(PG8_SB(0, 0), cB, voffB); PG8_STAGE(PG8_SB(0, 1), cB + hstepB, voffB); PG8_STAGE(PG8_SA(0, 0), cA, voffA); PG8_STAGE(PG8_SA(0, 1), cA + hstepA, voffA);
        if (wr == 1) PG8_BAR;
        PG8_WAIT_V(2); PG8_BAR;
        PG8_STAGE(PG8_SB(1, 0), cB + kstepB, voffB); PG8_STAGE(PG8_SA(1, 0), cA + kstepA, voffA); PG8_STAGE(PG8_SB(1, 1), cB + hstepB + kstepB, voffB);
        PG8_WAIT_V(6); PG8_BAR;
    } else {
        PG8_STAGE(PG8_SB(0, 0), cB, voffB); PG8_STAGE(PG8_SA(0, 0), cA, voffA); PG8_STAGE(PG8_SB(0, 1), cB + hstepB, voffB); PG8_STAGE(PG8_SA(0, 1), cA + hstepA, voffA);
        if (wr == 1) PG8_BAR;
        PG8_WAIT_V(4); PG8_BAR;
        PG8_STAGE(PG8_SB(1, 0), cB + kstepB, voffB); PG8_STAGE(PG8_SA(1, 0), cA + kstepA, voffA); PG8_STAGE(PG8_SB(1, 1), cB + hstepB + kstepB, voffB);
        PG8_WAIT_V(6); PG8_BAR;
    }
    for (;;) {
        const bool has_next = S.next(ui + 1, nxt);
        const char* nA = has_next ? (const char*)g.A + (size_t)nxt.pm * tstepA + (size_t)nxt.kt0 * kstepA : cA; const char* nB = has_next ? (const char*)g.Bt + (size_t)nxt.pn * tstepB + (size_t)nxt.kt0 * kstepB : cB;
        const int nt = cur.nt;
        for (int t = 0; t < nt; t += 2) {
            const bool last = (t == nt - 2);
            const char* a1 = cA + (size_t)(t + 1) * kstepA;
            const char* a2 = last ? nA : cA + (size_t)(t + 2) * kstepA; const char* b2 = last ? nB : cB + (size_t)(t + 2) * kstepB;
            const char* a3 = a2 + kstepA; const char* b3 = b2 + kstepB;
            if constexpr (SP2) {
            PG8_LDB(B0, 0, 0); PG8_LDB(B1, 0, 1); PG8_SCHED; PG8_LDA(At, 0, 0); PG8_STAGE(PG8_SA(1, 1), a1 + hstepA, voffA);
            PG8_WAIT_V(8); PG8_WAIT_L(0); PG8_BAR; PG8_MMA(0, 0, At, B0); PG8_MMA(0, 1, At, B1); PG8_BAR; PG8_SCHED;
            PG8_LDA(At, 0, 1); PG8_STAGE(PG8_SB(0, 0), b2, voffB); PG8_STAGE(PG8_SB(0, 1), b2 + hstepB, voffB); PG8_STAGE(PG8_SA(0, 0), a2, voffA);
            PG8_WAIT_V(8); PG8_WAIT_L(0); PG8_BAR; PG8_MMA(1, 0, At, B0); PG8_MMA(1, 1, At, B1); PG8_BAR; PG8_SCHED;
            PG8_LDB(B0, 1, 0); PG8_LDB(B1, 1, 1); PG8_SCHED; PG8_LDA(At, 1, 0); PG8_STAGE(PG8_SA(0, 1), a2 + hstepA, voffA);
            PG8_WAIT_V(8); PG8_WAIT_L(0); PG8_BAR; PG8_MMA(0, 0, At, B0); PG8_MMA(0, 1, At, B1); PG8_BAR; PG8_SCHED;
            PG8_LDA(At, 1, 1); PG8_STAGE(PG8_SB(1, 0), b3, voffB); PG8_STAGE(PG8_SB(1, 1), b3 + hstepB, voffB); PG8_STAGE(PG8_SA(1, 0), a3, voffA);
            PG8_WAIT_V(8); PG8_WAIT_L(0); PG8_BAR; PG8_MMA(1, 0, At, B0); PG8_MMA(1, 1, At, B1); PG8_BAR; PG8_SCHED;
            } else {
            PG8_LDB(B0, 0, 0); PG8_SCHED; PG8_LDA(At, 0, 0); PG8_STAGE(PG8_SA(1, 1), a1 + hstepA, voffA);
            PG8_WAIT_L(8); PG8_BAR; PG8_WAIT_L(0); PG8_MMA(0, 0, At, B0); PG8_BAR; PG8_SCHED;
            PG8_LDB(B1, 0, 1); PG8_STAGE(PG8_SB(0, 0), b2, voffB);
            PG8_BAR; PG8_WAIT_L(0); PG8_MMA(0, 1, At, B1); PG8_BAR;
            PG8_LDA(At, 0, 1); PG8_STAGE(PG8_SA(0, 0), a2, voffA);
            PG8_BAR; PG8_WAIT_L(0); PG8_MMA(1, 0, At, B0); PG8_BAR; PG8_SCHED;
            PG8_STAGE(PG8_SB(0, 1), b2 + hstepB, voffB);
            PG8_WAIT_V(6); PG8_BAR; PG8_MMA(1, 1, At, B1); PG8_BAR;
            PG8_LDB(B0, 1, 0); PG8_SCHED; PG8_LDA(At, 1, 0); PG8_STAGE(PG8_SA(0, 1), a2 + hstepA, voffA);
            PG8_WAIT_L(8); PG8_BAR; PG8_WAIT_L(0); PG8_MMA(0, 0, At, B0); PG8_BAR; PG8_SCHED;
            PG8_LDB(B1, 1, 1); PG8_STAGE(PG8_SB(1, 0), b3, voffB);
            PG8_BAR; PG8_WAIT_L(0); PG8_MMA(0, 1, At, B1); PG8_BAR;
            PG8_LDA(At, 1, 1); PG8_STAGE(PG8_SA(1, 0), a3, voffA);
            PG8_BAR; PG8_WAIT_L(0); PG8_MMA(1, 0, At, B0); PG8_BAR; PG8_SCHED;
            PG8_STAGE(PG8_SB(1, 1), b3 + hstepB, voffB);
            PG8_WAIT_V(6); PG8_BAR; PG8_MMA(1, 1, At, B1); PG8_BAR;
            }
        }
        if constexpr (ALIGN_EPI) { if (wr == 0) PG8_BAR; }
        E(acc, cur, wr, wc, fr, fq);
        if (!has_next) break;
        if (cur.mode != 0) {
#pragma unroll
        for (int a = 0; a < 2; ++a)
#pragma unroll
            for (int b = 0; b < 2; ++b)
#pragma unroll
                for (int m = 0; m < 4; ++m)
#pragma unroll
                    for (int n = 0; n < 2; ++n) acc[a][b][m][n] = (f32x4){0.f, 0.f, 0.f, 0.f};
        }
        cur = nxt; cA = nA; cB = nB; ++ui;
        if constexpr (ALIGN_EPI) { if (wr == 1) PG8_BAR; }
    }
    PG8_WAIT_V(0);
    if constexpr (!ALIGN_EPI) { if (wr == 0) PG8_BAR; }
    PG8_BAR;
#undef PG8_SA
#undef PG8_SB
#undef PG8_STAGE
#undef PG8_LDA
#undef PG8_LDB
#undef PG8_MMA
#undef PG8_H
#undef PG8_WAIT_V
#undef PG8_WAIT_L
#undef PG8_BAR
#undef PG8_SCHED
}

struct EpiZ {
    static constexpr bool PERM = true;
    bf16_t* O; int ldc; int split, split2, off0, off1, off2; float sc; unsigned char* G; int gpn0;
    __device__ __forceinline__ void operator()(f32x4 (&acc)[2][2][4][2], const Unit& u, int wr, int wc, int fr, int fq) const {
        if (u.pn >= gpn0) {
            unsigned char* gp = G + ((size_t)u.pm * 32 + (u.pn - gpn0)) * GTILE + (size_t)(wr * 4 + wc) * 16384 + lane_id_opaque() * 16;
#pragma unroll
            for (int ai = 0; ai < 2; ++ai)
#pragma unroll
                for (int m = 0; m < 4; ++m)
#pragma unroll
                    for (int bj = 0; bj < 2; ++bj) { const f32x4 v0 = acc[ai][bj][m][0] * sc, v1 = acc[ai][bj][m][1] * sc;
                        u32x4 w; w.x = cvt_pk_bf16(v0[0], v0[1]); w.y = cvt_pk_bf16(v0[2], v0[3]); w.z = cvt_pk_bf16(v1[0], v1[1]); w.w = cvt_pk_bf16(v1[2], v1[3]);
                        __builtin_nontemporal_store(w, (u32x4*)(gp + ((ai * 4 + m) * 2 + bj) * 1024)); }
            return; }
        const int row0 = u.pm * BM + wr * 64 + fr, col0 = (u.pn < split ? off0 + u.pn * BM : (u.pn < split2 ? off1 + (u.pn - split) * BM : off2 + (u.pn - split2) * BM)) + wc * 32 + 8 * fq;
#pragma unroll
        for (int ai = 0; ai < 2; ++ai)
#pragma unroll
            for (int m = 0; m < 4; ++m) { bf16_t* rowp = O + (size_t)(row0 + ai * HALF + m * 16) * ldc + col0;
#pragma unroll
                for (int bj = 0; bj < 2; ++bj) { const f32x4 v0 = acc[ai][bj][m][0] * sc, v1 = acc[ai][bj][m][1] * sc;
                    u32x4 w; w.x = cvt_pk_bf16(v0[0], v0[1]); w.y = cvt_pk_bf16(v0[2], v0[3]); w.z = cvt_pk_bf16(v1[0], v1[1]); w.w = cvt_pk_bf16(v1[2], v1[3]);
                    __builtin_nontemporal_store(w, (u32x4*)(rowp + bj * HALF)); } }
    }
};
struct EpiLora {
    static constexpr bool PERM = true;
    bf16_t* DW; bf16_t* AA; const float* w0; const float* a0;
    __device__ __forceinline__ void operator()(f32x4 (&acc)[2][2][4][2], const Unit& u, int wr, int wc, int fr, int fq) const {
        const int row0 = u.pm * BM + wr * 64 + fr; const bool isw = u.pn < 8; const int colt = (isw ? u.pn : u.pn - 8) * BM + wc * 32 + 8 * fq;
        bf16_t* outp = isw ? DW : AA; const float* bias = isw ? w0 : a0; const float sc = isw ? -0.6065306597126334f : 1.0f;
        f32x4 bv[2][2];
#pragma unroll
        for (int bj = 0; bj < 2; ++bj)
#pragma unroll
            for (int n = 0; n < 2; ++n) bv[bj][n] = *(const f32x4*)(bias + colt + bj * HALF + 4 * n);
#pragma unroll
        for (int ai = 0; ai < 2; ++ai)
#pragma unroll
            for (int m = 0; m < 4; ++m) { bf16_t* rowp = outp + (size_t)(row0 + ai * HALF + m * 16) * RW + colt;
#pragma unroll
                for (int bj = 0; bj < 2; ++bj) { float o[8];
#pragma unroll
                    for (int n = 0; n < 2; ++n) { const f32x4 x = acc[ai][bj][m][n] + bv[bj][n];
#pragma unroll
                        for (int j = 0; j < 4; ++j) o[4 * n + j] = sc * frcp(1.0f + __expf(-x[j])); }
                    u32x4 w; w.x = cvt_pk_bf16(o[0], o[1]); w.y = cvt_pk_bf16(o[2], o[3]); w.z = cvt_pk_bf16(o[4], o[5]); w.w = cvt_pk_bf16(o[6], o[7]);
                    *(u32x4*)(rowp + bj * HALF) = w; } }
    }
};
struct EpiMix {
    static constexpr bool PERM = true;
    const unsigned char* Z; unsigned char* O;
    __device__ __forceinline__ void operator()(f32x4 (&acc)[2][2][4][2], const Unit& u, int wr, int wc, int fr_, int fq_) const {
        const int l_ = lane_id_opaque(), fr = l_ & 15, fq = l_ >> 4;
        const int row0 = u.pm * BM + wr * 64 + fr, col0 = u.pn * BM + wc * 32 + 8 * fq;
        const unsigned char* Z = this->Z; unsigned char* O = this->O; asm volatile("" : "+s"(Z), "+s"(O));
        const unsigned char* gR = Z + ((size_t)u.pm * 32 + u.pn) * GTILE + (size_t)(wr * 4 + wc) * 16384 + l_ * 16; const unsigned char* gA = gR + 16 * GTILE;
        const bool m0_ = (u.mode == 0);
        bf16x8 gaA[2], grA[2], gaB[2], grB[2];
#define EM_LOAD(GA, GR, it_) do { GA[0] = *(const bf16x8*)(gA + ((it_) * 2) * 1024); GA[1] = *(const bf16x8*)(gA + ((it_) * 2 + 1) * 1024); \
            if (m0_) { GR[0] = *(const bf16x8*)(gR + ((it_) * 2) * 1024); GR[1] = *(const bf16x8*)(gR + ((it_) * 2 + 1) * 1024); } } while (0)
#define EM_FIN(GA, GR, it_) do { const int ai_ = (it_) >> 2, m_ = (it_) & 3; const size_t r_ = (size_t)(row0 + ai_ * HALF + m_ * 16); \
            _Pragma("unroll") for (int bj = 0; bj < 2; ++bj) { \
                if (m0_) { \
                    _Pragma("unroll") for (int n = 0; n < 2; ++n) _Pragma("unroll") for (int j = 0; j < 4; ++j) { \
                        const float ea = __expf(-bfs2f(GA[bj][4 * n + j])), er = __expf(-bfs2f(GR[bj][4 * n + j])); acc[ai_][bj][m_][n][j] *= (1.0f + ea) * frcp(1.0f + er); } \
                } else { float v[8]; \
                    _Pragma("unroll") for (int n = 0; n < 2; ++n) _Pragma("unroll") for (int j = 0; j < 4; ++j) \
                        v[4 * n + j] = acc[ai_][bj][m_][n][j] * (1.0f / 64.0f) * frcp(1.0f + __expf(-bfs2f(GA[bj][4 * n + j]))); \
                    *(u32x2*)(O + r_ * D + col0 + bj * HALF) = (u32x2){pk4_fp8(v[0], v[1], v[2], v[3]), pk4_fp8(v[4], v[5], v[6], v[7])}; } } \
            asm volatile("" ::: "memory"); } while (0)
        EM_LOAD(gaA, grA, 0);
#pragma unroll
        for (int it = 0; it < 8; it += 2) { EM_LOAD(gaB, grB, it + 1); EM_FIN(gaA, grA, it); if (it + 2 < 8) EM_LOAD(gaA, grA, it + 2); EM_FIN(gaB, grB, it + 1); }
#undef EM_LOAD
#undef EM_FIN
    }
};
struct EpiH {
    static constexpr bool PERM = true;
    const float* xp; const float* xs; bf16_t* H;
    __device__ __forceinline__ void operator()(f32x4 (&acc)[2][2][4][2], const Unit& u, int wr, int wc, int fr, int fq, int quad = -1) const {
        const int row0 = u.pm * BM + wr * 64 + fr, col0 = u.pn * BM + wc * 32 + 8 * fq;
#pragma unroll
        for (int ai = 0; ai < 2; ++ai)
#pragma unroll
            for (int m = 0; m < 4; ++m) { if (quad >= 0 && (quad >> 1) != ai) continue;
                const int r = row0 + ai * HALF + m * 16; const float* xr = (r < M_P) ? xp + (size_t)r * D : xs + (size_t)(r - M_P) * D; bf16_t* hr = H + (size_t)r * D;
#pragma unroll
                for (int bj = 0; bj < 2; ++bj) { if (quad >= 0 && (quad & 1) != bj) continue;
                    const int c = col0 + bj * HALF; const f32x4 x0 = __builtin_nontemporal_load((const f32x4*)(xr + c)), x1 = __builtin_nontemporal_load((const f32x4*)(xr + c + 4));
                    const f32x4 v0 = x0 * ALPHA + acc[ai][bj][m][0] * (1.0f / 64.0f), v1 = x1 * ALPHA + acc[ai][bj][m][1] * (1.0f / 64.0f);
                    u32x4 w; w.x = cvt_pk_bf16(v0[0], v0[1]); w.y = cvt_pk_bf16(v0[2], v0[3]); w.z = cvt_pk_bf16(v1[0], v1[1]); w.w = cvt_pk_bf16(v1[2], v1[3]);
                    *(u32x4*)(hr + c) = w; }
                asm volatile("" ::: "memory"); }
    }
};
struct EpiMixTail {
    static constexpr bool PERM = true;
    const unsigned char* Z; unsigned char* O; TailCtx T;
    __device__ __forceinline__ void operator()(f32x4 (&acc)[2][2][4][2], const Unit& u, int wr, int wc, int fr_, int fq_) const {
        const int l_ = lane_id_opaque(), fr = l_ & 15, fq = l_ >> 4;
        const int row0 = u.pm * BM + wr * 64 + fr, col0 = u.pn * BM + wc * 32 + 8 * fq;
        {
            const unsigned char* Zg = this->Z; asm volatile("" : "+s"(Zg));
            const unsigned char* gQ = Zg + ((size_t)u.pm * 32 + ((u.mode < 6) ? 0 : 16) + u.pn) * GTILE + (size_t)(wr * 4 + wc) * 16384 + l_ * 16;
#pragma unroll
            for (int ai = 0; ai < 2; ++ai)
#pragma unroll
                for (int m = 0; m < 4; ++m) {
#pragma unroll
                    for (int bj = 0; bj < 2; ++bj) { const bf16x8 gg = *(const bf16x8*)(gQ + ((ai * 4 + m) * 2 + bj) * 1024);
#pragma unroll
                        for (int n = 0; n < 2; ++n)
#pragma unroll
                            for (int j = 0; j < 4; ++j) acc[ai][bj][m][n][j] *= frcp(1.0f + __expf(-bfs2f(gg[4 * n + j]))); } }
            tail_exchange(acc, u, T, wr * 4 + wc, fq * 16 + fr);
            const int q = u.mode - 4;
#pragma unroll
            for (int ai = 0; ai < 2; ++ai)
#pragma unroll
              for (int bj = 0; bj < 2; ++bj) if (ai * 2 + bj == q) {
#pragma unroll
                for (int m = 0; m < 4; ++m) { const size_t r = (size_t)(row0 + ai * HALF + m * 16);
                    const f32x4 v0 = acc[ai][bj][m][0] * (1.0f / 64.0f), v1 = acc[ai][bj][m][1] * (1.0f / 64.0f);
                    *(u32x2*)(O + r * D + col0 + bj * HALF) = (u32x2){pk4_fp8(v0[0], v0[1], v0[2], v0[3]), pk4_fp8(v1[0], v1[1], v1[2], v1[3])}; } }
            return;
        }
    }
};
struct EpiHTail {
    static constexpr bool PERM = false;
    const float* xp; const float* xs; bf16_t* H; TailCtx T;
    __device__ __forceinline__ void operator()(f32x4 (&acc)[2][2][4][2], const Unit& u, int wr, int wc, int fr_, int fq_) const {
        tail_exchange(acc, u, T, wr * 4 + wc, lane_id_opaque());
        const int l_ = lane_id_opaque();
        EpiH E{xp, xs, H}; E(acc, u, wr, wc, l_ & 15, l_ >> 4, u.mode - 4);
    }
};
}

struct Args { const float* in[23]; float* out; unsigned char* ws; int ph_lo, ph_hi; };

__device__ __forceinline__ void p0_transpose_item_f8(const float* W, int N, int nbs, unsigned char* W8, LAS float* scr, int kb, int nb, int lane, int koff = 0) {
    const int k0 = 64 * kb, n0 = 32 * nb;
    f32x4 wv[8];
#pragma unroll
    for (int i = 0; i < 8; ++i) wv[i] = __builtin_nontemporal_load((const f32x4*)(W + (size_t)(k0 + 8 * i + (lane >> 3)) * N + 32 * nbs + (lane & 7) * 4));
#pragma unroll
    for (int i = 0; i < 8; ++i) { LAS float* d = scr + (8 * i + (lane >> 3)) * 33 + (i >> 2) * 16 + (lane & 7) * 4; d[0] = wv[i][0]; d[1] = wv[i][1]; d[2] = wv[i][2]; d[3] = wv[i][3]; }
    LDS_WAIT();
    const int c2 = lane & 1, n = lane >> 1; const LAS float* sp = scr + (16 * c2) * 33 + n;
    const int ng = n0 + n, nl = ng & 127, x = nl & 31, slot = (nl & ~31) + 16 * ((x >> 2) & 1) + 4 * (x >> 3) + (x & 3); const int kd = koff + k0;
    unsigned char* dst = W8 + ((size_t)(ng >> 7) * 32 + (kd >> 7)) * pg8::HTB;
#pragma unroll
    for (int j = 0; j < 2; ++j) { const LAS float* s2 = sp + (32 * j) * 33 + 16 * j;
        u32x4 o; o.x = pk4_fp8(s2[0 * 33] * 64.f, s2[1 * 33] * 64.f, s2[2 * 33] * 64.f, s2[3 * 33] * 64.f); o.y = pk4_fp8(s2[4 * 33] * 64.f, s2[5 * 33] * 64.f, s2[6 * 33] * 64.f, s2[7 * 33] * 64.f);
        o.z = pk4_fp8(s2[8 * 33] * 64.f, s2[9 * 33] * 64.f, s2[10 * 33] * 64.f, s2[11 * 33] * 64.f); o.w = pk4_fp8(s2[12 * 33] * 64.f, s2[13 * 33] * 64.f, s2[14 * 33] * 64.f, s2[15 * 33] * 64.f);
        const int kbyte = (kd & 127) + 32 * j + 16 * c2;
        *(u32x4*)(dst + pg8::lds_byte(slot, kbyte >> 1)) = o; }
    LDS_WAIT();
}
__device__ __forceinline__ void p0_transpose_item(const float* W, int N, bf16_t* WT, int ldt, int koff, int row_off, LAS float* scr, int kb, int nb, int lane, int ktiles = 0, bool perm = false, int nbs = -1) {
    const int k0 = 32 * kb, n0 = 64 * nb, n0s = 64 * (nbs < 0 ? nb : nbs);
    f32x4 wv[8];
#pragma unroll
    for (int i = 0; i < 8; ++i) wv[i] = __builtin_nontemporal_load((const f32x4*)(W + (size_t)(k0 + 4 * i + (lane >> 4)) * N + n0s + (lane & 15) * 4));
#pragma unroll
    for (int i = 0; i < 8; ++i) { LAS float* d = scr + (4 * i + (lane >> 4)) * 65 + (lane & 15) * 4; d[0] = wv[i][0]; d[1] = wv[i][1]; d[2] = wv[i][2]; d[3] = wv[i][3]; }
    LDS_WAIT();
    const int c = lane & 3;
#pragma unroll
    for (int j = 0; j < 4; ++j) { const int n = (lane >> 2) + 16 * j; const LAS float* sp = scr + (8 * c) * 65 + n;
        u32x4 o; o.x = pk2(sp[0 * 65], sp[1 * 65]); o.y = pk2(sp[2 * 65], sp[3 * 65]); o.z = pk2(sp[4 * 65], sp[5 * 65]); o.w = pk2(sp[6 * 65], sp[7 * 65]);
        const int kg = koff + k0 + 8 * c;
        if (ktiles == 0) *(u32x4*)(WT + (size_t)(row_off + n0 + n) * ldt + kg) = o;
        else { const int ng = row_off + n0 + n, nl = ng & 127, x = nl & 31; const int slot = perm ? ((nl & ~31) + 16 * ((x >> 2) & 1) + 4 * (x >> 3) + (x & 3)) : nl;
            *(u32x4*)((unsigned char*)WT + ((size_t)(ng >> 7) * ktiles + (kg >> 6)) * pg8::HTB + pg8::lds_byte(slot, kg & 63)) = o; } }
    LDS_WAIT();
}

__device__ __forceinline__ void p0_item_load(f32x4 (&wv)[8], const float* W, int N, int row, int col, int shape, int lane) {
    const int rs = shape ? 8 : 4, lr = shape ? (lane >> 3) : (lane >> 4), lc = shape ? (lane & 7) : (lane & 15);
#pragma unroll
    for (int i = 0; i < 8; ++i) wv[i] = __builtin_nontemporal_load((const f32x4*)(W + (size_t)(row + rs * i + lr) * N + col + lc * 4));
}
__device__ __forceinline__ void p0_item_fin_bf16(const f32x4 (&wv)[8], bf16_t* WT, int koff, int row_off, LAS float* scr, int kb, int nb, int lane, int ktiles) {
    const int k0 = 32 * kb, n0 = 64 * nb;
#pragma unroll
    for (int i = 0; i < 8; ++i) { LAS float* d = scr + (4 * i + (lane >> 4)) * 65 + (lane & 15) * 4; d[0] = wv[i][0]; d[1] = wv[i][1]; d[2] = wv[i][2]; d[3] = wv[i][3]; }
    LDS_WAIT();
    const int c = lane & 3;
#pragma unroll
    for (int j = 0; j < 4; ++j) { const int n = (lane >> 2) + 16 * j; const LAS float* sp = scr + (8 * c) * 65 + n;
        u32x4 o; o.x = pk2(sp[0 * 65], sp[1 * 65]); o.y = pk2(sp[2 * 65], sp[3 * 65]); o.z = pk2(sp[4 * 65], sp[5 * 65]); o.w = pk2(sp[6 * 65], sp[7 * 65]);
        const int kg = koff + k0 + 8 * c;
        const int ng = row_off + n0 + n, nl = ng & 127, x = nl & 31; const int slot = (nl & ~31) + 16 * ((x >> 2) & 1) + 4 * (x >> 3) + (x & 3);
        *(u32x4*)((unsigned char*)WT + ((size_t)(ng >> 7) * ktiles + (kg >> 6)) * pg8::HTB + pg8::lds_byte(slot, kg & 63)) = o; }
    LDS_WAIT();
}
__device__ __forceinline__ void p0_item_fin_f8(const f32x4 (&wv)[8], unsigned char* W8, LAS float* scr, int kb, int nb, int lane) {
    const int k0 = 64 * kb, n0 = 32 * nb;
#pragma unroll
    for (int i = 0; i < 8; ++i) { LAS float* d = scr + (8 * i + (lane >> 3)) * 33 + (i >> 2) * 16 + (lane & 7) * 4; d[0] = wv[i][0]; d[1] = wv[i][1]; d[2] = wv[i][2]; d[3] = wv[i][3]; }
    LDS_WAIT();
    const int c2 = lane & 1, n = lane >> 1; const LAS float* sp = scr + (16 * c2) * 33 + n;
    const int ng = n0 + n, nl = ng & 127, x = nl & 31, slot = (nl & ~31) + 16 * ((x >> 2) & 1) + 4 * (x >> 3) + (x & 3);
    unsigned char* dst = W8 + ((size_t)(ng >> 7) * 32 + (k0 >> 7)) * pg8::HTB;
#pragma unroll
    for (int j = 0; j < 2; ++j) { const LAS float* s2 = sp + (32 * j) * 33 + 16 * j;
        u32x4 o; o.x = pk4_fp8(s2[0 * 33] * 64.f, s2[1 * 33] * 64.f, s2[2 * 33] * 64.f, s2[3 * 33] * 64.f); o.y = pk4_fp8(s2[4 * 33] * 64.f, s2[5 * 33] * 64.f, s2[6 * 33] * 64.f, s2[7 * 33] * 64.f);
        o.z = pk4_fp8(s2[8 * 33] * 64.f, s2[9 * 33] * 64.f, s2[10 * 33] * 64.f, s2[11 * 33] * 64.f); o.w = pk4_fp8(s2[12 * 33] * 64.f, s2[13 * 33] * 64.f, s2[14 * 33] * 64.f, s2[15 * 33] * 64.f);
        const int kbyte = (k0 & 127) + 32 * j + 16 * c2;
        *(u32x4*)(dst + pg8::lds_byte(slot, kbyte >> 1)) = o; }
    LDS_WAIT();
}

__device__ __forceinline__ void phase_convert(const Args& a, LAS unsigned char* lds, const int tid) {
    const int lane = tid & 63, wave = tid >> 6, G = gridDim.x;
    unsigned char* ws = a.ws;
    bf16_t* XB = (bf16_t*)(ws + WS_XB); bf16_t* W1T = (bf16_t*)(ws + WS_W1T); bf16_t* WLT = (bf16_t*)(ws + WS_WLT);
    LAS float* scr = (LAS float*)(lds + wave * 8704);
    const int gw = blockIdx.x * 8 + wave, NGW = G * 8;
    constexpr int I1 = 128 * 332, I5 = 4 * 32, I6 = 4 * 32, NIT = I1 + I5 + I6;
    constexpr int I7 = 128 * 32;
    static_assert(I1 + I5 + I6 == NIT, "items"); constexpr int NIT2 = NIT + I7;
#define P0_LOAD(R, it_) do { int r_ = (it_); const float* W_; int N_, row_, col_, sh_; \
        if (r_ < I1) { const int kb_ = r_ / 332, nb_ = r_ % 332; W_ = a.in[6]; N_ = NZ; \
            if ((nb_ >= 32 && nb_ < 100) || (nb_ >= 164 && nb_ < 172)) { sh_ = 0; row_ = 32 * kb_; col_ = 64 * nb_; } else { sh_ = 1; row_ = 64 * (kb_ >> 1); col_ = 32 * (2 * nb_ + (kb_ & 1)); } } \
        else if (r_ < I1 + I5) { r_ -= I1; W_ = a.in[9]; N_ = RW; sh_ = 0; row_ = 32 * (r_ / 32); col_ = 64 * (r_ % 32); } \
        else if (r_ < NIT) { r_ -= I1 + I5; W_ = a.in[11]; N_ = RW; sh_ = 0; row_ = 32 * (r_ / 32); col_ = 64 * (r_ % 32); } \
        else { r_ -= NIT; W_ = a.in[6]; N_ = NZ; sh_ = 0; row_ = 32 * (r_ / 32); col_ = 64 * (r_ % 32); } \
        p0_item_load(R, W_, N_, row_, col_, sh_, lane); } while (0)
#define P0_FIN(R, it_) do { int r_ = (it_); \
        if (r_ < I1) { const int kb_ = r_ / 332, nb_ = r_ % 332; \
            if (nb_ < 32) p0_item_fin_f8(R, ws + WS_W8T, scr, kb_ >> 1, 2 * nb_ + (kb_ & 1), lane); \
            else if (nb_ < 100) p0_item_fin_bf16(R, W1T, 0, 0, scr, kb_, nb_ - 32, lane, 64); \
            else if (nb_ < 164) p0_item_fin_f8(R, ws + WS_W8T, scr, kb_ >> 1, 2 * (32 + nb_ - 100) + (kb_ & 1), lane); \
            else if (nb_ < 172) p0_item_fin_bf16(R, W1T, 0, 0, scr, kb_, 68 + nb_ - 164, lane, 64); \
            else p0_item_fin_f8(R, ws + WS_W8T, scr, kb_ >> 1, 2 * (96 + nb_ - 172) + (kb_ & 1), lane); } \
        else if (r_ < I1 + I5) { r_ -= I1; p0_item_fin_bf16(R, WLT, 0, 0, scr, r_ / 32, r_ % 32, lane, 4); } \
        else if (r_ < NIT) { r_ -= I1 + I5; p0_item_fin_bf16(R, WLT, 128, 2048, scr, r_ / 32, r_ % 32, lane, 4); } \
        else { r_ -= NIT; p0_item_fin_bf16(R, W1T, 0, 0, scr, r_ / 32, 76 + r_ % 32, lane, 64); } } while (0)
    { f32x4 RA[8], RB[8];
      const int ntrip = (NIT2 - gw + NGW - 1) / NGW;
      { const int i0 = gw, i1 = (gw + NGW < NIT2) ? gw + NGW : NIT2 - 1; P0_LOAD(RA, i0); P0_LOAD(RB, i1); }
      for (int k = 0; k < ntrip; k += 2) {
          const int iA = gw + k * NGW, iB = iA + NGW, nA = (iB + NGW < NIT2) ? iB + NGW : NIT2 - 1, nB = (iB + 2 * NGW < NIT2) ? iB + 2 * NGW : NIT2 - 1;
          P0_FIN(RA, iA); P0_LOAD(RA, nA);
          if (k + 1 < ntrip) P0_FIN(RB, iB);
          P0_LOAD(RB, nB);
      } }
#undef P0_LOAD
#undef P0_FIN
    const size_t gt = (size_t)blockIdx.x * NTHREADS + tid, NGT = (size_t)G * NTHREADS;
    for (size_t i = gt; i < (size_t)4096 * 16; i += NGT) { const int n = (int)(i >> 4), cc = (int)(i & 15); const int kc = (n < 2048 ? 128 : 0) + 8 * cc;
        const int nl = n & 127, x = nl & 31, slot = (nl & ~31) + 16 * ((x >> 2) & 1) + 4 * (x >> 3) + (x & 3);
        *(u32x4*)((unsigned char*)WLT + ((size_t)(n >> 7) * 4 + (kc >> 6)) * pg8::HTB + pg8::lds_byte(slot, kc & 63)) = (u32x4){0u, 0u, 0u, 0u}; }
    for (size_t i = gt; i < (size_t)(M_X - NB_P - NB_S) * (D / 8); i += NGT) { const int rx = M + NB_P + NB_S + (int)(i / (D / 8)), k = (int)(i % (D / 8)) * 8;
        *(u32x4*)((unsigned char*)XB + ((size_t)(rx >> 7) * (D / 64) + (k >> 6)) * pg8::HTB + pg8::lds_byte(rx & 127, k & 63)) = (u32x4){0u, 0u, 0u, 0u}; }
    const float* xp = a.in[0]; const float* xs = a.in[1]; unsigned char* XB8 = ws + WS_XB8;
    for (int it0 = gw; it0 < (M / 16) * (D / 64); it0 += 2 * NGW) {
        f32x4 v[2][4];
#pragma unroll
        for (int u = 0; u < 2; ++u) { const int it = it0 + u * NGW; if (it < (M / 16) * (D / 64)) {
            const int rt = it / (D / 64), ct = it % (D / 64); const int row0 = rt * 16 + (lane >> 4), k = ct * 64 + (lane & 15) * 4;
            const float* src = (row0 < M_P) ? xp + (size_t)row0 * D + k : xs + (size_t)(row0 - M_P) * D + k;
#pragma unroll
            for (int i = 0; i < 4; ++i) v[u][i] = __builtin_nontemporal_load((const f32x4*)(src + (size_t)(4 * i) * D)); } }
#pragma unroll
        for (int u = 0; u < 2; ++u) { const int it = it0 + u * NGW; if (it < (M / 16) * (D / 64)) {
            const int rt = it / (D / 64), ct = it % (D / 64); const int k = ct * 64 + (lane & 15) * 4;
#pragma unroll
            for (int i = 0; i < 4; ++i) { const int row = rt * 16 + 4 * i + (lane >> 4);
                const u32x2 ob = (u32x2){pk2(v[u][i][0], v[u][i][1]), pk2(v[u][i][2], v[u][i][3])}; const unsigned o8 = pk4_fp8(v[u][i][0], v[u][i][1], v[u][i][2], v[u][i][3]);
                *(u32x2*)((unsigned char*)XB + ((size_t)(row >> 7) * (D / 64) + (k >> 6)) * pg8::HTB + pg8::lds_byte(row & 127, k & 63)) = ob;
                { const bool lastp = (row < M_P) && ((row & (TP - 1)) == TP - 1), lasts = (row >= M_P) && (((row - M_P) & (TS - 1)) == TS - 1);
                  if (lastp || lasts) { const int rx = M + (lastp ? (row >> 11) : NB_P + ((row - M_P) >> 3));
                      *(u32x2*)((unsigned char*)XB + ((size_t)(rx >> 7) * (D / 64) + (k >> 6)) * pg8::HTB + pg8::lds_byte(rx & 127, k & 63)) = ob; } }
                *(unsigned*)(XB8 + ((size_t)(row >> 7) * (D / 128) + (k >> 7)) * pg8::HTB + pg8::lds_byte(row & 127, (k & 127) >> 1)) = o8; } } }
    }
    f32x2* rope = (f32x2*)(ws + WS_ROPE);
    for (size_t i = gt; i < (size_t)2056 * 8; i += NGT) { const int p = (int)(i >> 3), ii = (int)(i & 7); const double pos = (p < 2048) ? (double)p : (double)(8192 + p - 2048);
        const double inv = pow(500000.0, -(double)ii / 8.0), ang = pos * inv; rope[i] = (f32x2){(float)cos(ang), (float)sin(ang)}; }
}

__device__ __forceinline__ void convert_rest(const Args& a, LAS unsigned char* lds, const int tid, int hi, int nh) {
    const int lane = tid & 63, wave = tid >> 6;
    unsigned char* W2T = a.ws + WS_W2T; unsigned char* W3T = a.ws + WS_W3T;
    LAS float* scr = (LAS float*)(lds + wave * 8704);
    constexpr int I2 = 64 * 64, I3 = 64 * 64, I4 = 128 * 64, NITR = I2 + I3 + I4;
#define CR_LOAD(R, it_) do { int r_ = (it_); const int sg_ = __builtin_amdgcn_readfirstlane((r_ >= I2) + (r_ >= I2 + I3)); const float* W_ = (sg_ == 0) ? a.in[18] : ((sg_ == 1) ? a.in[19] : a.in[20]); r_ -= (sg_ == 0) ? 0 : ((sg_ == 1) ? I2 : I2 + I3); \
        const int kb_ = r_ / 64, nb_ = r_ % 64; p0_item_load(R, W_, D, 64 * (kb_ >> 1), 32 * (2 * nb_ + (kb_ & 1)), 1, lane); } while (0)
#define CR_FIN(R, it_) do { int r_ = (it_); const int sg_ = __builtin_amdgcn_readfirstlane((r_ >= I2) + (r_ >= I2 + I3)); unsigned char* W8_ = (sg_ == 2) ? W3T : W2T; const int kadd_ = (sg_ == 1) ? 32 : 0; r_ -= (sg_ == 0) ? 0 : ((sg_ == 1) ? I2 : I2 + I3); \
        const int kb_ = r_ / 64, nb_ = r_ % 64; p0_item_fin_f8(R, W8_, scr, (kb_ >> 1) + kadd_, 2 * nb_ + (kb_ & 1), lane); } while (0)
    const int first = hi * 8 + wave, stride = nh * 8;
    if (first >= NITR) return;
    f32x4 RA[8], RB[8];
    const int ntrip = (NITR - first + stride - 1) / stride;
    { const int i1 = (first + stride < NITR) ? first + stride : NITR - 1; CR_LOAD(RA, first); CR_LOAD(RB, i1); }
    for (int k = 0; k < ntrip; k += 2) {
        const int iA = first + k * stride, iB = iA + stride, nA = (iB + stride < NITR) ? iB + stride : NITR - 1, nB = (iB + 2 * stride < NITR) ? iB + 2 * stride : NITR - 1;
        CR_FIN(RA, iA); CR_LOAD(RA, nA);
        if (k + 1 < ntrip) CR_FIN(RB, iB);
        CR_LOAD(RB, nB);
    }
#undef CR_LOAD
#undef CR_FIN
}
__device__ __forceinline__ void lora_a_panel(const Args& a, int pm, const int tid, int first_it = -1, int stride = NTHREADS, int n_it = 256 * 32) {
    const bf16_t* Z = (const bf16_t*)(a.ws + WS_Z); bf16_t* AL = (bf16_t*)(a.ws + WS_AL); const float* mu = a.in[7] + OFF_WD; const float* sh = a.in[3];
#pragma unroll 4
    for (int it = (first_it >= 0 ? first_it : tid); it < n_it; it += stride) {
        const int r = (first_it >= 0 ? 0 : pm * 256) + (it >> 5), c = (it & 31) * 8;
        const bf16x8 cur = *(const bf16x8*)(Z + (size_t)r * LDZ + OFF_WD + c);
        const bf16x8 p = *(const bf16x8*)(Z + (size_t)(r > 0 ? r - 1 : 0) * LDZ + OFF_WD + c);
        float pv[8]; bool first;
        if (r < M_P) first = (r & (TP - 1)) == 0; else first = ((r - M_P) & (TS - 1)) == 0;
#pragma unroll
        for (int j = 0; j < 8; ++j) pv[j] = bfs2f(p[j]);
        if (first) {
            if (r >= M_P) { const float* s = sh + (size_t)((r - M_P) >> 3) * SHIFT_W + OFF_WD + c;
#pragma unroll
                for (int j = 0; j < 8; ++j) pv[j] = s[j]; }
            else {
#pragma unroll
                for (int j = 0; j < 8; ++j) pv[j] = 0.f; } }
        float o[8];
        const f32x4 mu0 = *(const f32x4*)(mu + c), mu1 = *(const f32x4*)(mu + c + 4);
#pragma unroll
        for (int j = 0; j < 8; ++j) { const float z = bfs2f(cur[j]); const float x = z + (j < 4 ? mu0[j & 3] : mu1[j & 3]) * (pv[j] - z); o[j] = (c < 128) ? (1.0f - 2.0f * frcp(1.0f + __expf(2.0f * x))) : x; }
        u32x4 w; w.x = pk2(o[0], o[1]); w.y = pk2(o[2], o[3]); w.z = pk2(o[4], o[5]); w.w = pk2(o[6], o[7]);
        *(u32x4*)((unsigned char*)AL + ((size_t)(r >> 7) * 4 + (c >> 6)) * pg8::HTB + pg8::lds_byte(r & 127, c & 63)) = w;
    }
}

__device__ __forceinline__ void lora_sample(const Args& a, const int tid) {
    const int lane = tid & 63, wave = tid >> 6, m = lane & 15, kg = lane >> 4;
    const bf16_t* Z = (const bf16_t*)(a.ws + WS_Z); const unsigned char* WLT = a.ws + WS_WLT; const float* mu = a.in[7] + OFF_WD; const float* sh = a.in[3];
    for (int t = (int)blockIdx.x * 8 + wave; t < (M_S / 16) * 32; t += (int)gridDim.x * 8) {
        const int rb = t >> 5, cb = t & 31; const bool isw = cb < 16; const int kofs = isw ? 0 : 128, cbase = (isw ? cb : cb - 16) * 128;
        const int row = M_P + rb * 16 + m; const bool first = (m & (TS - 1)) == 0;
        bf16x8 af[4];
#pragma unroll
        for (int ks = 0; ks < 4; ++ks) { const int k = kofs + 32 * ks + 8 * kg;
            const bf16x8 cur = *(const bf16x8*)(Z + (size_t)row * LDZ + OFF_WD + k);
            const bf16x8 pb = *(const bf16x8*)(Z + (size_t)(row - 1) * LDZ + OFF_WD + k);
            const float* s = sh + (size_t)((row - M_P) >> 3) * SHIFT_W + OFF_WD + k; const f32x4 s0 = *(const f32x4*)s, s1 = *(const f32x4*)(s + 4);
            const f32x4 mu0 = *(const f32x4*)(mu + k), mu1 = *(const f32x4*)(mu + k + 4);
            float o[8];
#pragma unroll
            for (int j = 0; j < 8; ++j) { const float z = bfs2f(cur[j]); const float pv = first ? (j < 4 ? s0[j & 3] : s1[j & 3]) : bfs2f(pb[j]);
                const float x = z + (j < 4 ? mu0[j & 3] : mu1[j & 3]) * (pv - z); o[j] = isw ? (1.0f - 2.0f * frcp(1.0f + __expf(2.0f * x))) : x; }
            const u32x4 w = (u32x4){pk2(o[0], o[1]), pk2(o[2], o[3]), pk2(o[4], o[5]), pk2(o[6], o[7])}; af[ks] = __builtin_bit_cast(bf16x8, w); }
        bf16_t* outp = (isw ? (bf16_t*)(a.ws + WS_DW) : (bf16_t*)(a.ws + WS_AA)) + (size_t)row * RW + cbase + 4 * kg;
        const float* bias = (isw ? a.in[8] : a.in[10]) + cbase + 4 * kg; const float sc = isw ? -0.6065306597126334f : 1.0f;
#pragma unroll
        for (int nb = 0; nb < 8; ++nb) {
            const int ng = (isw ? 0 : 2048) + cbase + 16 * nb + m, nl = ng & 127, x = nl & 31, slot = (nl & ~31) + 16 * ((x >> 2) & 1) + 4 * (x >> 3) + (x & 3);
            f32x4 acc = (f32x4){0.f, 0.f, 0.f, 0.f};
#pragma unroll
            for (int ks = 0; ks < 4; ++ks) { const int k = kofs + 32 * ks + 8 * kg;
                const bf16x8 bf = *(const bf16x8*)(WLT + ((size_t)(ng >> 7) * 4 + (k >> 6)) * pg8::HTB + pg8::lds_byte(slot, k & 63));
                acc = __builtin_amdgcn_mfma_f32_16x16x32_bf16(bf, af[ks], acc, 0, 0, 0); }
            const f32x4 bv = *(const f32x4*)(bias + 16 * nb);
            float v[4];
#pragma unroll
            for (int j = 0; j < 4; ++j) v[j] = sc * frcp(1.0f + __expf(-(acc[j] + bv[j])));
            *(u32x2*)(outp + 16 * nb) = (u32x2){pk2(v[0], v[1]), pk2(v[2], v[3])}; }
    }
}

namespace att {
constexpr int KT_STRIDE = 144, KT_ROWS = 272, VT_STRIDE = 552;
constexpr int KT_OFF = 0, VT_OFF = KT_ROWS * KT_STRIDE, SC_OFF = VT_OFF + 64 * VT_STRIDE, SC_STRIDE = 68, SC_WAVE = 16 * SC_STRIDE * 4;
static_assert(SC_OFF + 8 * SC_WAVE <= 131072 && VT_OFF % 16 == 0 && SC_OFF % 16 == 0, "attention LDS map");

__device__ __forceinline__ bf16x8 rope8(bf16x8 own, bf16x8 oth, const f32x2* tab, int c) {
    bf16x8 o;
#pragma unroll
    for (int j = 0; j < 8; ++j) { const f32x2 cs = tab[j]; const float x = bfs2f(own[j]), y = bfs2f(oth[j]); const float r = (c == 0) ? x * cs.x - y * cs.y : x * cs.x + y * cs.y; o[j] = (short)f2bf(r); }
    return o;
}

struct QFrag { bf16x8 q0, q1, oth, g0, g1; };
template <class RowFn>
__device__ __forceinline__ void attn_load(QFrag& F, int lane, const RowFn& rf, const bf16_t* Z) {
    const int qi = lane & 15, g = lane >> 4;
    int row, head, qpos2, ridx; rf(qi, row, head, qpos2, ridx);
    const bf16_t* qp = Z + (size_t)row * LDZ + OFF_Q + head * 64;
    F.q0 = *(const bf16x8*)(qp + 8 * g); F.q1 = *(const bf16x8*)(qp + 32 + 8 * g); F.oth = *(const bf16x8*)(qp + 8 * (g ^ 1));
    int row2, head2, d0, d1; rf(lane >> 2, row2, head2, d0, d1);
    const bf16_t* gp = Z + (size_t)row2 * LDZ + OFF_GA + head2 * 64 + (lane & 3) * 16;
    F.g0 = *(const bf16x8*)gp; F.g1 = *(const bf16x8*)(gp + 8);
}
template <class RowFn>
__device__ __forceinline__ void attn_group(const QFrag& F, LAS unsigned char* lds, int wave, int lane, const RowFn& rf, int T0, bool prev_valid, const float* sinks, bf16_t* Y, const f32x2* rope) {
    const int qi = lane & 15, g = lane >> 4;
    int row, head, qpos2, ridx; rf(qi, row, head, qpos2, ridx);
    bf16x8 q0 = F.q0; const bf16x8 q1 = F.q1;
    if (g < 2) q0 = rope8(q0, F.oth, rope + (size_t)ridx * 8, g);
    float s[9][4];
#pragma unroll
    for (int tl = 0; tl < 9; ++tl) {
        const LAS unsigned char* kp = lds + KT_OFF + ((T0 + tl) * 16 + qi) * KT_STRIDE + 16 * g;
        const bf16x8 k0 = *(const LAS bf16x8*)kp, k1 = *(const LAS bf16x8*)(kp + 64);
        f32x4 a = (f32x4){0.f, 0.f, 0.f, 0.f};
        a = __builtin_amdgcn_mfma_f32_16x16x32_bf16(k0, q0, a, 0, 0, 0);
        a = __builtin_amdgcn_mfma_f32_16x16x32_bf16(k1, q1, a, 0, 0, 0);
#pragma unroll
        for (int r = 0; r < 4; ++r) s[tl][r] = a[r];
    }
    const float sink = sinks[head];
    const int dq = (qpos2 & 15) - 4 * g;
    float mx = -1e30f;
#pragma unroll
    for (int tl = 0; tl < 9; ++tl) { const bool tile_ok = prev_valid || (T0 + tl >= 8);
#pragma unroll
        for (int r = 0; r < 4; ++r) { const bool ok = tile_ok && (tl == 0 ? (dq - r < 0) : (tl == 8 ? (dq - r >= 0) : true));
            s[tl][r] = ok ? s[tl][r] : -1e30f; mx = fmaxf(mx, s[tl][r]); } }
    mx = fmaxf(mx, __shfl_xor(mx, 16)); mx = fmaxf(mx, __shfl_xor(mx, 32));
    constexpr float SC = 0.125f * 1.4426950408889634f;
    const float m2 = fmaxf(mx * SC, sink * 1.4426950408889634f);
    float sum = 0.f;
#pragma unroll
    for (int tl = 0; tl < 9; ++tl)
#pragma unroll
        for (int r = 0; r < 4; ++r) { s[tl][r] = __builtin_amdgcn_exp2f(fmaf(s[tl][r], SC, -m2)); sum += s[tl][r]; }
    sum += __shfl_xor(sum, 16); sum += __shfl_xor(sum, 32);
    const float inv = frcp(sum + __builtin_amdgcn_exp2f(sink * 1.4426950408889634f - m2));
    bf16x8 pa[5];
#pragma unroll
    for (int pr = 0; pr < 4; ++pr)
        { u32x4 w_; w_.x = pk2(s[2 * pr][0] * inv, s[2 * pr][1] * inv); w_.y = pk2(s[2 * pr][2] * inv, s[2 * pr][3] * inv); w_.z = pk2(s[2 * pr + 1][0] * inv, s[2 * pr + 1][1] * inv); w_.w = pk2(s[2 * pr + 1][2] * inv, s[2 * pr + 1][3] * inv); pa[pr] = __builtin_bit_cast(bf16x8, w_); }
    { u32x4 w_; w_.x = pk2(s[8][0] * inv, s[8][1] * inv); w_.y = pk2(s[8][2] * inv, s[8][3] * inv); w_.z = 0u; w_.w = 0u; pa[4] = __builtin_bit_cast(bf16x8, w_); }
    f32x4 o[4];
#pragma unroll
    for (int n = 0; n < 4; ++n) { o[n] = (f32x4){0.f, 0.f, 0.f, 0.f};
#pragma unroll
        for (int pr = 0; pr < 5; ++pr) {
            const LAS unsigned char* vp = lds + VT_OFF + (16 * n + qi) * VT_STRIDE + ((T0 + 2 * pr) * 16 + 4 * g) * 2;
            const s16x4 lo = *(const LAS s16x4*)vp, hi = *(const LAS s16x4*)(vp + 32);
            bf16x8 vf; vf[0] = lo[0]; vf[1] = lo[1]; vf[2] = lo[2]; vf[3] = lo[3]; vf[4] = hi[0]; vf[5] = hi[1]; vf[6] = hi[2]; vf[7] = hi[3];
            o[n] = __builtin_amdgcn_mfma_f32_16x16x32_bf16(pa[pr], vf, o[n], 0, 0, 0);
        } }
    LAS float* sc = (LAS float*)(lds + SC_OFF + wave * SC_WAVE);
#pragma unroll
    for (int n = 0; n < 4; ++n)
#pragma unroll
        for (int r = 0; r < 4; ++r) sc[(4 * g + r) * SC_STRIDE + 16 * n + qi] = o[n][r];
    LDS_WAIT();
    const int q = lane >> 2, ch = lane & 3;
    int row2, head2, d0, d1; rf(q, row2, head2, d0, d1);
    const LAS float* sr = sc + q * SC_STRIDE + ch * 16;
    const bf16x8 g0 = F.g0, g1 = F.g1;
    float v[16];
#pragma unroll
    for (int i = 0; i < 4; ++i) { const f32x4 x = *(const LAS f32x4*)(sr + 4 * i); v[4 * i] = x[0]; v[4 * i + 1] = x[1]; v[4 * i + 2] = x[2]; v[4 * i + 3] = x[3]; }
#pragma unroll
    for (int j = 0; j < 8; ++j) { const float ga = bfs2f(g0[j]), gb = bfs2f(g1[j]); v[j] *= ga * frcp(1.0f + __expf(-ga)); v[8 + j] *= gb * frcp(1.0f + __expf(-gb)); }
    *(u32x4*)((unsigned char*)Y + (size_t)row2 * D + 2048 + head2 * 64 + ch * 16) = (u32x4){pk4_fp8(v[0], v[1], v[2], v[3]), pk4_fp8(v[4], v[5], v[6], v[7]), pk4_fp8(v[8], v[9], v[10], v[11]), pk4_fp8(v[12], v[13], v[14], v[15])};
    LDS_WAIT();
}

struct PromptRows { int rowbase, hq, q0, posbase; __device__ __forceinline__ void operator()(int i, int& row, int& head, int& qpos2, int& ridx) const { row = rowbase + q0 + i; head = hq; qpos2 = 128 + q0 + i; ridx = posbase + q0 + i; } };
struct SampleRows { int rowbase, h0; __device__ __forceinline__ void operator()(int i, int& row, int& head, int& qpos2, int& ridx) const { const int t = i & 7; row = rowbase + t; head = h0 + (i >> 3); qpos2 = 128 + t; ridx = 2048 + t; } };

__device__ __forceinline__ void store8f(float* p, bf16x8 v) { f32x4 a, b;
#pragma unroll
    for (int j = 0; j < 4; ++j) { a[j] = bfs2f(v[j]); b[j] = bfs2f(v[4 + j]); } *(f32x4*)p = a; *(f32x4*)(p + 4) = b; }

__device__ __forceinline__ void unit_prompt(const Args& a, LAS unsigned char* lds, int u, const int tid) {
    const int lane = tid & 63, wave = tid >> 6;
    const int kvh = u & 3, nb = (u >> 2) & 15, b = u >> 6;
    const bf16_t* Z = (const bf16_t*)(a.ws + WS_Z); bf16_t* Y = (bf16_t*)(a.ws + WS_Y); const f32x2* rope = (const f32x2*)(a.ws + WS_ROPE);
    float* wk = a.out + O_WKP; float* wv = a.out + O_WVP;
    bf16x8 kvr[5], othr[5], vvr[5];
#pragma unroll
    for (int u5 = 0; u5 < 5; ++u5) { const int it = tid + u5 * NTHREADS, key = it >> 3, c = it & 7;
        kvr[u5] = (bf16x8){0, 0, 0, 0, 0, 0, 0, 0}; othr[u5] = kvr[u5]; vvr[u5] = kvr[u5];
        if (it < KT_ROWS * 8 && key < 256 && (key >= 128 || nb > 0)) {
            const int tok = (nb - 1) * 128 + key; const size_t row = (size_t)b * TP + tok; const bf16_t* kp = Z + row * LDZ + OFF_K + kvh * 64;
            kvr[u5] = *(const bf16x8*)(kp + 8 * c); if (c < 2) othr[u5] = *(const bf16x8*)(kp + 8 * (c ^ 1)); vvr[u5] = *(const bf16x8*)(Z + row * LDZ + OFF_V + kvh * 64 + 8 * c); } }
    PromptRows rf; rf.rowbase = b * TP + nb * 128; rf.hq = kvh * 8 + wave; rf.posbase = nb * 128; rf.q0 = 0;
    QFrag FA, FB; attn_load(FA, lane, rf, Z);
#pragma unroll
    for (int u5 = 0; u5 < 5; ++u5) { const int it = tid + u5 * NTHREADS, key = it >> 3, c = it & 7;
        if (it < KT_ROWS * 8) {
            bf16x8 kv = kvr[u5]; const bf16x8 vv = vvr[u5];
            if (key < 256 && (key >= 128 || nb > 0)) {
                const int tok = (nb - 1) * 128 + key;
                if (c < 2) kv = rope8(kv, othr[u5], rope + (size_t)tok * 8, c);
                if (nb == 15 && key >= 128) { const size_t o = (((size_t)b * 128 + (key - 128)) * 4 + kvh) * 64 + 8 * c; store8f(wk + o, kv); store8f(wv + o, vv); } }
            *(LAS bf16x8*)(lds + KT_OFF + key * KT_STRIDE + 16 * c) = kv;
#pragma unroll
            for (int j = 0; j < 8; ++j) *(LAS short*)(lds + VT_OFF + (8 * c + j) * VT_STRIDE + key * 2) = vv[j]; } }
    __syncthreads();
    for (int grp = 0; grp < 8; grp += 2) {
        rf.q0 = 16 * (grp + 1); attn_load(FB, lane, rf, Z);
        rf.q0 = 16 * grp; attn_group(FA, lds, wave, lane, rf, grp, nb > 0, a.in[17], Y, rope);
        if (grp + 2 < 8) { rf.q0 = 16 * (grp + 2); attn_load(FA, lane, rf, Z); }
        rf.q0 = 16 * (grp + 1); attn_group(FB, lds, wave, lane, rf, grp + 1, nb > 0, a.in[17], Y, rope);
    }
    __syncthreads();
}

__device__ __forceinline__ void unit_sample(const Args& a, LAS unsigned char* lds, int u, const int tid) {
    const int lane = tid & 63, wave = tid >> 6;
    const int kvh = u & 3, b = u >> 2;
    const bf16_t* Z = (const bf16_t*)(a.ws + WS_Z); bf16_t* Y = (bf16_t*)(a.ws + WS_Y); const f32x2* rope = (const f32x2*)(a.ws + WS_ROPE);
    const float* ck = a.in[4]; const float* cv = a.in[5]; float* wk = a.out + O_WKS; float* wv = a.out + O_WVS;
    SampleRows rf; rf.rowbase = M_P + b * TS; rf.h0 = kvh * 8 + 2 * (wave & 3);
    QFrag FA; attn_load(FA, lane, rf, Z);
    f32x4 ck0[3], ck1[3], cv0[3], cv1[3]; bf16x8 nk[3], no[3], nv[3];
#pragma unroll
    for (int u3 = 0; u3 < 3; ++u3) { const int it = tid + u3 * NTHREADS, key = it >> 3, c = it & 7;
        ck0[u3] = (f32x4){0.f, 0.f, 0.f, 0.f}; ck1[u3] = ck0[u3]; cv0[u3] = ck0[u3]; cv1[u3] = ck0[u3]; nk[u3] = (bf16x8){0, 0, 0, 0, 0, 0, 0, 0}; no[u3] = nk[u3]; nv[u3] = nk[u3];
        if (it < 160 * 8) {
            if (key < 128) { const size_t so = (((size_t)b * 128 + key) * 4 + kvh) * 64 + 4 * c;
                ck0[u3] = __builtin_nontemporal_load((const f32x4*)(ck + so)); ck1[u3] = __builtin_nontemporal_load((const f32x4*)(ck + so + 32)); cv0[u3] = __builtin_nontemporal_load((const f32x4*)(cv + so)); cv1[u3] = __builtin_nontemporal_load((const f32x4*)(cv + so + 32)); }
            else if (key < 136) { const size_t row = (size_t)M_P + b * TS + (key - 128); const bf16_t* kp = Z + row * LDZ + OFF_K + kvh * 64;
                nk[u3] = *(const bf16x8*)(kp + 8 * c); if (c < 2) no[u3] = *(const bf16x8*)(kp + 8 * (c ^ 1)); nv[u3] = *(const bf16x8*)(Z + row * LDZ + OFF_V + kvh * 64 + 8 * c); } } }
#pragma unroll
    for (int u3 = 0; u3 < 3; ++u3) { const int it = tid + u3 * NTHREADS, key = it >> 3, c = it & 7;
        if (it < 160 * 8) {
            bf16x8 kv = nk[u3], vv = nv[u3];
            if (key < 128) {
                const f32x4 k0 = ck0[u3], k1 = ck1[u3], v0 = cv0[u3], v1 = cv1[u3];
                { u32x4 w_; w_.x = pk2(k0[0], k0[1]); w_.y = pk2(k0[2], k0[3]); w_.z = pk2(k1[0], k1[1]); w_.w = pk2(k1[2], k1[3]); kv = __builtin_bit_cast(bf16x8, w_);
                  w_.x = pk2(v0[0], v0[1]); w_.y = pk2(v0[2], v0[3]); w_.z = pk2(v1[0], v1[1]); w_.w = pk2(v1[2], v1[3]); vv = __builtin_bit_cast(bf16x8, w_); }
                if (key >= 8) { const size_t o = (((size_t)b * 128 + (key - 8)) * 4 + kvh) * 64 + 4 * c; __builtin_nontemporal_store(k0, (f32x4*)(wk + o)); __builtin_nontemporal_store(k1, (f32x4*)(wk + o + 32)); __builtin_nontemporal_store(v0, (f32x4*)(wv + o)); __builtin_nontemporal_store(v1, (f32x4*)(wv + o + 32)); }
            } else if (key < 136) {
                const int t = key - 128;
                if (c < 2) kv = rope8(kv, no[u3], rope + (size_t)(2048 + t) * 8, c);
                const size_t o = (((size_t)b * 128 + (120 + t)) * 4 + kvh) * 64 + 8 * c; store8f(wk + o, kv); store8f(wv + o, vv);
            }
            if (key < 128) {
                const u32x4 kw = __builtin_bit_cast(u32x4, kv);
                *(LAS u32x2*)(lds + KT_OFF + key * KT_STRIDE + 8 * c) = (u32x2){kw.x, kw.y}; *(LAS u32x2*)(lds + KT_OFF + key * KT_STRIDE + 64 + 8 * c) = (u32x2){kw.z, kw.w};
#pragma unroll
                for (int j = 0; j < 4; ++j) { *(LAS short*)(lds + VT_OFF + (4 * c + j) * VT_STRIDE + key * 2) = vv[j]; *(LAS short*)(lds + VT_OFF + (32 + 4 * c + j) * VT_STRIDE + key * 2) = vv[4 + j]; }
            } else {
                *(LAS bf16x8*)(lds + KT_OFF + key * KT_STRIDE + 16 * c) = kv;
#pragma unroll
                for (int j = 0; j < 8; ++j) *(LAS short*)(lds + VT_OFF + (8 * c + j) * VT_STRIDE + key * 2) = vv[j]; } } }
    __syncthreads();
    if (wave < 4) attn_group(FA, lds, wave, lane, rf, 0, true, a.in[17], Y, rope);
    __syncthreads();
}
}

namespace scan {
constexpr int CT = 32, IN_STRIDE = 1536, IN_BYTES = CT * IN_STRIDE, YB_OFF = 2 * IN_BYTES + 256  , RK_OFF = YB_OFF + CT * 64 * 4, JUNK_OFF = RK_OFF + CT * 4;
static_assert(JUNK_OFF % 16 == 0 && JUNK_OFF + 512 + (CT + 1) * 256 <= 131072, "scan LDS map");
struct Chunk { int row0, nsteps, h, first, last, kind, seq; };
struct Raw { u32x2 zr, zk, zv, pr, pk, pv, g, dw, aa; f32x4 fr, fk, fv, mur, muk, muv, kkc, kac, rkc, gw, gb; };
struct KV { f32x4 w, nk, bb, kh, rr; f32x2 vv; };

__device__ __forceinline__ float red16(float x) {
    x += __builtin_bit_cast(float, __builtin_amdgcn_update_dpp(0, __builtin_bit_cast(int, x), 0xB1, 0xF, 0xF, true));
    x += __builtin_bit_cast(float, __builtin_amdgcn_update_dpp(0, __builtin_bit_cast(int, x), 0x4E, 0xF, 0xF, true));
    x += __builtin_bit_cast(float, __builtin_amdgcn_update_dpp(0, __builtin_bit_cast(int, x), 0x141, 0xF, 0xF, true));
    x += __builtin_bit_cast(float, __builtin_amdgcn_update_dpp(0, __builtin_bit_cast(int, x), 0x140, 0xF, 0xF, true));
    return x;
}
__device__ __forceinline__ void red16x4(float& a, float& b, float& c, float& d) {
    asm volatile("s_nop 1\n\t"
        "v_add_f32_dpp %0, %0, %0 quad_perm:[1,0,3,2] row_mask:0xf bank_mask:0xf bound_ctrl:1\n\t"
        "v_add_f32_dpp %1, %1, %1 quad_perm:[1,0,3,2] row_mask:0xf bank_mask:0xf bound_ctrl:1\n\t"
        "v_add_f32_dpp %2, %2, %2 quad_perm:[1,0,3,2] row_mask:0xf bank_mask:0xf bound_ctrl:1\n\t"
        "v_add_f32_dpp %3, %3, %3 quad_perm:[1,0,3,2] row_mask:0xf bank_mask:0xf bound_ctrl:1\n\t"
        "v_add_f32_dpp %0, %0, %0 quad_perm:[2,3,0,1] row_mask:0xf bank_mask:0xf bound_ctrl:1\n\t"
        "v_add_f32_dpp %1, %1, %1 quad_perm:[2,3,0,1] row_mask:0xf bank_mask:0xf bound_ctrl:1\n\t"
        "v_add_f32_dpp %2, %2, %2 quad_perm:[2,3,0,1] row_mask:0xf bank_mask:0xf bound_ctrl:1\n\t"
        "v_add_f32_dpp %3, %3, %3 quad_perm:[2,3,0,1] row_mask:0xf bank_mask:0xf bound_ctrl:1\n\t"
        "v_add_f32_dpp %0, %0, %0 row_half_mirror row_mask:0xf bank_mask:0xf bound_ctrl:1\n\t"
        "v_add_f32_dpp %1, %1, %1 row_half_mirror row_mask:0xf bank_mask:0xf bound_ctrl:1\n\t"
        "v_add_f32_dpp %2, %2, %2 row_half_mirror row_mask:0xf bank_mask:0xf bound_ctrl:1\n\t"
        "v_add_f32_dpp %3, %3, %3 row_half_mirror row_mask:0xf bank_mask:0xf bound_ctrl:1\n\t"
        "v_add_f32_dpp %0, %0, %0 row_mirror row_mask:0xf bank_mask:0xf bound_ctrl:1\n\t"
        "v_add_f32_dpp %1, %1, %1 row_mirror row_mask:0xf bank_mask:0xf bound_ctrl:1\n\t"
        "v_add_f32_dpp %2, %2, %2 row_mirror row_mask:0xf bank_mask:0xf bound_ctrl:1\n\t"
        "v_add_f32_dpp %3, %3, %3 row_mirror row_mask:0xf bank_mask:0xf bound_ctrl:1\n\t"
        "s_nop 0"
        : "+v"(a), "+v"(b), "+v"(c), "+v"(d));
}
__device__ __forceinline__ float dot4(f32x4 a, f32x4 b) { return (a[0] * b[0] + a[1] * b[1]) + (a[2] * b[2] + a[3] * b[3]); }
__device__ __forceinline__ f32x4 unpack4(u32x2 v) { f32x4 r; r[0] = __builtin_bit_cast(float, v.x << 16); r[1] = __builtin_bit_cast(float, v.x & 0xffff0000u); r[2] = __builtin_bit_cast(float, v.y << 16); r[3] = __builtin_bit_cast(float, v.y & 0xffff0000u); return r; }

__device__ __forceinline__ bool get_chunk(int j, Chunk& C) {
    const int G = (int)gridDim.x, w = (int)blockIdx.x;
    if (G >= 256 && w < 128) return false;
    const int s = (G >= 256) ? (w - 128) + j * (G - 128) : w + j * G;
    if (s >= NB_S * NH) return false;
    C.kind = 1; C.seq = s >> 5; C.h = s & 31; C.row0 = M_P + C.seq * TS; C.nsteps = TS; C.first = 1; C.last = 1; return true;
}

__device__ __forceinline__ void phase_scan(const Args& a, LAS unsigned char* lds, const int tid) {
    const int lane = tid & 63, wave = tid >> 6;
    const bf16_t* Z = (const bf16_t*)(a.ws + WS_Z); const bf16_t* DW = (const bf16_t*)(a.ws + WS_DW); const bf16_t* AA = (const bf16_t*)(a.ws + WS_AA); bf16_t* Y = (bf16_t*)(a.ws + WS_Y);
    const float* mu = a.in[7]; const float* k_k = a.in[12]; const float* k_a = a.in[13]; const float* r_k = a.in[14]; const float* gn_w = a.in[15]; const float* gn_b = a.in[16];
    const int kq = lane & 15, rp = lane >> 4, srow = wave * 8 + rp * 2;
    const int pt = tid >> 4;
    LAS float* ybuf = (LAS float*)(lds + YB_OFF); LAS float* rkbuf = (LAS float*)(lds + RK_OFF);
    const unsigned ya = (kq == 0) ? (unsigned)(YB_OFF + srow * 4) : (unsigned)(JUNK_OFF + 256 + lane * 8);
    Chunk C, CN; Raw R;
    int j = 0;
    if (!get_chunk(0, C)) return;
    f32x4 S0 = (f32x4){0.f, 0.f, 0.f, 0.f}, S1 = S0, N0 = S0, N1 = S0;
    u32x2 gcur = (u32x2){0u, 0u}; f32x4 gwc = S0, gbc = S0;

#define SCAN_PREFETCH(CC) do { if (pt < (CC).nsteps) { const int col = (CC).h * 64 + 4 * kq; const size_t row = (size_t)((CC).row0 + pt); const size_t rprev = row > 0 ? row - 1 : 0; \
            const bf16_t* zp = Z + row * LDZ + col; const bf16_t* pp = Z + rprev * LDZ + col; \
            R.zr = *(const u32x2*)zp; R.zk = *(const u32x2*)(zp + 2048); R.zv = *(const u32x2*)(zp + 4096); R.g = *(const u32x2*)(zp + OFF_GR); \
            R.pr = *(const u32x2*)pp; R.pk = *(const u32x2*)(pp + 2048); R.pv = *(const u32x2*)(pp + 4096); \
            R.dw = *(const u32x2*)(DW + row * RW + col); R.aa = *(const u32x2*)(AA + row * RW + col); \
            R.mur = *(const f32x4*)(mu + col); R.muk = *(const f32x4*)(mu + 2048 + col); R.muv = *(const f32x4*)(mu + 4096 + col); \
            R.kkc = *(const f32x4*)(k_k + col); R.kac = *(const f32x4*)(k_a + col); R.rkc = *(const f32x4*)(r_k + col); R.gw = *(const f32x4*)(gn_w + col); R.gb = *(const f32x4*)(gn_b + col); \
            R.fr = (f32x4){0.f, 0.f, 0.f, 0.f}; R.fk = R.fr; R.fv = R.fr; \
            if ((CC).first && (CC).kind == 1 && pt == 0) { const float* sp = a.in[3] + (size_t)(CC).seq * SHIFT_W + col; R.fr = *(const f32x4*)sp; R.fk = *(const f32x4*)(sp + 2048); R.fv = *(const f32x4*)(sp + 4096); } } } while (0)
#define SCAN_LOADS0(CC, A0, A1) do { if ((CC).kind == 1) { const float* sp = a.in[2] + (((size_t)(CC).seq * NH + (CC).h) * 64 + srow) * 64 + 4 * kq; A0 = *(const f32x4*)sp; A1 = *(const f32x4*)(sp + 64); } \
        else { A0 = (f32x4){0.f, 0.f, 0.f, 0.f}; A1 = A0; } } while (0)
#define SCAN_PROCESS(CC, INB) do { if (pt < (CC).nsteps) { \
            const f32x4 zr = unpack4(R.zr), zk = unpack4(R.zk), zv = unpack4(R.zv); f32x4 pr = unpack4(R.pr), pkk = unpack4(R.pk), pv = unpack4(R.pv); \
            if ((CC).first && pt == 0) { pr = R.fr; pkk = R.fk; pv = R.fv; } \
            const f32x4 xr = zr + R.mur * (pr - zr), xk = zk + R.muk * (pkk - zk), xv = zv + R.muv * (pv - zv); const f32x4 av = unpack4(R.aa), ldv = unpack4(R.dw); \
            const f32x4 kkv = xk * R.kkc; const float ss = red16(dot4(kkv, kkv)); const f32x4 kkn = kkv * __builtin_amdgcn_rsqf(fmaxf(ss, 1e-24f)); \
            const f32x4 kh = xk * ((av - 1.0f) * R.kac + 1.0f); const float rk = red16(dot4(xr * kh, R.rkc)); \
            LAS unsigned char* ib = (INB) + pt * IN_STRIDE + kq * 16; \
            { f32x4 wd_; wd_[0] = __expf(ldv[0]); wd_[1] = __expf(ldv[1]); wd_[2] = __expf(ldv[2]); wd_[3] = __expf(ldv[3]); *(LAS f32x4*)ib = wd_; } *(LAS f32x4*)(ib + 256) = -kkn; *(LAS f32x4*)(ib + 512) = kkn * av; *(LAS f32x4*)(ib + 768) = kh; *(LAS f32x4*)(ib + 1024) = xr; *(LAS f32x4*)(ib + 1280) = xv; \
            if (kq == 0) rkbuf[pt] = rk; gcur = R.g; gwc = R.gw; gbc = R.gb; } } while (0)
#define SCAN_LOADK(K, tt) do { const LAS unsigned char* p_ = ibk + (tt) * IN_STRIDE; K.w = *(const LAS f32x4*)p_; K.nk = *(const LAS f32x4*)(p_ + 256); K.bb = *(const LAS f32x4*)(p_ + 512); \
            K.kh = *(const LAS f32x4*)(p_ + 768); K.rr = *(const LAS f32x4*)(p_ + 1024); K.vv = *(const LAS f32x2*)(vbk + (tt) * IN_STRIDE); } while (0)
#define SCAN_STEP(K, tt) do { float sa0 = dot4(S0, K.nk), sa1 = dot4(S1, K.nk); \
            const f32x4 T0 = S0 * K.w + K.kh * K.vv[0], T1 = S1 * K.w + K.kh * K.vv[1]; \
            red16x4(sa0, sa1, py0, py1); \
            *(LAS f32x2*)(lds + ya + ((tt) - 1) * 256) = (f32x2){py0, py1}; \
            S0 = T0 + K.bb * sa0; S1 = T1 + K.bb * sa1; \
            py0 = dot4(S0, K.rr); py1 = dot4(S1, K.rr); } while (0)

    SCAN_PREFETCH(C);
    SCAN_LOADS0(C, S0, S1);
    SCAN_PROCESS(C, lds);
    __syncthreads();
    for (;;) {
        const bool haveN = get_chunk(j + 1, CN);
        LAS unsigned char* inb = lds + (j & 1) * IN_BYTES;
        if (haveN) { SCAN_PREFETCH(CN); if (CN.first) SCAN_LOADS0(CN, N0, N1); }
        {
            const LAS unsigned char* ibk = inb + kq * 16;
            const LAS unsigned char* vbk = inb + 1280 + srow * 4;
            const int ns = C.nsteps;
            float py0 = 0.f, py1 = 0.f;
            KV KA, KB;
            SCAN_LOADK(KA, 0);
            for (int t = 0; t < ns; t += 2) {
                SCAN_LOADK(KB, t + 1);
                SCAN_STEP(KA, t);
                SCAN_LOADK(KA, t + 2);
                SCAN_STEP(KB, t + 1);
            }
            py0 = red16(py0); py1 = red16(py1);
            *(LAS f32x2*)(lds + ya + (ns - 1) * 256) = (f32x2){py0, py1};
        }
        if (C.last) { float* op = a.out + (C.kind == 0 ? O_WKVP : O_WKVS) + (((size_t)C.seq * NH + C.h) * 64 + srow) * 64 + 4 * kq; *(f32x4*)op = S0; *(f32x4*)(op + 64) = S1; }
        __syncthreads();
        if (pt < C.nsteps) {
            const f32x4 y = *(const LAS f32x4*)(ybuf + pt * 64 + 4 * kq);
            const float mean = red16((y[0] + y[1]) + (y[2] + y[3])) * (1.0f / 64.0f); const f32x4 d = y - mean; const float var = red16(dot4(d, d)) * (1.0f / 64.0f);
            const f32x4 xv = *(const LAS f32x4*)(inb + pt * IN_STRIDE + 1280 + kq * 16);
            const f32x4 gt = unpack4(gcur);
            const f32x4 yn = d * rsqrtf(var + GN_EPS) * gwc + gbc + xv * rkbuf[pt];
            f32x4 o;
#pragma unroll
            for (int i = 0; i < 4; ++i) o[i] = yn[i] * (gt[i] * frcp(1.0f + __expf(-gt[i])));
            u32x2 w; w.x = pk2(o[0], o[1]); w.y = pk2(o[2], o[3]);
            *(u32x2*)(Y + (size_t)(C.row0 + pt) * D + C.h * 64 + 4 * kq) = w;
        }
        if (haveN) SCAN_PROCESS(CN, lds + ((j + 1) & 1) * IN_BYTES);
        __syncthreads();
        if (!haveN) break;
        C = CN; ++j; if (C.first) { S0 = N0; S1 = N1; }
    }
#undef SCAN_PREFETCH
#undef SCAN_LOADS0
#undef SCAN_PROCESS
#undef SCAN_LOADK
#undef SCAN_STEP
}
}


namespace cscan {
constexpr int CB = 14336, CB_PT0 = 0, CB_PT1 = 1024, CB_RT0 = 2048, CB_RT1 = 3072, CB_NM = 4096, CB_BK = 5120, CB_QT = 9216, CB_V = 9728, CB_GAM = 11776, CB_RK = 12032, CB_GATE = 12288;
constexpr int NCH = 128, IMG = 144;
constexpr int A_AT = 0, A_BT = 2304, A_KT = 4608, A_RT = 6912, A_NS = 9216, A_MK = 10240, A_TS = 11264, A_PS = 12288, A_WAVE = 14592;
static_assert(8 * A_WAVE <= 131072, "chunk_pre LDS map");
constexpr int RING = 7, DEPTH = 5, YB_OFF = RING * CB, YB_SZ = 8704;
static_assert(YB_OFF + 2 * YB_SZ <= 131072, "chunk_scan LDS map");

__device__ __forceinline__ int kpos(int k) { const int s = k >> 5, kk = k & 31; return s * 32 + ((kk & 15) >> 2) * 8 + (kk & 3) + ((kk >> 4) << 2); }
__device__ __forceinline__ float wsum64(float x) {
    x = scan::red16(x); const int xi = __builtin_bit_cast(int, x);
    const float s0 = __builtin_bit_cast(float, __builtin_amdgcn_readlane(xi, 0)), s1 = __builtin_bit_cast(float, __builtin_amdgcn_readlane(xi, 16)),
                s2 = __builtin_bit_cast(float, __builtin_amdgcn_readlane(xi, 32)), s3 = __builtin_bit_cast(float, __builtin_amdgcn_readlane(xi, 48));
    return (s0 + s1) + (s2 + s3);
}
__device__ __forceinline__ float red8(float x) {
    x += __builtin_bit_cast(float, __builtin_amdgcn_update_dpp(0, __builtin_bit_cast(int, x), 0xB1, 0xF, 0xF, true));
    x += __builtin_bit_cast(float, __builtin_amdgcn_update_dpp(0, __builtin_bit_cast(int, x), 0x4E, 0xF, 0xF, true));
    x += __builtin_bit_cast(float, __builtin_amdgcn_update_dpp(0, __builtin_bit_cast(int, x), 0x141, 0xF, 0xF, true));
    return x;
}

constexpr int A_ATT = 6656;
constexpr int S_BK = 0, S_V = 4096, S_GAM = 6144, S_RK = 6400, S_YB = 6656;
template <bool SAMPLE>
__device__ __forceinline__ void chunk_pre(const Args& a, LAS unsigned char* wl, int task, int lane) {
    const int h = SAMPLE ? (task & 31) : ((task >> 7) & 31), c = SAMPLE ? 1 : (task & 127), k = lane, col = h * 64 + k, vc = lane & 15, g = lane >> 4;
    const size_t row0 = SAMPLE ? (size_t)M_P + (size_t)(task >> 5) * TS : (size_t)(task >> 12) * TP + 16 * c;
    constexpr int NT = SAMPLE ? 8 : 16;
    const bf16_t* Z = (const bf16_t*)(a.ws + WS_Z); const bf16_t* DW = (const bf16_t*)(a.ws + WS_DW); const bf16_t* AA = (const bf16_t*)(a.ws + WS_AA);
    unsigned char* blk = a.ws + WS_CB + (size_t)task * CB;
    const float mur = a.in[7][col], muk = a.in[7][2048 + col], muv = a.in[7][4096 + col], kkc = a.in[12][col], kac = a.in[13][col], rkc = a.in[14][col];
    unsigned short zr[17], zk[17], zv[17], dw[16], aa[16];
    u32x4 tg[2];
    { const int rr = lane >> 3, ch8 = (lane & 7) * 8;
      u32x4 tz[3][3], td[2][2];
#pragma unroll
      for (int i = 0; i < 3; ++i) { const int r = rr + 8 * i; const bool ok = SAMPLE ? (r >= 1 && r <= 8) : ((r < 17) && !(c == 0 && r == 0)); const size_t row = row0 + (size_t)(ok ? r : 1) - 1;
          const bf16_t* zp = Z + row * LDZ + h * 64 + ch8;
#pragma unroll
          for (int m3 = 0; m3 < 3; ++m3) { tz[m3][i] = *(const u32x4*)(zp + 2048 * m3); if (!ok) tz[m3][i] = (u32x4){0u, 0u, 0u, 0u}; } }
      if (SAMPLE && rr == 0) {
          const float* sp = a.in[3] + (size_t)(task >> 5) * SHIFT_W + h * 64 + ch8;
#pragma unroll
          for (int m3 = 0; m3 < 3; ++m3) { const f32x4 lo = *(const f32x4*)(sp + 2048 * m3), hi = *(const f32x4*)(sp + 2048 * m3 + 4);
              tz[m3][0] = (u32x4){pk2(lo[0], lo[1]), pk2(lo[2], lo[3]), pk2(hi[0], hi[1]), pk2(hi[2], hi[3])}; } }
#pragma unroll
      for (int i = 0; i < 2; ++i) { const size_t row = row0 + rr + (SAMPLE ? 0 : 8 * i); td[0][i] = *(const u32x4*)(DW + row * RW + h * 64 + ch8); td[1][i] = *(const u32x4*)(AA + row * RW + h * 64 + ch8);
          if (SAMPLE && i == 0) tg[0] = *(const u32x4*)(Z + row * LDZ + OFF_GR + h * 64 + ch8); }
#pragma unroll
      for (int i = 0; i < 3; ++i) { const int r = rr + 8 * i; if (r < 17) {
#pragma unroll
          for (int m3 = 0; m3 < 3; ++m3) *(LAS u32x4*)(wl + m3 * 2176 + r * 128 + ch8 * 2) = tz[m3][i]; } }
#pragma unroll
      for (int i = 0; i < 2; ++i) { const int r = rr + 8 * i; *(LAS u32x4*)(wl + 6528 + r * 128 + ch8 * 2) = td[0][i]; *(LAS u32x4*)(wl + 8576 + r * 128 + ch8 * 2) = td[1][i];
          }
      LDS_WAIT();
#pragma unroll
      for (int t = 0; t < NT + 1; ++t) { zr[t] = *(const LAS unsigned short*)(wl + t * 128 + 2 * k); zk[t] = *(const LAS unsigned short*)(wl + 2176 + t * 128 + 2 * k); zv[t] = *(const LAS unsigned short*)(wl + 4352 + t * 128 + 2 * k); }
#pragma unroll
      for (int t = 0; t < NT; ++t) { dw[t] = *(const LAS unsigned short*)(wl + 6528 + t * 128 + 2 * k); aa[t] = *(const LAS unsigned short*)(wl + 8576 + t * 128 + 2 * k); }
      LDS_WAIT(); }
    const int kp2 = 2 * kpos(k);
    float al[16], be[16], kt[16]; unsigned xvp[8]; float cum = 0.f, rkv = 0.f, ecl = 1.0f;
#pragma unroll
    for (int t = 0; t < NT; ++t) {
        const float z_r = bf2f(zr[t + 1]), z_k = bf2f(zk[t + 1]), z_v = bf2f(zv[t + 1]), p_r = bf2f(zr[t]), p_k = bf2f(zk[t]), p_v = bf2f(zv[t]);
        const float xr = z_r + mur * (p_r - z_r), xk = z_k + muk * (p_k - z_k), xv = z_v + muv * (p_v - z_v), av = bf2f(aa[t]);
        const float kkv = xk * kkc, ss = wsum64(kkv * kkv), kkn = kkv * __builtin_amdgcn_rsqf(fmaxf(ss, 1e-24f));
        const float kh = xk * (1.0f + (av - 1.0f) * kac), rkt = wsum64(xr * kh * rkc);
        rkv = (lane == t) ? rkt : rkv;
        const float ecp = ecl; cum += bf2f(dw[t]); const float ec = __expf(cum), eci = frcp(ec); ecl = ec;
        al[t] = -kkn * ecp; be[t] = kkn * av * eci; kt[t] = kh * eci;
        *(LAS unsigned short*)(wl + A_AT + t * IMG + kp2) = (unsigned short)f2bf(al[t]);
        *(LAS unsigned short*)(wl + A_BT + t * IMG + kp2) = (unsigned short)f2bf(be[t]);
        *(LAS unsigned short*)(wl + A_KT + t * IMG + kp2) = (unsigned short)f2bf(kt[t]);
        *(LAS unsigned short*)(wl + A_RT + t * IMG + kp2) = (unsigned short)f2bf(xr * ec);
        if (t & 1) xvp[t >> 1] |= f2bf(xv) << 16; else xvp[t >> 1] = f2bf(xv);
    }
    if (SAMPLE) {
#pragma unroll
        for (int t = NT; t < 16; ++t) { al[t] = 0.f; be[t] = 0.f; kt[t] = 0.f; if (!(t & 1)) xvp[t >> 1] = 0u;
            *(LAS unsigned short*)(wl + A_AT + t * IMG + kp2) = 0; *(LAS unsigned short*)(wl + A_BT + t * IMG + kp2) = 0; *(LAS unsigned short*)(wl + A_KT + t * IMG + kp2) = 0; *(LAS unsigned short*)(wl + A_RT + t * IMG + kp2) = 0; } }
    const float eL = ecl;
    u32x4 w4[4];
#pragma unroll
    for (int gg = 0; gg < 4; ++gg) { w4[gg].x = pk2(be[4 * gg] * eL, be[4 * gg + 1] * eL); w4[gg].y = pk2(be[4 * gg + 2] * eL, be[4 * gg + 3] * eL); w4[gg].z = pk2(kt[4 * gg] * eL, kt[4 * gg + 1] * eL); w4[gg].w = pk2(kt[4 * gg + 2] * eL, kt[4 * gg + 3] * eL); }
    if (!SAMPLE) { *(float*)(blk + CB_GAM + 4 * k) = eL; if (lane < 16) *(float*)(blk + CB_RK + 4 * lane) = rkv; }
    LDS_WAIT();
    f32x4 gN = (f32x4){0.f, 0.f, 0.f, 0.f}, gMk = gN, gNr = gN, gMkr = gN;
    bf16x8 frs[2];
#pragma unroll
    for (int sK = 0; sK < 2; ++sK) { const int fo = vc * IMG + sK * 64 + g * 16;
        const bf16x8 fa = *(const LAS bf16x8*)(wl + A_AT + fo), fb = *(const LAS bf16x8*)(wl + A_BT + fo), fk = *(const LAS bf16x8*)(wl + A_KT + fo), fr = *(const LAS bf16x8*)(wl + A_RT + fo);
        gN = __builtin_amdgcn_mfma_f32_16x16x32_bf16(fb, fa, gN, 0, 0, 0); gMk = __builtin_amdgcn_mfma_f32_16x16x32_bf16(fk, fa, gMk, 0, 0, 0);
        gNr = __builtin_amdgcn_mfma_f32_16x16x32_bf16(fb, fr, gNr, 0, 0, 0); gMkr = __builtin_amdgcn_mfma_f32_16x16x32_bf16(fk, fr, gMkr, 0, 0, 0);
        frs[sK] = fr;
        if (!SAMPLE) __builtin_nontemporal_store(__builtin_bit_cast(u32x4, fr), (u32x4*)(blk + CB_RT0 + sK * 1024 + vc * 64 + g * 16)); }
    { u32x4 lo_, hi_; lo_.x = pk2(al[0], al[1]); lo_.y = pk2(al[2], al[3]); lo_.z = pk2(al[4], al[5]); lo_.w = pk2(al[6], al[7]); hi_.x = pk2(al[8], al[9]); hi_.y = pk2(al[10], al[11]); hi_.z = pk2(al[12], al[13]); hi_.w = pk2(al[14], al[15]);
      *(LAS u32x4*)(wl + A_ATT + k * 32) = lo_; *(LAS u32x4*)(wl + A_ATT + k * 32 + 16) = hi_; }
    {
        LDS_WAIT();
#pragma unroll
        for (int gg = 0; gg < 4; ++gg) *(LAS u32x4*)(wl + S_BK + k * 64 + gg * 16) = w4[gg];
        *(LAS u32x4*)(wl + S_V + (k >> 4) * 512 + (k & 15) * 32) = (u32x4){xvp[0], xvp[1], xvp[2], xvp[3]}; *(LAS u32x4*)(wl + S_V + (k >> 4) * 512 + (k & 15) * 32 + 16) = (u32x4){xvp[4], xvp[5], xvp[6], xvp[7]};
        if (SAMPLE) { *(LAS float*)(wl + S_GAM + 4 * k) = eL; if (lane < 16) *(LAS float*)(wl + S_RK + 4 * lane) = rkv; }
        else { LDS_WAIT();
#pragma unroll
            for (int q = 0; q < 4; ++q) __builtin_nontemporal_store(*(const LAS u32x4*)(wl + S_BK + q * 1024 + lane * 16), (u32x4*)(blk + CB_BK + q * 1024 + lane * 16));
#pragma unroll
            for (int q = 0; q < 2; ++q) __builtin_nontemporal_store(*(const LAS u32x4*)(wl + S_V + q * 1024 + lane * 16), (u32x4*)(blk + CB_V + q * 1024 + lane * 16)); }
    }
#pragma unroll
    for (int r = 0; r < 4; ++r) { const int i = 4 * g + r; gN[r] = (i < vc) ? gN[r] : 0.f; gMk[r] = (i < vc) ? gMk[r] : 0.f; gNr[r] = (i <= vc) ? gNr[r] : 0.f; gMkr[r] = (i <= vc) ? gMkr[r] : 0.f;
        ((LAS float*)(wl + A_NS))[i * 16 + vc] = gN[r]; ((LAS float*)(wl + A_MK))[i * 16 + vc] = gMk[r]; }
    u32x4 nmw; nmw.x = pk2(gNr[0], gNr[1]); nmw.y = pk2(gNr[2], gNr[3]); nmw.z = pk2(gMkr[0], gMkr[1]); nmw.w = pk2(gMkr[2], gMkr[3]);
    if (!SAMPLE) __builtin_nontemporal_store(nmw, (u32x4*)(blk + CB_NM + vc * 64 + g * 16));
    LDS_WAIT();
    float Tc[16];
#pragma unroll
    for (int i = 15; i >= 0; --i) { float acc = (i == vc) ? 1.0f : 0.0f;
#pragma unroll
        for (int m = i + 1; m < 16; ++m) acc += ((const LAS float*)(wl + A_NS))[i * 16 + m] * Tc[m];
        Tc[i] = acc; }
    bf16x8 tfr;
    { float tb[8];
#pragma unroll
      for (int j = 0; j < 8; ++j) tb[j] = (g == 0) ? Tc[j] : ((g == 1) ? Tc[8 + j] : 0.f);
      const u32x4 w_ = (u32x4){pk2(tb[0], tb[1]), pk2(tb[2], tb[3]), pk2(tb[4], tb[5]), pk2(tb[6], tb[7])}; tfr = __builtin_bit_cast(bf16x8, w_); }
    u32x2 qw;
    { const LAS float* mp = (const LAS float*)(wl + A_MK) + vc * 16 + 8 * (g & 1); const f32x4 m0 = *(const LAS f32x4*)mp, m1 = *(const LAS f32x4*)(mp + 4);
      const u32x4 w_ = (u32x4){pk2(m0[0], m0[1]), pk2(m0[2], m0[3]), pk2(m1[0], m1[1]), pk2(m1[2], m1[3])};
      const f32x4 qd = __builtin_amdgcn_mfma_f32_16x16x32_bf16(__builtin_bit_cast(bf16x8, w_), tfr, (f32x4){0.f, 0.f, 0.f, 0.f}, 0, 0, 0);
      qw = (u32x2){pk2(qd[0], qd[1]), pk2(qd[2], qd[3])};
      if (!SAMPLE) *(u32x2*)(blk + CB_QT + vc * 32 + g * 8) = qw; }
#pragma unroll
    for (int kb = 0; kb < 4; ++kb) { const bf16x8 af = *(const LAS bf16x8*)(wl + A_ATT + (16 * kb + vc) * 32 + (g & 1) * 16);
        const f32x4 pd = __builtin_amdgcn_mfma_f32_16x16x32_bf16(af, tfr, (f32x4){0.f, 0.f, 0.f, 0.f}, 0, 0, 0);
        *(LAS u32x2*)(wl + A_PS + vc * IMG + 2 * (32 * (kb >> 1) + 8 * g + 4 * (kb & 1))) = (u32x2){pk2(pd[0], pd[1]), pk2(pd[2], pd[3])}; }
    LDS_WAIT();
    if (!SAMPLE) {
#pragma unroll
        for (int sK = 0; sK < 2; ++sK) __builtin_nontemporal_store(*(const LAS u32x4*)(wl + A_PS + vc * IMG + sK * 64 + g * 16), (u32x4*)(blk + CB_PT0 + sK * 1024 + vc * 64 + g * 16));
        LDS_WAIT();
    } else {
        const int fo = vc * IMG + g * 16;
        const bf16x8 pt0 = *(const LAS bf16x8*)(wl + A_PS + fo), pt1 = *(const LAS bf16x8*)(wl + A_PS + fo + 64), nm = __builtin_bit_cast(bf16x8, nmw);
        const f32x4 rk4 = *(const LAS f32x4*)(wl + S_RK + 16 * g);
        bf16x8 qt;
        { const s16x4 qt4 = __builtin_bit_cast(s16x4, qw);
#pragma unroll
          for (int jj = 0; jj < 4; ++jj) { qt[jj] = qt4[jj]; qt[4 + jj] = 0; } }
        bf16x8 bk[4]; f32x4 gm[4];
#pragma unroll
        for (int kb = 0; kb < 4; ++kb) { bk[kb] = *(const LAS bf16x8*)(wl + S_BK + (16 * kb + vc) * 64 + g * 16); gm[kb] = *(const LAS f32x4*)(wl + S_GAM + (16 * kb + 4 * g) * 4); }
        float* op = a.out + O_WKVS + ((size_t)task * 64 + vc) * 64 + 4 * g;
        const float* sp = a.in[2] + ((size_t)task * 64 + vc) * 64 + 4 * g;
        LAS float* yb = (LAS float*)(wl + S_YB);
        f32x4 St[4][4];
#pragma unroll
        for (int wv = 0; wv < 4; ++wv)
#pragma unroll
            for (int kb = 0; kb < 4; ++kb) St[wv][kb] = *(const f32x4*)(sp + (size_t)wv * 1024 + 16 * kb);
#pragma unroll
        for (int wv = 0; wv < 4; ++wv) {
            const s16x4 vw4 = *(const LAS s16x4*)(wl + S_V + wv * 512 + vc * 32 + g * 8);
            bf16x8 vv, sf0, sf1, uv;
#pragma unroll
            for (int jj = 0; jj < 4; ++jj) { vv[jj] = vw4[jj]; vv[4 + jj] = vw4[jj]; }
            { u32x4 w_; w_.x = pk2(St[wv][0][0], St[wv][0][1]); w_.y = pk2(St[wv][0][2], St[wv][0][3]); w_.z = pk2(St[wv][1][0], St[wv][1][1]); w_.w = pk2(St[wv][1][2], St[wv][1][3]); sf0 = __builtin_bit_cast(bf16x8, w_);
              w_.x = pk2(St[wv][2][0], St[wv][2][1]); w_.y = pk2(St[wv][2][2], St[wv][2][3]); w_.z = pk2(St[wv][3][0], St[wv][3][1]); w_.w = pk2(St[wv][3][2], St[wv][3][3]); sf1 = __builtin_bit_cast(bf16x8, w_); }
            f32x4 ut = (f32x4){0.f, 0.f, 0.f, 0.f}, y0 = ut;
            ut = __builtin_amdgcn_mfma_f32_16x16x32_bf16(pt0, sf0, ut, 0, 0, 0); y0 = __builtin_amdgcn_mfma_f32_16x16x32_bf16(frs[0], sf0, y0, 0, 0, 0);
            ut = __builtin_amdgcn_mfma_f32_16x16x32_bf16(pt1, sf1, ut, 0, 0, 0); y0 = __builtin_amdgcn_mfma_f32_16x16x32_bf16(frs[1], sf1, y0, 0, 0, 0);
            ut = __builtin_amdgcn_mfma_f32_16x16x32_bf16(qt, vv, ut, 0, 0, 0);
#pragma unroll
            for (int jj = 0; jj < 4; ++jj) uv[4 + jj] = vw4[jj];
            { const unsigned u0_ = pk2(ut[0], ut[1]), u1_ = pk2(ut[2], ut[3]); uv[0] = (short)(u0_ & 0xffffu); uv[1] = (short)(u0_ >> 16); uv[2] = (short)(u1_ & 0xffffu); uv[3] = (short)(u1_ >> 16); }
            const f32x4 yt = __builtin_amdgcn_mfma_f32_16x16x32_bf16(nm, uv, y0, 0, 0, 0);
#pragma unroll
            for (int kb = 0; kb < 4; ++kb) { const f32x4 sn = __builtin_amdgcn_mfma_f32_16x16x32_bf16(bk[kb], uv, St[wv][kb] * gm[kb], 0, 0, 0); *(f32x4*)(op + (size_t)wv * 1024 + 16 * kb) = sn; }
            if (g < 2) {
#pragma unroll
                for (int r = 0; r < 4; ++r) { yb[(4 * g + r) * 68 + 16 * wv + vc] = yt[r]; yb[544 + (4 * g + r) * 68 + 16 * wv + vc] = rk4[r] * bfs2f(vw4[r]); } }
        }
        LDS_WAIT();
        { const int pt = lane >> 3, vo = lane & 7;
          const float* gwp = a.in[15] + h * 64 + 8 * vo; const float* gbp = a.in[16] + h * 64 + 8 * vo;
          const f32x4 gw0 = *(const f32x4*)gwp, gw1 = *(const f32x4*)(gwp + 4), gb0 = *(const f32x4*)gbp, gb1 = *(const f32x4*)(gbp + 4);
          const LAS float* yp = yb + pt * 68 + 8 * vo;
          const f32x4 y0_ = *(const LAS f32x4*)yp, y1_ = *(const LAS f32x4*)(yp + 4), b0_ = *(const LAS f32x4*)(yp + 544), b1_ = *(const LAS f32x4*)(yp + 548);
          const bf16x8 gt_ = __builtin_bit_cast(bf16x8, tg[0]);
          const float mean_ = red8(((y0_[0] + y0_[1]) + (y0_[2] + y0_[3])) + ((y1_[0] + y1_[1]) + (y1_[2] + y1_[3]))) * (1.0f / 64.0f);
          const f32x4 d0_ = y0_ - mean_, d1_ = y1_ - mean_;
          const float var_ = red8(scan::dot4(d0_, d0_) + scan::dot4(d1_, d1_)) * (1.0f / 64.0f); const float rs_ = rsqrtf(var_ + GN_EPS);
          const f32x4 n0_ = d0_ * rs_ * gw0 + gb0 + b0_, n1_ = d1_ * rs_ * gw1 + gb1 + b1_; float o_[8];
#pragma unroll
          for (int i_ = 0; i_ < 4; ++i_) { const float ga_ = bfs2f(gt_[i_]), gb_ = bfs2f(gt_[4 + i_]); o_[i_] = n0_[i_] * (ga_ * frcp(1.0f + __expf(-ga_))); o_[4 + i_] = n1_[i_] * (gb_ * frcp(1.0f + __expf(-gb_))); }
          *(u32x2*)(a.ws + WS_Y + (row0 + pt) * D + h * 64 + 8 * vo) = (u32x2){pk4_fp8(o_[0], o_[1], o_[2], o_[3]), pk4_fp8(o_[4], o_[5], o_[6], o_[7])}; }
        LDS_WAIT();
    }
}

struct CFrag { bf16x8 pt0, pt1, rt0, rt1, nm, bk0, bk1, bk2, bk3; s16x4 qt4, vw4; f32x4 rk4, gm0, gm1, gm2, gm3; };
__device__ __forceinline__ void chunk_scan(const Args& a, LAS unsigned char* lds, const int tid, const int p) {
    const int wave = __builtin_amdgcn_readfirstlane(tid >> 6), lane = tid & 63, vc = lane & 15, g = lane >> 4;
    const int b = p >> 5, h = p & 31;
    const unsigned char* gblk = a.ws + WS_CB + (size_t)p * NCH * CB;
    bf16_t* Y = (bf16_t*)(a.ws + WS_Y);
#define CS_BAR() do { asm volatile("s_waitcnt lgkmcnt(0)" ::: "memory"); __builtin_amdgcn_s_barrier(); asm volatile("" ::: "memory"); } while (0)
    const unsigned char* zgt = a.ws + WS_Z + (((size_t)b * TP + (lane >> 3)) * LDZ + OFF_GR + h * 64) * 2 + (lane & 7) * 16;
#define CS_ISSUE(blkidx, slot) do { _Pragma("unroll") for (int q_ = 0; q_ < 4; ++q_) { int pc_ = (wave & 3) * 4 + q_; pc_ = (pc_ >= 14) ? pc_ - 2 : pc_; \
        const unsigned char* src_ = (pc_ < 12) ? gblk + (size_t)(blkidx) * CB + pc_ * 1024 + lane * 16 : zgt + ((size_t)(blkidx) * 16 + (pc_ - 12) * 8) * LDZ * 2; \
        __builtin_amdgcn_global_load_lds((const unsigned*)src_, (LAS unsigned*)(lds + (slot) * CB + pc_ * 1024), 16, 0, 2); } } while (0)
    f32x4 St[4];
#pragma unroll
    for (int kb = 0; kb < 4; ++kb) St[kb] = (f32x4){0.f, 0.f, 0.f, 0.f};
    const int lt = tid - 256, pt = (lt >> 4) & 15, vo = lt & 15;
    const f32x4 gw0 = *(const f32x4*)(a.in[15] + h * 64 + 4 * vo), gb0 = *(const f32x4*)(a.in[16] + h * 64 + 4 * vo);
    asm volatile("s_waitcnt vmcnt(0)" ::: "memory");
    if (wave < 4) {
#pragma unroll
        for (int i = 0; i < DEPTH; ++i) CS_ISSUE(i, i);
        asm volatile("s_waitcnt vmcnt(12)" ::: "memory");
    }
    CS_BAR();
    int slot = 0, islot = DEPTH;
#define CS_POST(cc, sl) do { const LAS float* yb_ = (const LAS float*)(lds + YB_OFF + ((cc) & 1) * YB_SZ) + pt * 68 + 4 * vo; \
        const f32x4 y0_ = *(const LAS f32x4*)yb_, b0_ = *(const LAS f32x4*)(yb_ + 1088); \
        const s16x4 gt_ = *(const LAS s16x4*)(lds + (sl) * CB + CB_GATE + pt * 128 + vo * 8); \
        const float mean_ = scan::red16((y0_[0] + y0_[1]) + (y0_[2] + y0_[3])) * (1.0f / 64.0f); \
        const f32x4 d0_ = y0_ - mean_; \
        const float var_ = scan::red16(scan::dot4(d0_, d0_)) * (1.0f / 64.0f); const float rs_ = rsqrtf(var_ + GN_EPS); \
        const f32x4 n0_ = d0_ * rs_ * gw0 + gb0 + b0_; float o_[4]; \
        _Pragma("unroll") for (int i_ = 0; i_ < 4; ++i_) { const float ga_ = bfs2f(gt_[i_]); o_[i_] = n0_[i_] * (ga_ * frcp(1.0f + __expf(-ga_))); } \
        *(unsigned*)((unsigned char*)Y + ((size_t)b * TP + 16 * (cc) + pt) * D + h * 64 + 4 * vo) = pk4_fp8(o_[0], o_[1], o_[2], o_[3]); } while (0)
    const int fo = vc * 64 + g * 16;
#define CS_LOADF(F, sl) do { const LAS unsigned char* sb_ = lds + (sl) * CB; \
        F.pt0 = *(const LAS bf16x8*)(sb_ + CB_PT0 + fo); F.pt1 = *(const LAS bf16x8*)(sb_ + CB_PT1 + fo); F.rt0 = *(const LAS bf16x8*)(sb_ + CB_RT0 + fo); F.rt1 = *(const LAS bf16x8*)(sb_ + CB_RT1 + fo); F.nm = *(const LAS bf16x8*)(sb_ + CB_NM + fo); \
        F.qt4 = *(const LAS s16x4*)(sb_ + CB_QT + vc * 32 + g * 8); F.vw4 = *(const LAS s16x4*)(sb_ + CB_V + wave * 512 + vc * 32 + g * 8); F.rk4 = *(const LAS f32x4*)(sb_ + CB_RK + 16 * g); \
        F.bk0 = *(const LAS bf16x8*)(sb_ + CB_BK + fo); F.bk1 = *(const LAS bf16x8*)(sb_ + CB_BK + 1024 + fo); F.bk2 = *(const LAS bf16x8*)(sb_ + CB_BK + 2048 + fo); F.bk3 = *(const LAS bf16x8*)(sb_ + CB_BK + 3072 + fo); \
        F.gm0 = *(const LAS f32x4*)(sb_ + CB_GAM + (4 * g) * 4); F.gm1 = *(const LAS f32x4*)(sb_ + CB_GAM + (16 + 4 * g) * 4); F.gm2 = *(const LAS f32x4*)(sb_ + CB_GAM + (32 + 4 * g) * 4); F.gm3 = *(const LAS f32x4*)(sb_ + CB_GAM + (48 + 4 * g) * 4); } while (0)
#define CS_COMPUTE(F, cc) do { bf16x8 qt, vv, sf0, sf1, uv; \
        _Pragma("unroll") for (int jj = 0; jj < 4; ++jj) { qt[jj] = F.qt4[jj]; qt[4 + jj] = 0; vv[jj] = F.vw4[jj]; vv[4 + jj] = F.vw4[jj]; } \
        { u32x4 w_; w_.x = pk2(St[0][0], St[0][1]); w_.y = pk2(St[0][2], St[0][3]); w_.z = pk2(St[1][0], St[1][1]); w_.w = pk2(St[1][2], St[1][3]); sf0 = __builtin_bit_cast(bf16x8, w_); \
          w_.x = pk2(St[2][0], St[2][1]); w_.y = pk2(St[2][2], St[2][3]); w_.z = pk2(St[3][0], St[3][1]); w_.w = pk2(St[3][2], St[3][3]); sf1 = __builtin_bit_cast(bf16x8, w_); } \
        f32x4 ut = (f32x4){0.f, 0.f, 0.f, 0.f}, y0 = ut; \
        ut = __builtin_amdgcn_mfma_f32_16x16x32_bf16(F.pt0, sf0, ut, 0, 0, 0); y0 = __builtin_amdgcn_mfma_f32_16x16x32_bf16(F.rt0, sf0, y0, 0, 0, 0); \
        ut = __builtin_amdgcn_mfma_f32_16x16x32_bf16(F.pt1, sf1, ut, 0, 0, 0); y0 = __builtin_amdgcn_mfma_f32_16x16x32_bf16(F.rt1, sf1, y0, 0, 0, 0); \
        ut = __builtin_amdgcn_mfma_f32_16x16x32_bf16(qt, vv, ut, 0, 0, 0); \
        _Pragma("unroll") for (int jj = 0; jj < 4; ++jj) uv[4 + jj] = F.vw4[jj]; \
        { const unsigned u0_ = pk2(ut[0], ut[1]), u1_ = pk2(ut[2], ut[3]); uv[0] = (short)(u0_ & 0xffffu); uv[1] = (short)(u0_ >> 16); uv[2] = (short)(u1_ & 0xffffu); uv[3] = (short)(u1_ >> 16); } \
        const f32x4 yt = __builtin_amdgcn_mfma_f32_16x16x32_bf16(F.nm, uv, y0, 0, 0, 0); \
        St[0] = __builtin_amdgcn_mfma_f32_16x16x32_bf16(F.bk0, uv, St[0] * F.gm0, 0, 0, 0); St[1] = __builtin_amdgcn_mfma_f32_16x16x32_bf16(F.bk1, uv, St[1] * F.gm1, 0, 0, 0); \
        St[2] = __builtin_amdgcn_mfma_f32_16x16x32_bf16(F.bk2, uv, St[2] * F.gm2, 0, 0, 0); St[3] = __builtin_amdgcn_mfma_f32_16x16x32_bf16(F.bk3, uv, St[3] * F.gm3, 0, 0, 0); \
        LAS float* yb = (LAS float*)(lds + YB_OFF + ((cc) & 1) * YB_SZ) + 16 * wave + vc; \
        _Pragma("unroll") for (int r = 0; r < 4; ++r) { yb[(4 * g + r) * 68] = yt[r]; yb[1088 + (4 * g + r) * 68] = F.rk4[r] * bfs2f(F.vw4[r]); } } while (0)
#define CS_STEP(FC, FN, cc) do { if (wave < 4) { const int s1 = (slot + 1 == RING) ? 0 : slot + 1; const int nb = ((cc) + DEPTH < NCH) ? (cc) + DEPTH : NCH - 1; \
            CS_ISSUE(nb, islot); CS_LOADF(FN, s1); CS_COMPUTE(FC, cc); \
            asm volatile("s_waitcnt vmcnt(12)" ::: "memory");             \
        } else { if ((cc) > 0) { const int ps = (slot == 0) ? RING - 1 : slot - 1; CS_POST((cc) - 1, ps); } } \
        CS_BAR(); slot = (slot + 1 == RING) ? 0 : slot + 1; islot = (islot + 1 == RING) ? 0 : islot + 1; } while (0)
    CFrag FA, FB;
    if (wave < 4) CS_LOADF(FA, 0);
    for (int c = 0; c < NCH; c += 2) { CS_STEP(FA, FB, c); CS_STEP(FB, FA, c + 1); }
#undef CS_LOADF
#undef CS_COMPUTE
#undef CS_STEP
    if (wave >= 4) { const int ps = (slot == 0) ? RING - 1 : slot - 1; CS_POST(NCH - 1, ps); }
    if (wave < 4) { float* op = a.out + O_WKVP + (((size_t)p) * 64 + 16 * wave + vc) * 64 + 4 * g;
#pragma unroll
        for (int kb = 0; kb < 4; ++kb) *(f32x4*)(op + 16 * kb) = St[kb]; }
    asm volatile("s_waitcnt vmcnt(0)" ::: "memory");
    CS_BAR();
#undef CS_BAR
#undef CS_ISSUE
#undef CS_POST
}
}

__device__ __forceinline__ void phase_ln(const Args& a, const int tid) {
    const int lane = tid & 63, wave = tid >> 6; const int gw = blockIdx.x * 8 + wave, NGW = gridDim.x * 8;
    const float* lg = a.in[21]; const float* lb = a.in[22]; const bf16_t* H = (const bf16_t*)(a.ws + WS_Y);
    for (int m = gw; m < M; m += NGW) {
        const u32x2* hr = (const u32x2*)(H + (size_t)m * D) + lane; f32x4 v[16]; float s = 0.f;
#pragma unroll
        for (int q = 0; q < 16; ++q) { const u32x2 w = hr[64 * q];
            v[q] = (f32x4){__builtin_bit_cast(float, w.x << 16), __builtin_bit_cast(float, w.x & 0xffff0000u), __builtin_bit_cast(float, w.y << 16), __builtin_bit_cast(float, w.y & 0xffff0000u)}; }
#pragma unroll
        for (int q = 0; q < 16; ++q) s += (v[q][0] + v[q][1]) + (v[q][2] + v[q][3]);
        const float mean = wave_sum(s) * (1.0f / D); float s2 = 0.f;
#pragma unroll
        for (int q = 0; q < 16; ++q) { v[q] = v[q] - mean; s2 += (v[q][0] * v[q][0] + v[q][1] * v[q][1]) + (v[q][2] * v[q][2] + v[q][3] * v[q][3]); }
        const float rstd = rsqrtf(wave_sum(s2) * (1.0f / D) + LN_EPS);
        float* yr = a.out + O_Y + (size_t)m * D;
#pragma unroll
        for (int q = 0; q < 16; ++q) { const int c = (lane + 64 * q) * 4; const f32x4 gg = *(const f32x4*)(lg + c), bb = *(const f32x4*)(lb + c); __builtin_nontemporal_store(v[q] * rstd * gg + bb, (f32x4*)(yr + c)); }
    }
}

#define XB_TMO      128
#define XB_XCNT(j)  (256  + 64 * (j))
#define XB_XSUB(j)  (1280 + 64 * (j))
#define XB_XGEN(j)  (2304 + 64 * (j))
#define XB_TOP      3328
#define XB_TOPGEN   3392
#define XCD_BAR_WORDS 3456
#define XB_SPIN_CAP (1u << 20)
__device__ __forceinline__ unsigned xb_ld(unsigned* p)              { return __hip_atomic_load(p, __ATOMIC_RELAXED, __HIP_MEMORY_SCOPE_AGENT); }
__device__ __forceinline__ unsigned xb_add(unsigned* p, unsigned v) { return __hip_atomic_fetch_add(p, v, __ATOMIC_RELAXED, __HIP_MEMORY_SCOPE_AGENT); }
__device__ __forceinline__ unsigned xb_xcc_id() { return (unsigned)__builtin_amdgcn_s_getreg((3 << 11) | 20) & 0xFu; }
#define XB_SPIN(cond, bar) do { unsigned _sp = 0; while (cond) { __builtin_amdgcn_s_sleep(1); \
    if ((++_sp & 255u) == 0u) { if (xb_ld(&(bar)[XB_TMO])) break; if (_sp > XB_SPIN_CAP) { atomicAdd(&(bar)[XB_TMO], 1u); break; } } } } while (0)
struct XcdBarrier { unsigned* bar; unsigned x; volatile LAS unsigned* st; };
__device__ __forceinline__ XcdBarrier xcd_barrier_post(unsigned* bar, volatile LAS unsigned* st, int tid) {
    XcdBarrier b; b.bar = bar; b.x = xb_xcc_id(); b.st = st;
    if (tid == 0) (void)xb_add(&bar[XB_XCNT(b.x)], 1u);
    return b;
}
__device__ __forceinline__ void xcd_barrier_complete(unsigned* bar, unsigned x, unsigned& nloc, unsigned& nx) {
    const unsigned G = gridDim.x * gridDim.y * gridDim.z;
    unsigned sum, cnt, mine, sp = 0u;
    for (;;) {
        sum = 0u; cnt = 0u; mine = 0u;
#pragma unroll
        for (unsigned j = 0; j < 16; ++j) { const unsigned c = xb_ld(&bar[XB_XCNT(j)]); sum += c; cnt += (c > 0u) ? 1u : 0u; mine = (j == x) ? c : mine; }
        if (sum == G) break;
        __builtin_amdgcn_s_sleep(1);
        if ((++sp & 255u) == 0u) { if (xb_ld(&bar[XB_TMO])) break; if (sp > XB_SPIN_CAP) { atomicAdd(&bar[XB_TMO], 1u); break; } }
    }
    nloc = mine > 0u ? mine : 1u; nx = cnt > 0u ? cnt : 1u;
}
__device__ __forceinline__ void xcd_barrier(const XcdBarrier& b, int tid) {
    asm volatile("s_waitcnt vmcnt(0)" ::: "memory");
    __syncthreads();
    if (tid == 0) {
        unsigned* bar = b.bar;
        __builtin_amdgcn_s_waitcnt(0);
        unsigned nloc = b.st[0], nx = b.st[1];
        if (nloc == 0u) { xcd_barrier_complete(bar, b.x, nloc, nx); b.st[0] = nloc; b.st[1] = nx; }
        const unsigned old = xb_add(&bar[XB_XSUB(b.x)], 1u);
        const unsigned gen = old / nloc;
        if (old + 1u == (gen + 1u) * nloc) {
            __builtin_amdgcn_fence(__ATOMIC_RELEASE, "agent");
            asm volatile("s_waitcnt vmcnt(0)" ::: "memory");
            const unsigned og = xb_add(&bar[XB_TOP], 1u);
            const unsigned tg = og / nx;
            if (og + 1u == (tg + 1u) * nx) xb_add(&bar[XB_TOPGEN], 1u);
            else XB_SPIN(xb_ld(&bar[XB_TOPGEN]) == tg, bar);
            __builtin_amdgcn_fence(__ATOMIC_ACQUIRE, "agent");
            xb_add(&bar[XB_XGEN(b.x)], 1u);
            asm volatile("s_waitcnt vmcnt(0)" ::: "memory");
        } else {
            XB_SPIN(xb_ld(&bar[XB_XGEN(b.x)]) == gen, bar);
            __builtin_amdgcn_fence(__ATOMIC_ACQUIRE, "agent");
            asm volatile("s_waitcnt vmcnt(0)" ::: "memory");
        }
    }
    __syncthreads();
}

template <bool COOP>
__global__ void __launch_bounds__(NTHREADS, 2) fwd_kernel(Args a) {
    extern __shared__ __attribute__((aligned(16))) unsigned char lds_raw[];
    LAS unsigned char* lds = (LAS unsigned char*)lds_raw;
    const int lo = a.ph_lo, hi = a.ph_hi;
    const int wid_s = __builtin_amdgcn_readfirstlane((int)(threadIdx.x >> 6));
#define TID() (wid_s * 64 + lane_id_opaque())
    unsigned char* ws = a.ws;
#define IN(k) (lo <= (k) && (k) < hi)
#define SEAM(k) do { if (COOP && IN(k) && IN((k) + 1)) { xcd_barrier(xbar, TID()); } } while (0)
    XcdBarrier xbar; xbar.bar = (unsigned*)(ws + WS_BAR); xbar.x = 0; xbar.st = (volatile LAS unsigned*)(lds + LDS_MISC);
    if (COOP) {
        if (a.ph_lo < 0) cg::this_grid().sync();
        if (threadIdx.x < 2) ((LAS unsigned*)(lds + LDS_MISC))[threadIdx.x] = 0u;
        __syncthreads();
        xbar = xcd_barrier_post((unsigned*)(ws + WS_BAR), (volatile LAS unsigned*)(lds + LDS_MISC), TID());
    }
    for (int rp_ = 0; rp_ < (PROBE_REP == 0 ? 2 : 1); ++rp_)
    if (IN(0)) { phase_convert(a, lds, TID()); __syncthreads(); }
    SEAM(0);
    for (int rp_ = 0; rp_ < (PROBE_REP == 1 ? 2 : 1); ++rp_)
    if (IN(1)) {
        const int G_ = (int)gridDim.x, c_ = (int)blockIdx.x; const bool full = (G_ == 256); const int cr_ = full ? ((c_ + 76) & 255) : c_;
        if (!full) { convert_rest(a, lds, TID(), c_, G_); __syncthreads(); }
        { pg8::Gemm g{(const bf16_t*)(ws + WS_XB), (const bf16_t*)(ws + WS_W1T), D, D, D / 64, 64, 64}; pg8::TileOrder S; S.init(M, N_BF, G_, c_, 1, D / 64);
          S.nextra = N_BFX / 256; S.ex_pm = M / 256; S.ex_pn0 = N_BF / 256;
          pg8::EpiZ E{(bf16_t*)(ws + WS_Z), LDZ, 17, 19, 2048, OFF_K, 0, 1.0f, ws + WS_G, 1 << 20};
          pg8::gemm_phase<pg8::EpiZ, true, true, false>(lds, g, S, E, TID()); }
        { pg8::Gemm g{(const bf16_t*)(ws + WS_XB8), (const bf16_t*)(ws + WS_W8T), D, D, D / 128, D / 128, D / 128}; pg8::TileOrder S; S.init(M, N_F8, G_, cr_, 1, D / 128);
          if (full) { S.gA = 76; S.tA = 11; S.nBt = S.nwg - 76 * 11; }
          pg8::EpiZ E{(bf16_t*)(ws + WS_Z), LDZ, 8, 24, 0, OFF_GR, OFF_GA, 1.0f / 64.0f, ws + WS_G, 32};
          pg8::gemm_phase<pg8::EpiZ, true, true, true>(lds, g, S, E, TID()); }
        if (full && cr_ >= 104) { __syncthreads(); convert_rest(a, lds, TID(), cr_ - 104, 152); }
    }
    SEAM(1);
    for (int rp_ = 0; rp_ < (PROBE_REP == 2 ? 2 : 1); ++rp_)
    if (IN(2)) {
        const int tid = TID();
        { const bf16_t* Z = (const bf16_t*)(ws + WS_Z);
          for (size_t i = (size_t)blockIdx.x * NTHREADS + tid; i < (size_t)(NB_P + NB_S) * (SHIFT_W / 8); i += (size_t)gridDim.x * NTHREADS) {
              const int r = (int)(i / (SHIFT_W / 8)), c = (int)(i % (SHIFT_W / 8)) * 8;
              const size_t zrow = (c < 2048) ? (size_t)(M + r) : ((r < NB_P) ? ((size_t)r * TP + TP - 1) : ((size_t)M_P + (size_t)(r - NB_P) * TS + TS - 1));
              float* op = (r < NB_P) ? a.out + O_SHP + (size_t)r * SHIFT_W + c : a.out + O_SHS + (size_t)(r - NB_P) * SHIFT_W + c;
              att::store8f(op, *(const bf16x8*)(Z + zrow * LDZ + c)); } }
        lora_sample(a, tid);
        if (COOP) { lora_a_panel(a, 0, tid, (int)blockIdx.x * NTHREADS + tid, (int)gridDim.x * NTHREADS, M_P * 32); VM_WAIT(); __syncthreads(); }
    }
    if (COOP && IN(2)) { xcd_barrier(xbar, TID()); }
    for (int rp_ = 0; rp_ < (PROBE_REP == 22 ? 2 : 1); ++rp_)
    if (IN(2)) {
        const int tid = TID();
        pg8::TileOrder S; S.init(M_P, 4096, gridDim.x, blockIdx.x, 1, 2); S.khalf_pn = 8;
        if (!COOP) { pg8::Unit u; int lastpm = -1; for (int i = 0; S.next(i, u); ++i) if (u.pm != lastpm) { lora_a_panel(a, u.pm, tid); lastpm = u.pm; } VM_WAIT(); __syncthreads(); }
        { pg8::Gemm g{(const bf16_t*)(ws + WS_AL), (const bf16_t*)(ws + WS_WLT), 256, 256, 4, 4, 4};
          pg8::EpiLora E{(bf16_t*)(ws + WS_DW), (bf16_t*)(ws + WS_AA), a.in[8], a.in[10]};
          pg8::gemm_phase<pg8::EpiLora, true, true>(lds, g, S, E, tid); }
    }
    SEAM(2);
    const bool full3 = ((int)gridDim.x == 256);
    for (int rp_ = 0; rp_ < (PROBE_REP == 3 ? 2 : 1); ++rp_)
    if (IN(3)) {
        const int tid = TID();
        if (!full3) for (int u = blockIdx.x; u < 256 + 512; u += gridDim.x) { if (u < 256) att::unit_prompt(a, lds, u, tid); else att::unit_sample(a, lds, u - 256, tid); }
        for (int r12 = 0; r12 < (PROBE_REP == 12 ? 2 : 1); ++r12)
        { const int wv = tid >> 6, NW = (int)gridDim.x * 8, gw = (int)blockIdx.x * 8 + wv; int tp = gw, tsm = gw;
          for (int i = gw % 5; ; ++i) { if (i >= 5) i -= 5;
              const bool hp = tp < 128 * cscan::NCH, hs = tsm < NB_S * NH; if (!hp && !hs) break;
              if (hs && (i == 4 || !hp)) { cscan::chunk_pre<true>(a, lds + wv * cscan::A_WAVE, tsm, tid & 63); tsm += NW; }
              else { cscan::chunk_pre<false>(a, lds + wv * cscan::A_WAVE, tp, tid & 63); tp += NW; } } }
        __syncthreads();
    }
    if (COOP && IN(3)) { xcd_barrier(xbar, TID()); }
    if (IN(3)) {
        const int tid = TID();
        if (full3) {
            if (blockIdx.x < 128) { for (int r13 = 0; r13 < (PROBE_REP == 13 ? 2 : 1); ++r13) cscan::chunk_scan(a, lds, tid, blockIdx.x);
                for (int u = (int)blockIdx.x; u < 384; u += 128) att::unit_sample(a, lds, u, tid); }
            else { const int j = (int)blockIdx.x - 128; for (int r10 = 0; r10 < (PROBE_REP == 10 ? 2 : 1); ++r10) { att::unit_prompt(a, lds, j, tid); att::unit_prompt(a, lds, j + 128, tid); att::unit_sample(a, lds, 384 + j, tid); } }
        } else {
            for (int p = blockIdx.x; p < 128; p += gridDim.x) cscan::chunk_scan(a, lds, tid, p);
        }
    }
    SEAM(3);
    for (int rp_ = 0; rp_ < (PROBE_REP == 4 ? 2 : 1); ++rp_)
    if (IN(4)) {
        pg8::Gemm g{(const bf16_t*)(ws + WS_Y), (const bf16_t*)(ws + WS_W2T), D / 2, D / 2, 16, 0, 32}; pg8::TileOrder S; S.init(M, D, gridDim.x, blockIdx.x, 2, 16, true, 0);
        pg8::EpiMix E{ws + WS_G, ws + WS_MIX};
        pg8::gemm_phase<pg8::EpiMix, true, true, true>(lds, g, S, E, TID());
        pg8::TileOrder S2; S2.init(M, D, gridDim.x, blockIdx.x, 2, 16, true, 1);
        pg8::EpiMixTail E2{ws + WS_G, ws + WS_MIX, pg8::TailCtx{(float*)(ws + WS_CB), (unsigned*)(ws + WS_TCNT), (volatile LAS unsigned*)(lds + LDS_MISC + 16)}};
        pg8::gemm_phase<pg8::EpiMixTail, true, true, true>(lds, g, S2, E2, TID());
    }
    SEAM(4);
    for (int rp_ = 0; rp_ < (PROBE_REP == 5 ? 2 : 1); ++rp_)
    if (IN(5)) {
        pg8::Gemm g{(const bf16_t*)(ws + WS_MIX), (const bf16_t*)(ws + WS_W3T), D / 2, D / 2, 32, 0, 32}; pg8::TileOrder S; S.init(M, D, gridDim.x, blockIdx.x, 1, 32, true, 0);
        pg8::EpiH E{a.in[0], a.in[1], (bf16_t*)(ws + WS_Y)};
        pg8::gemm_phase<pg8::EpiH, true, true, true>(lds, g, S, E, TID());
        pg8::TileOrder S2; S2.init(M, D, gridDim.x, blockIdx.x, 1, 32, true, 1);
        pg8::EpiHTail E2{a.in[0], a.in[1], (bf16_t*)(ws + WS_Y), pg8::TailCtx{(float*)(ws + WS_CB) + (size_t)64 * 4 * 65536, (unsigned*)(ws + WS_TCNT) + 1024, (volatile LAS unsigned*)(lds + LDS_MISC + 16)}};
        pg8::gemm_phase<pg8::EpiHTail, true, true, true>(lds, g, S2, E2, TID());
    }
    SEAM(5);
    if (IN(6)) { phase_ln(a, TID()); }
#undef IN
#undef SEAM
#undef TID
}

extern "C" void kernel_launch(void* const* d_in, const int* in_sizes, int n_in, void* d_out, int out_size, void* d_ws, size_t ws_size, hipStream_t stream) {
    static int grid = 0;
    if (grid == 0) {
        if (n_in != 23 || out_size != (int)O_END || ws_size < WS_END) { fprintf(stderr, "kernel_launch: unexpected shapes: n_in %d out %d ws %zu (need %zu)\n", n_in, out_size, ws_size, (size_t)WS_END); grid = -1; return; }
        int dev = 0, cus = 0, per_cu = 0;
        if (hipGetDevice(&dev) != hipSuccess || hipDeviceGetAttribute(&cus, hipDeviceAttributeMultiprocessorCount, dev) != hipSuccess) { grid = -1; return; }
        if (hipFuncSetAttribute((const void*)fwd_kernel<(MK_FUSED != 0)>, hipFuncAttributeMaxDynamicSharedMemorySize, LDS_BYTES) != hipSuccess) { fprintf(stderr, "kernel_launch: hipFuncSetAttribute failed\n"); grid = -1; return; }
        if (hipOccupancyMaxActiveBlocksPerMultiprocessor(&per_cu, (const void*)fwd_kernel<(MK_FUSED != 0)>, NTHREADS, LDS_BYTES) != hipSuccess || per_cu < 1) { fprintf(stderr, "kernel_launch: occupancy query says %d\n", per_cu); per_cu = 1; }
        (void)hipGetLastError();
        grid = cus;
    }
    if (grid < 0) return;
    Args a{};
    for (int i = 0; i < 23; ++i) a.in[i] = (const float*)d_in[i];
    a.out = (float*)d_out; a.ws = (unsigned char*)d_ws;
#if MK_FUSED
    a.ph_lo = 0; a.ph_hi = 7;
    if (hipMemsetAsync(d_ws, 0, 65536, stream) != hipSuccess) { fprintf(stderr, "kernel_launch: hipMemsetAsync of the control words failed\n"); return; }
    void* args[] = {&a};
    hipError_t e = hipLaunchCooperativeKernel((const void*)fwd_kernel<true>, dim3(grid), dim3(NTHREADS), args, LDS_BYTES, stream);
    if (e != hipSuccess) fprintf(stderr, "cooperative launch failed: %s (grid %d)\n", hipGetErrorString(e), grid);
#else
    for (int p = 0; p < 7; ++p) { a.ph_lo = p; a.ph_hi = p + 1; hipLaunchKernelGGL(fwd_kernel<false>, dim3(grid), dim3(NTHREADS), LDS_BYTES, stream, a); }
#endif
}
```

```cpp
#include <hip/hip_runtime.h>
#include <hip/hip_cooperative_groups.h>
#include <cstdio>
#include <cstdint>
namespace cg = cooperative_groups;

#ifndef MK_FUSED
#define MK_FUSED 1
#endif

#ifndef PROBE_REP
#define PROBE_REP -1
#endif
#define LAS __attribute__((address_space(3)))
typedef unsigned short bf16_t;
typedef short bf16x8 __attribute__((ext_vector_type(8)));
typedef short s16x4 __attribute__((ext_vector_type(4)));
typedef float f32x4 __attribute__((ext_vector_type(4)));
typedef float f32x2 __attribute__((ext_vector_type(2)));
typedef unsigned u32x4 __attribute__((ext_vector_type(4)));
typedef unsigned u32x2 __attribute__((ext_vector_type(2)));

constexpr int D = 4096, M_P = 8192, M_S = 1024, M = M_P + M_S;
constexpr int TP = 2048, TS = 8, NB_S = 128, NB_P = 4;
constexpr int NZ = 21248, LDZ = 13056;
constexpr int RW = 2048, SHIFT_W = 6400, NH = 32, HS = 64;
constexpr int N_BF = 4864, N_BFX = 2048, N_F8 = 16384, M_X = 256;
constexpr int OFF_WD = 6144, OFF_GR = 6400, OFF_Q = 8448, OFF_K = 10496, OFF_V = 10752, OFF_GA = 11008, OFF_MR = 13056, OFF_MA = 17152;
constexpr float ALPHA = 1.189207115002721f;
constexpr float LN_EPS = 1e-5f, GN_EPS = 64e-5f;
constexpr size_t O_Y = 0, O_WKVP = 37748736, O_SHP = 38273024, O_WKP = 38298624, O_WVP = 38429696, O_WKVS = 38560768, O_SHS = 55337984, O_WKS = 56157184, O_WVS = 60351488, O_END = 64545792;
constexpr size_t al1m(size_t x) { return (x + ((1u << 20) - 1)) & ~(size_t)((1u << 20) - 1); }
constexpr size_t WS_BAR = 0;
constexpr size_t WS_TCNT = 32768;
constexpr size_t WS_ROPE = 1u << 20;
constexpr size_t WS_XB = 2u << 20;
constexpr size_t WS_W1T = al1m(WS_XB + (size_t)(M + M_X) * D * 2);
constexpr size_t WS_W2T = al1m(WS_W1T + (size_t)NZ * D * 2);
constexpr size_t WS_W3T = al1m(WS_W2T + (size_t)D * D * 2);
constexpr size_t WS_WLT = al1m(WS_W3T + (size_t)D * D * 2);
constexpr size_t WS_Z = al1m(WS_WLT + (size_t)4096 * 256 * 2);
constexpr size_t WS_AL = al1m(WS_Z + (size_t)(M + M_X) * LDZ * 2);
constexpr size_t WS_DW = al1m(WS_AL + (size_t)M * 256 * 2);
constexpr size_t WS_AA = al1m(WS_DW + (size_t)M * 2048 * 4);
constexpr size_t WS_Y = al1m(WS_AA + (size_t)M * 2048 * 4);
constexpr size_t WS_MIX = al1m(WS_Y + (size_t)M * D * 2);
constexpr size_t WS_CB = al1m(WS_MIX + (size_t)M * D * 2);
constexpr size_t WS_XB8 = al1m(WS_CB + (size_t)16384 * 14336);
constexpr size_t WS_W8T = al1m(WS_XB8 + (size_t)M * D);
constexpr size_t WS_G = al1m(WS_W8T + (size_t)N_F8 * D);
constexpr size_t GTILE = 131072;
constexpr size_t WS_END = al1m(WS_G + (size_t)(M / 256) * 32 * GTILE);

constexpr int LDS_BYTES = 147456;
constexpr int NTHREADS = 512;
constexpr int LDS_MISC = 131072;

typedef __bf16 bf16x2_t __attribute__((ext_vector_type(2)));
__device__ __forceinline__ unsigned pk2(float lo, float hi) { const f32x2 v = {lo, hi}; return __builtin_bit_cast(unsigned, __builtin_convertvector(v, bf16x2_t)); }
__device__ __forceinline__ unsigned f2bf(float f) { return pk2(f, 0.f) & 0xffffu; }
__device__ __forceinline__ unsigned pk4_fp8(float a, float b, float c, float d) { int p = __builtin_amdgcn_cvt_pk_fp8_f32(a, b, 0, false); p = __builtin_amdgcn_cvt_pk_fp8_f32(c, d, p, true); return (unsigned)p; }
__device__ __forceinline__ float frcp(float x) { return __builtin_amdgcn_rcpf(x); }
__device__ __forceinline__ float bf2f(unsigned short b) { return __builtin_bit_cast(float, ((unsigned)b) << 16); }
__device__ __forceinline__ float bfs2f(short b) { return __builtin_bit_cast(float, ((unsigned)(unsigned short)b) << 16); }
__device__ __forceinline__ float wave_sum(float v) {
#pragma unroll
    for (int o = 1; o < 64; o <<= 1) v += __shfl_xor(v, o);
    return v;
}
__device__ __forceinline__ float sigmoidf_(float x) { return frcp(1.0f + __expf(-x)); }
__device__ __forceinline__ int lane_id_opaque() { int l; asm volatile("v_mbcnt_lo_u32_b32 %0, -1, 0\n\tv_mbcnt_hi_u32_b32 %0, -1, %0" : "=v"(l)); return l; }
#define LDS_WAIT() asm volatile("s_waitcnt lgkmcnt(0)" ::: "memory")
#define VM_WAIT() asm volatile("s_waitcnt vmcnt(0)" ::: "memory")

namespace pg8 {
constexpr int BM = 256, BK = 64, HALF = 128, HTB = HALF * BK * 2  , STAGE_BYTES = 8 * HTB, NXCD = 8, WGM = 8;
__host__ __device__ __forceinline__ int lds_byte(int r, int c) { const int st = (r >> 4) * 2 + (c >> 5), rr = r & 15, cc = c & 31, ob = rr * 64 + cc * 2; return st * 1024 + (ob ^ (((ob >> 9) & 1) << 5)); }
__host__ __device__ __forceinline__ void stage_rc(int b, int& R, int& C) { const int st = b / 1024, sb = b % 1024, swz = sb ^ (((sb >> 9) & 1) << 5); R = (st >> 1) * 16 + swz / 64; C = (st & 1) * 32 + (swz % 64) / 2; }
__host__ __device__ __forceinline__ int perm32(int rho) { const int n = rho >> 4, i = rho & 15; return 8 * (i >> 2) + 4 * n + (i & 3); }

struct Unit { int pm, pn, kt0, mode, nt, tt; };
struct Gemm { const bf16_t* A; const bf16_t* Bt; int lda, ldb, nt, ablk, bblk; };

struct TileOrder {
    int nM, nN, nwg, G, c, halves, nth, nfull, part;
    int khalf_pn;
    int nextra, ex_pm, ex_pn0;
    int gA, tA, nBt;
    __device__ __forceinline__ void init(int M_, int N_, int G_, int c_, int halves_, int nth_, bool split_tail = false, int part_ = 0) { part = part_; gA = 0; tA = 0; nBt = 0; nextra = 0; ex_pm = 0; ex_pn0 = 0; khalf_pn = 0; nM = M_ / BM; nN = N_ / BM; nwg = nM * nN; G = G_; c = c_; halves = halves_; nth = nth_;
        nfull = (split_tail && G == 256 && (nwg % 256) == 64) ? nwg - 64 : nwg; }
    __device__ __forceinline__ void tile(long L, Unit& u) const {
        int wgid = (int)L; { const int q = nwg / NXCD, r = nwg % NXCD, xcd = wgid % NXCD, off = wgid / NXCD; wgid = (xcd < r ? xcd * (q + 1) : r * (q + 1) + (xcd - r) * q) + off; }
        const int nig = WGM * nN, gid = wgid / nig, fm = gid * WGM, gsz = (nM - fm) < WGM ? (nM - fm) : WGM;
        u.pm = fm + ((wgid % nig) % gsz); u.pn = (wgid % nig) / gsz; }
    __device__ __forceinline__ bool next(int i, Unit& u) const {
        const int ti = (halves == 2) ? (i >> 1) : i, hf = (halves == 2) ? (i & 1) : 0;
        if (gA > 0) { int L2; if (c >= gA) { L2 = i * (G - gA) + (c - gA); if (L2 >= nBt) return false; } else { if (i >= tA) return false; L2 = nBt + i * gA + c; }
            tile(L2, u); u.kt0 = 0; u.mode = 2; u.nt = nth; u.tt = 0; return true; }
        const int L = ti * G + c;
        if (part == 0) { if (L >= nfull + nextra) return false; if (L >= nfull) { u.pm = ex_pm; u.pn = ex_pn0 + (L - nfull); } else tile(L, u); u.kt0 = hf * nth + ((khalf_pn > 0 && u.pn >= khalf_pn) ? nth : 0); u.mode = (halves == 2) ? hf : 2; u.nt = nth; u.tt = 0; return true; }
        if (nfull == nwg || i != 0) return false;
        const int xcd = c & 7, j = c >> 3, q = j & 3; u.tt = xcd + 8 * (j >> 2);
        tile((long)nfull + u.tt, u); u.nt = (halves * nth) / 4; u.kt0 = q * u.nt; u.mode = 4 + q; return true;
    }
};

struct TailCtx { float* slabs; unsigned* cnt; volatile LAS unsigned* flag; };
__device__ __forceinline__ void tail_exchange(f32x4 (&acc)[2][2][4][2], const Unit& u, const TailCtx& T, int wid, int lane) {
    const int q = u.mode - 4;
    float* base = T.slabs + (size_t)u.tt * 4 * 65536 + (size_t)(wid * 32) * 256 + lane * 4;
    { float* my = base + (size_t)q * 65536;
#pragma unroll
      for (int ai = 0; ai < 2; ++ai)
#pragma unroll
        for (int bj = 0; bj < 2; ++bj) if (ai * 2 + bj != q) {
#pragma unroll
            for (int m = 0; m < 4; ++m)
#pragma unroll
                for (int n = 0; n < 2; ++n) *(f32x4*)(my + (((ai * 2 + bj) * 4 + m) * 2 + n) * 256) = acc[ai][bj][m][n]; } }
    asm volatile("s_waitcnt vmcnt(0)" ::: "memory");
    __builtin_amdgcn_s_barrier();
    if (wid == 0 && lane == 0) {
        __builtin_amdgcn_fence(__ATOMIC_RELEASE, "agent");
        asm volatile("s_waitcnt vmcnt(0)" ::: "memory");
        (void)__hip_atomic_fetch_add(T.cnt + 16 * u.tt, 1u, __ATOMIC_RELAXED, __HIP_MEMORY_SCOPE_AGENT);
        unsigned sp = 0;
        while (__hip_atomic_load(T.cnt + 16 * u.tt, __ATOMIC_RELAXED, __HIP_MEMORY_SCOPE_AGENT) < 4u) { __builtin_amdgcn_s_sleep(2); if (++sp > (1u << 22)) break; }
        __builtin_amdgcn_fence(__ATOMIC_ACQUIRE, "agent");
        asm volatile("s_waitcnt vmcnt(0)" ::: "memory");
    }
    asm volatile("s_waitcnt vmcnt(0) lgkmcnt(0)" ::: "memory");
    __builtin_amdgcn_s_barrier();
    asm volatile("" ::: "memory");
#pragma unroll
    for (int ai = 0; ai < 2; ++ai)
#pragma unroll
        for (int bj = 0; bj < 2; ++bj) if (ai * 2 + bj == q) {
            f32x4 tv[3][4][2];
#pragma unroll
            for (int o = 0; o < 3; ++o) { const int qq = (q + 1 + o) & 3; const float* ot = base + (size_t)qq * 65536;
#pragma unroll
                for (int m = 0; m < 4; ++m)
#pragma unroll
                    for (int n = 0; n < 2; ++n) tv[o][m][n] = *(const f32x4*)(ot + (((ai * 2 + bj) * 4 + m) * 2 + n) * 256); }
#pragma unroll
            for (int m = 0; m < 4; ++m)
#pragma unroll
                for (int n = 0; n < 2; ++n) acc[ai][bj][m][n] += (tv[0][m][n] + tv[1][m][n]) + tv[2][m][n];
        }
}

__device__ __forceinline__ unsigned cvt_pk_bf16(float lo, float hi) { unsigned r; asm volatile("v_cvt_pk_bf16_f32 %0, %1, %2" : "=v"(r) : "v"(lo), "v"(hi)); return r; }

typedef int i32x4_t __attribute__((ext_vector_type(4))); typedef int i32x8_t __attribute__((ext_vector_type(8)));
__device__ __forceinline__ i32x8_t cat8(bf16x8 lo, bf16x8 hi) { return __builtin_shufflevector(__builtin_bit_cast(i32x4_t, lo), __builtin_bit_cast(i32x4_t, hi), 0, 1, 2, 3, 4, 5, 6, 7); }
template <class Epi, bool ALIGN_EPI, bool SP2, bool F8 = false>
__device__ __forceinline__ void gemm_phase(LAS unsigned char* lds, const Gemm g, const TileOrder& S, const Epi& E, const int tid) {
    const int wid = __builtin_amdgcn_readfirstlane(tid >> 6), lane = tid & 63, wr = wid >> 2, wc = wid & 3, fr = lane & 15, fq = lane >> 4;
    unsigned voffA[2], voffB[2];
#pragma unroll
    for (int i = 0; i < 2; ++i) { int R, C; stage_rc(tid * 16 + i * 8192, R, C); const int Rb = Epi::PERM ? ((R & ~31) + perm32(R & 31)) : R;
        voffA[i] = g.ablk ? (unsigned)(tid * 16 + i * 8192) : (unsigned)(R * g.lda + C) * 2u; voffB[i] = g.bblk ? (unsigned)(tid * 16 + i * 8192) : (unsigned)(Rb * g.ldb + C) * 2u; }
    const size_t kstepA = g.ablk ? (size_t)HTB : (size_t)(BK * 2), kstepB = g.bblk ? (size_t)HTB : (size_t)(BK * 2);
    const size_t hstepA = g.ablk ? (size_t)g.ablk * HTB : (size_t)HALF * g.lda * 2, hstepB = g.bblk ? (size_t)g.bblk * HTB : (size_t)HALF * g.ldb * 2;
    const size_t tstepA = 2 * hstepA, tstepB = 2 * hstepB;
    const unsigned ldsw = (unsigned)wid * 1024u;
    const int aoff = lds_byte(wr * 64 + fr, fq * 8), boff = lds_byte(wc * 32 + fr, fq * 8);
#define PG8_SA(b, h) (((b) * 2 + (h)) * HTB)
#define PG8_SB(b, h) ((4 + (b) * 2 + (h)) * HTB)
#define PG8_STAGE(bufoff, gbase, voff) do { _Pragma("unroll") for (int _i = 0; _i < 2; ++_i) { unsigned vo_ = (voff)[_i]; asm volatile("" : "+v"(vo_));     \
        __builtin_amdgcn_global_load_lds((const unsigned*)((const char*)(gbase) + vo_), (LAS unsigned*)(lds + (bufoff) + ldsw + _i * 8192), 16, 0, 0); } } while (0)
#define PG8_LDA(dst, b, h) do { _Pragma("unroll") for (int m = 0; m < 4; ++m) { const i32x4_t l0_ = *(const LAS i32x4_t*)(lds + PG8_SA(b, h) + aoff + m * 2048), l1_ = *(const LAS i32x4_t*)(lds + PG8_SA(b, h) + aoff + m * 2048 + 1024); \
        dst[m] = __builtin_shufflevector(l0_, l1_, 0, 1, 2, 3, 4, 5, 6, 7); } } while (0)
#define PG8_LDB(dst, b, h) do { _Pragma("unroll") for (int n = 0; n < 2; ++n) { const i32x4_t l0_ = *(const LAS i32x4_t*)(lds + PG8_SB(b, h) + boff + n * 2048), l1_ = *(const LAS i32x4_t*)(lds + PG8_SB(b, h) + boff + n * 2048 + 1024); \
        dst[n] = __builtin_shufflevector(l0_, l1_, 0, 1, 2, 3, 4, 5, 6, 7); } } while (0)
#define PG8_H(x, k) __builtin_bit_cast(bf16x8, __builtin_shufflevector(x, x, 4 * (k), 4 * (k) + 1, 4 * (k) + 2, 4 * (k) + 3))
#define PG8_MMA(ai, bj, At, Bt) do { __builtin_amdgcn_s_setprio(1); _Pragma("unroll") for (int m = 0; m < 4; ++m) _Pragma("unroll") for (int n = 0; n < 2; ++n) { \
        if constexpr (F8) acc[ai][bj][m][n] = __builtin_amdgcn_mfma_scale_f32_16x16x128_f8f6f4(Bt[n], At[m], acc[ai][bj][m][n], 0, 0, 0, 0x7F7F7F7F, 0, 0x7F7F7F7F); \
        else { acc[ai][bj][m][n] = __builtin_amdgcn_mfma_f32_16x16x32_bf16(PG8_H(Bt[n], 0), PG8_H(At[m], 0), acc[ai][bj][m][n], 0, 0, 0); \
               acc[ai][bj][m][n] = __builtin_amdgcn_mfma_f32_16x16x32_bf16(PG8_H(Bt[n], 1), PG8_H(At[m], 1), acc[ai][bj][m][n], 0, 0, 0); } } \
        __builtin_amdgcn_s_setprio(0); } while (0)
#define PG8_WAIT_V(n) asm volatile("s_waitcnt vmcnt(" #n ")" ::: "memory")
#define PG8_WAIT_L(n) asm volatile("s_waitcnt lgkmcnt(" #n ")" ::: "memory")
#define PG8_BAR __builtin_amdgcn_s_barrier()
#define PG8_SCHED __builtin_amdgcn_sched_barrier(0)
    Unit cur, nxt; int ui = 0;
    if (!S.next(0, cur)) return;
    f32x4 acc[2][2][4][2];
#pragma unroll
    for (int a = 0; a < 2; ++a)
#pragma unroll
        for (int b = 0; b < 2; ++b)
#pragma unroll
            for (int m = 0; m < 4; ++m)
#pragma unroll
                for (int n = 0; n < 2; ++n) acc[a][b][m][n] = (f32x4){0.f, 0.f, 0.f, 0.f};
    i32x8_t At[4], B0[2], B1[2];
    const char* cA = (const char*)g.A + (size_t)cur.pm * tstepA + (size_t)cur.kt0 * kstepA; const char* cB = (const char*)g.Bt + (size_t)cur.pn * tstepB + (size_t)cur.kt0 * kstepB;
    if constexpr (SP2) {
        PG8_STAGE(PG8_SB(0, 0), cB, voffB); PG8_STAGE(PG8_SB(0, 1), cB + hstepB, voffB); PG8_STAGE(PG8_SA(0, 0), cA, voffA); PG8_STAGE(PG8_SA(0, 1), cA + hstepA, voffA);
        if (wr == 1) PG8_BAR;
        PG8_WAIT_V(2); PG8_BAR;
        PG8_STAGE(PG8_SB(1, 0), cB + kstepB, voffB); PG8_STAGE(PG8_SA(1, 0), cA + kstepA, voffA); PG8_STAGE(PG8_SB(1, 1), cB + hstepB + kstepB, voffB);
        PG8_WAIT_V(6); PG8_BAR;
    } else {
        PG8_STAGE(PG8_SB(0, 0), cB, voffB); PG8_STAGE(PG8_SA(0, 0), cA, voffA); PG8_STAGE(PG8_SB(0, 1), cB + hstepB, voffB); PG8_STAGE(PG8_SA(0, 1), cA + hstepA, voffA);
        if (wr == 1) PG8_BAR;
        PG8_WAIT_V(4); PG8_BAR;
        PG8_STAGE(PG8_SB(1, 0), cB + kstepB, voffB); PG8_STAGE(PG8_SA(1, 0), cA + kstepA, voffA); PG8_STAGE(PG8_SB(1, 1), cB + hstepB + kstepB, voffB);
        PG8_WAIT_V(6); PG8_BAR;
    }
    for (;;) {
        const bool has_next = S.next(ui + 1, nxt);
        const char* nA = has_next ? (const char*)g.A + (size_t)nxt.pm * tstepA + (size_t)nxt.kt0 * kstepA : cA; const char* nB = has_next ? (const char*)g.Bt + (size_t)nxt.pn * tstepB + (size_t)nxt.kt0 * kstepB : cB;
        const int nt = cur.nt;
        for (int t = 0; t < nt; t += 2) {
            const bool last = (t == nt - 2);
            const char* a1 = cA + (size_t)(t + 1) * kstepA;
            const char* a2 = last ? nA : cA + (size_t)(t + 2) * kstepA; const char* b2 = last ? nB : cB + (size_t)(t + 2) * kstepB;
            const char* a3 = a2 + kstepA; const char* b3 = b2 + kstepB;
            if constexpr (SP2) {
            PG8_LDB(B0, 0, 0); PG8_LDB(B1, 0, 1); PG8_SCHED; PG8_LDA(At, 0, 0); PG8_STAGE(PG8_SA(1, 1), a1 + hstepA, voffA);
            PG8_WAIT_V(8); PG8_WAIT_L(0); PG8_BAR; PG8_MMA(0, 0, At, B0); PG8_MMA(0, 1, At, B1); PG8_BAR; PG8_SCHED;
            PG8_LDA(At, 0, 1); PG8_STAGE(PG8_SB(0, 0), b2, voffB); PG8_STAGE(PG8_SB(0, 1), b2 + hstepB, voffB); PG8_STAGE(PG8_SA(0, 0), a2, voffA);
            PG8_WAIT_V(8); PG8_WAIT_L(0); PG8_BAR; PG8_MMA(1, 0, At, B0); PG8_MMA(1, 1, At, B1); PG8_BAR; PG8_SCHED;
            PG8_LDB(B0, 1, 0); PG8_LDB(B1, 1, 1); PG8_SCHED; PG8_LDA(At, 1, 0); PG8_STAGE(PG8_SA(0, 1), a2 + hstepA, voffA);
            PG8_WAIT_V(8); PG8_WAIT_L(0); PG8_BAR; PG8_MMA(0, 0, At, B0); PG8_MMA(0, 1, At, B1); PG8_BAR; PG8_SCHED;
            PG8_LDA(At, 1, 1); PG8_STAGE(PG8_SB(1, 0), b3, voffB); PG8_STAGE(PG8_SB(1, 1), b3 + hstepB, voffB); PG8_STAGE(PG8_SA(1, 0), a3, voffA);
            PG8_WAIT_V(8); PG8_WAIT_L(0); PG8_BAR; PG8_MMA(1, 0, At, B0); PG8_MMA(1, 1, At, B1); PG8_BAR; PG8_SCHED;
            } else {
            PG8_LDB(B0, 0, 0); PG8_SCHED; PG8_LDA(At, 0, 0); PG8_STAGE(PG8_SA(1, 1), a1 + hstepA, voffA);
            PG8_WAIT_L(8); PG8_BAR; PG8_WAIT_L(0); PG8_MMA(0, 0, At, B0); PG8_BAR; PG8_SCHED;
            PG8_LDB(B1, 0, 1); PG8_STAGE(PG8_SB(0, 0), b2, voffB);
            PG8_BAR; PG8_WAIT_L(0); PG8_MMA(0, 1, At, B1); PG8_BAR;
            PG8_LDA(At, 0, 1); PG8_STAGE(PG8_SA(0, 0), a2, voffA);
            PG8_BAR; PG8_WAIT_L(0); PG8_MMA(1, 0, At, B0); PG8_BAR; PG8_SCHED;
            PG8_STAGE(PG8_SB(0, 1), b2 + hstepB, voffB);
            PG8_WAIT_V(6); PG8_BAR; PG8_MMA(1, 1, At, B1); PG8_BAR;
            PG8_LDB(B0, 1, 0); PG8_SCHED; PG8_LDA(At, 1, 0); PG8_STAGE(PG8_SA(0, 1), a2 + hstepA, voffA);
            PG8_WAIT_L(8); PG8_BAR; PG8_WAIT_L(0); PG8_MMA(0, 0, At, B0); PG8_BAR; PG8_SCHED;
            PG8_LDB(B1, 1, 1); PG8_STAGE(PG8_SB(1, 0), b3, voffB);
            PG8_BAR; PG8_WAIT_L(0); PG8_MMA(0, 1, At, B1); PG8_BAR;
            PG8_LDA(At, 1, 1); PG8_STAGE(PG8_SA(1, 0), a3, voffA);
            PG8_BAR; PG8_WAIT_L(0); PG8_MMA(1, 0, At, B0); PG8_BAR; PG8_SCHED;
            PG8_STAGE(PG8_SB(1, 1), b3 + hstepB, voffB);
            PG8_WAIT_V(6); PG8_BAR; PG8_MMA(1, 1, At, B1); PG8_BAR;
            }
        }
        if constexpr (ALIGN_EPI) { if (wr == 0) PG8_BAR; }
        E(acc, cur, wr, wc, fr, fq);
        if (!has_next) break;
        if (cur.mode != 0) {
#pragma unroll
        for (int a = 0; a < 2; ++a)
#pragma unroll
            for (int b = 0; b < 2; ++b)
#pragma unroll
                for (int m = 0; m < 4; ++m)
#pragma unroll
                    for (int n = 0; n < 2; ++n) acc[a][b][m][n] = (f32x4){0.f, 0.f, 0.f, 0.f};
        }
        cur = nxt; cA = nA; cB = nB; ++ui;
        if constexpr (ALIGN_EPI) { if (wr == 1) PG8_BAR; }
    }
    PG8_WAIT_V(0);
    if constexpr (!ALIGN_EPI) { if (wr == 0) PG8_BAR; }
    PG8_BAR;
#undef PG8_SA
#undef PG8_SB
#undef PG8_STAGE
#undef PG8_LDA
#undef PG8_LDB
#undef PG8_MMA
#undef PG8_H
#undef PG8_WAIT_V
#undef PG8_WAIT_L
#undef PG8_BAR
#undef PG8_SCHED
}

struct EpiZ {
    static constexpr bool PERM = true;
    bf16_t* O; int ldc; int split, split2, off0, off1, off2; float sc; unsigned char* G; int gpn0;
    __device__ __forceinline__ void operator()(f32x4 (&acc)[2][2][4][2], const Unit& u, int wr, int wc, int fr, int fq) const {
        if (u.pn >= gpn0) {
            unsigned char* gp = G + ((size_t)u.pm * 32 + (u.pn - gpn0)) * GTILE + (size_t)(wr * 4 + wc) * 16384 + lane_id_opaque() * 16;
#pragma unroll
            for (int ai = 0; ai < 2; ++ai)
#pragma unroll
                for (int m = 0; m < 4; ++m)
#pragma unroll
                    for (int bj = 0; bj < 2; ++bj) { const f32x4 v0 = acc[ai][bj][m][0] * sc, v1 = acc[ai][bj][m][1] * sc;
                        u32x4 w; w.x = cvt_pk_bf16(v0[0], v0[1]); w.y = cvt_pk_bf16(v0[2], v0[3]); w.z = cvt_pk_bf16(v1[0], v1[1]); w.w = cvt_pk_bf16(v1[2], v1[3]);
                        __builtin_nontemporal_store(w, (u32x4*)(gp + ((ai * 4 + m) * 2 + bj) * 1024)); }
            return; }
        const int row0 = u.pm * BM + wr * 64 + fr, col0 = (u.pn < split ? off0 + u.pn * BM : (u.pn < split2 ? off1 + (u.pn - split) * BM : off2 + (u.pn - split2) * BM)) + wc * 32 + 8 * fq;
#pragma unroll
        for (int ai = 0; ai < 2; ++ai)
#pragma unroll
            for (int m = 0; m < 4; ++m) { bf16_t* rowp = O + (size_t)(row0 + ai * HALF + m * 16) * ldc + col0;
#pragma unroll
                for (int bj = 0; bj < 2; ++bj) { const f32x4 v0 = acc[ai][bj][m][0] * sc, v1 = acc[ai][bj][m][1] * sc;
                    u32x4 w; w.x = cvt_pk_bf16(v0[0], v0[1]); w.y = cvt_pk_bf16(v0[2], v0[3]); w.z = cvt_pk_bf16(v1[0], v1[1]); w.w = cvt_pk_bf16(v1[2], v1[3]);
                    __builtin_nontemporal_store(w, (u32x4*)(rowp + bj * HALF)); } }
    }
};
struct EpiLora {
    static constexpr bool PERM = true;
    bf16_t* DW; bf16_t* AA; const float* w0; const float* a0;
    __device__ __forceinline__ void operator()(f32x4 (&acc)[2][2][4][2], const Unit& u, int wr, int wc, int fr, int fq) const {
        const int row0 = u.pm * BM + wr * 64 + fr; const bool isw = u.pn < 8; const int colt = (isw ? u.pn : u.pn - 8) * BM + wc * 32 + 8 * fq;
        bf16_t* outp = isw ? DW : AA; const float* bias = isw ? w0 : a0; const float sc = isw ? -0.6065306597126334f : 1.0f;
        f32x4 bv[2][2];
#pragma unroll
        for (int bj = 0; bj < 2; ++bj)
#pragma unroll
            for (int n = 0; n < 2; ++n) bv[bj][n] = *(const f32x4*)(bias + colt + bj * HALF + 4 * n);
#pragma unroll
        for (int ai = 0; ai < 2; ++ai)
#pragma unroll
            for (int m = 0; m < 4; ++m) { bf16_t* rowp = outp + (size_t)(row0 + ai * HALF + m * 16) * RW + colt;
#pragma unroll
                for (int bj = 0; bj < 2; ++bj) { float o[8];
#pragma unroll
                    for (int n = 0; n < 2; ++n) { const f32x4 x = acc[ai][bj][m][n] + bv[bj][n];
#pragma unroll
                        for (int j = 0; j < 4; ++j) o[4 * n + j] = sc * frcp(1.0f + __expf(-x[j])); }
                    u32x4 w; w.x = cvt_pk_bf16(o[0], o[1]); w.y = cvt_pk_bf16(o[2], o[3]); w.z = cvt_pk_bf16(o[4], o[5]); w.w = cvt_pk_bf16(o[6], o[7]);
                    *(u32x4*)(rowp + bj * HALF) = w; } }
    }
};
struct EpiMix {
    static constexpr bool PERM = true;
    const unsigned char* Z; unsigned char* O;
    __device__ __forceinline__ void operator()(f32x4 (&acc)[2][2][4][2], const Unit& u, int wr, int wc, int fr_, int fq_) const {
        const int l_ = lane_id_opaque(), fr = l_ & 15, fq = l_ >> 4;
        const int row0 = u.pm * BM + wr * 64 + fr, col0 = u.pn * BM + wc * 32 + 8 * fq;
        const unsigned char* Z = this->Z; unsigned char* O = this->O; asm volatile("" : "+s"(Z), "+s"(O));
        const unsigned char* gR = Z + ((size_t)u.pm * 32 + u.pn) * GTILE + (size_t)(wr * 4 + wc) * 16384 + l_ * 16; const unsigned char* gA = gR + 16 * GTILE;
        const bool m0_ = (u.mode == 0);
        bf16x8 gaA[2], grA[2], gaB[2], grB[2];
#define EM_LOAD(GA, GR, it_) do { GA[0] = *(const bf16x8*)(gA + ((it_) * 2) * 1024); GA[1] = *(const bf16x8*)(gA + ((it_) * 2 + 1) * 1024); \
            if (m0_) { GR[0] = *(const bf16x8*)(gR + ((it_) * 2) * 1024); GR[1] = *(const bf16x8*)(gR + ((it_) * 2 + 1) * 1024); } } while (0)
#define EM_FIN(GA, GR, it_) do { const int ai_ = (it_) >> 2, m_ = (it_) & 3; const size_t r_ = (size_t)(row0 + ai_ * HALF + m_ * 16); \
            _Pragma("unroll") for (int bj = 0; bj < 2; ++bj) { \
                if (m0_) { \
                    _Pragma("unroll") for (int n = 0; n < 2; ++n) _Pragma("unroll") for (int j = 0; j < 4; ++j) { \
                        const float ea = __expf(-bfs2f(GA[bj][4 * n + j])), er = __expf(-bfs2f(GR[bj][4 * n + j])); acc[ai_][bj][m_][n][j] *= (1.0f + ea) * frcp(1.0f + er); } \
                } else { float v[8]; \
                    _Pragma("unroll") for (int n = 0; n < 2; ++n) _Pragma("unroll") for (int j = 0; j < 4; ++j) \
                        v[4 * n + j] = acc[ai_][bj][m_][n][j] * (1.0f / 64.0f) * frcp(1.0f + __expf(-bfs2f(GA[bj][4 * n + j]))); \
                    *(u32x2*)(O + r_ * D + col0 + bj * HALF) = (u32x2){pk4_fp8(v[0], v[1], v[2], v[3]), pk4_fp8(v[4], v[5], v[6], v[7])}; } } \
            asm volatile("" ::: "memory"); } while (0)
        EM_LOAD(gaA, grA, 0);
#pragma unroll
        for (int it = 0; it < 8; it += 2) { EM_LOAD(gaB, grB, it + 1); EM_FIN(gaA, grA, it); if (it + 2 < 8) EM_LOAD(gaA, grA, it + 2); EM_FIN(gaB, grB, it + 1); }
#undef EM_LOAD
#undef EM_FIN
    }
};
struct EpiH {
    static constexpr bool PERM = true;
    const float* xp; const float* xs; bf16_t* H;
    __device__ __forceinline__ void operator()(f32x4 (&acc)[2][2][4][2], const Unit& u, int wr, int wc, int fr, int fq, int quad = -1) const {
        const int row0 = u.pm * BM + wr * 64 + fr, col0 = u.pn * BM + wc * 32 + 8 * fq;
#pragma unroll
        for (int ai = 0; ai < 2; ++ai)
#pragma unroll
            for (int m = 0; m < 4; ++m) { if (quad >= 0 && (quad >> 1) != ai) continue;
                const int r = row0 + ai * HALF + m * 16; const float* xr = (r < M_P) ? xp + (size_t)r * D : xs + (size_t)(r - M_P) * D; bf16_t* hr = H + (size_t)r * D;
#pragma unroll
                for (int bj = 0; bj < 2; ++bj) { if (quad >= 0 && (quad & 1) != bj) continue;
                    const int c = col0 + bj * HALF; const f32x4 x0 = __builtin_nontemporal_load((const f32x4*)(xr + c)), x1 = __builtin_nontemporal_load((const f32x4*)(xr + c + 4));
                    const f32x4 v0 = x0 * ALPHA + acc[ai][bj][m][0] * (1.0f / 64.0f), v1 = x1 * ALPHA + acc[ai][bj][m][1] * (1.0f / 64.0f);
                    u32x4 w; w.x = cvt_pk_bf16(v0[0], v0[1]); w.y = cvt_pk_bf16(v0[2], v0[3]); w.z = cvt_pk_bf16(v1[0], v1[1]); w.w = cvt_pk_bf16(v1[2], v1[3]);
                    *(u32x4*)(hr + c) = w; }
                asm volatile("" ::: "memory"); }
    }
};
struct EpiMixTail {
    static constexpr bool PERM = true;
    const unsigned char* Z; unsigned char* O; TailCtx T;
    __device__ __forceinline__ void operator()(f32x4 (&acc)[2][2][4][2], const Unit& u, int wr, int wc, int fr_, int fq_) const {
        const int l_ = lane_id_opaque(), fr = l_ & 15, fq = l_ >> 4;
        const int row0 = u.pm * BM + wr * 64 + fr, col0 = u.pn * BM + wc * 32 + 8 * fq;
        {
            const unsigned char* Zg = this->Z; asm volatile("" : "+s"(Zg));
            const unsigned char* gQ = Zg + ((size_t)u.pm * 32 + ((u.mode < 6) ? 0 : 16) + u.pn) * GTILE + (size_t)(wr * 4 + wc) * 16384 + l_ * 16;
#pragma unroll
            for (int ai = 0; ai < 2; ++ai)
#pragma unroll
                for (int m = 0; m < 4; ++m) {
#pragma unroll
                    for (int bj = 0; bj < 2; ++bj) { const bf16x8 gg = *(const bf16x8*)(gQ + ((ai * 4 + m) * 2 + bj) * 1024);
#pragma unroll
                        for (int n = 0; n < 2; ++n)
#pragma unroll
                            for (int j = 0; j < 4; ++j) acc[ai][bj][m][n][j] *= frcp(1.0f + __expf(-bfs2f(gg[4 * n + j]))); } }
            tail_exchange(acc, u, T, wr * 4 + wc, fq * 16 + fr);
            const int q = u.mode - 4;
#pragma unroll
            for (int ai = 0; ai < 2; ++ai)
#pragma unroll
              for (int bj = 0; bj < 2; ++bj) if (ai * 2 + bj == q) {
#pragma unroll
                for (int m = 0; m < 4; ++m) { const size_t r = (size_t)(row0 + ai * HALF + m * 16);
                    const f32x4 v0 = acc[ai][bj][m][0] * (1.0f / 64.0f), v1 = acc[ai][bj][m][1] * (1.0f / 64.0f);
                    *(u32x2*)(O + r * D + col0 + bj * HALF) = (u32x2){pk4_fp8(v0[0], v0[1], v0[2], v0[3]), pk4_fp8(v1[0], v1[1], v1[2], v1[3])}; } }
            return;
        }
    }
};
struct EpiHTail {
    static constexpr bool PERM = false;
    const float* xp; const float* xs; bf16_t* H; TailCtx T;
    __device__ __forceinline__ void operator()(f32x4 (&acc)[2][2][4][2], const Unit& u, int wr, int wc, int fr_, int fq_) const {
        tail_exchange(acc, u, T, wr * 4 + wc, lane_id_opaque());
        const int l_ = lane_id_opaque();
        EpiH E{xp, xs, H}; E(acc, u, wr, wc, l_ & 15, l_ >> 4, u.mode - 4);
    }
};
}

struct Args { const float* in[23]; float* out; unsigned char* ws; int ph_lo, ph_hi; };

__device__ __forceinline__ void p0_transpose_item_f8(const float* W, int N, int nbs, unsigned char* W8, LAS float* scr, int kb, int nb, int lane, int koff = 0) {
    const int k0 = 64 * kb, n0 = 32 * nb;
    f32x4 wv[8];
#pragma unroll
    for (int i = 0; i < 8; ++i) wv[i] = __builtin_nontemporal_load((const f32x4*)(W + (size_t)(k0 + 8 * i + (lane >> 3)) * N + 32 * nbs + (lane & 7) * 4));
#pragma unroll
    for (int i = 0; i < 8; ++i) { LAS float* d = scr + (8 * i + (lane >> 3)) * 33 + (i >> 2) * 16 + (lane & 7) * 4; d[0] = wv[i][0]; d[1] = wv[i][1]; d[2] = wv[i][2]; d[3] = wv[i][3]; }
    LDS_WAIT();
    const int c2 = lane & 1, n = lane >> 1; const LAS float* sp = scr + (16 * c2) * 33 + n;
    const int ng = n0 + n, nl = ng & 127, x = nl & 31, slot = (nl & ~31) + 16 * ((x >> 2) & 1) + 4 * (x >> 3) + (x & 3); const int kd = koff + k0;
    unsigned char* dst = W8 + ((size_t)(ng >> 7) * 32 + (kd >> 7)) * pg8::HTB;
#pragma unroll
    for (int j = 0; j < 2; ++j) { const LAS float* s2 = sp + (32 * j) * 33 + 16 * j;
        u32x4 o; o.x = pk4_fp8(s2[0 * 33] * 64.f, s2[1 * 33] * 64.f, s2[2 * 33] * 64.f, s2[3 * 33] * 64.f); o.y = pk4_fp8(s2[4 * 33] * 64.f, s2[5 * 33] * 64.f, s2[6 * 33] * 64.f, s2[7 * 33] * 64.f);
        o.z = pk4_fp8(s2[8 * 33] * 64.f, s2[9 * 33] * 64.f, s2[10 * 33] * 64.f, s2[11 * 33] * 64.f); o.w = pk4_fp8(s2[12 * 33] * 64.f, s2[13 * 33] * 64.f, s2[14 * 33] * 64.f, s2[15 * 33] * 64.f);
        const int kbyte = (kd & 127) + 32 * j + 16 * c2;
        *(u32x4*)(dst + pg8::lds_byte(slot, kbyte >> 1)) = o; }
    LDS_WAIT();
}
__device__ __forceinline__ void p0_transpose_item(const float* W, int N, bf16_t* WT, int ldt, int koff, int row_off, LAS float* scr, int kb, int nb, int lane, int ktiles = 0, bool perm = false, int nbs = -1) {
    const int k0 = 32 * kb, n0 = 64 * nb, n0s = 64 * (nbs < 0 ? nb : nbs);
    f32x4 wv[8];
#pragma unroll
    for (int i = 0; i < 8; ++i) wv[i] = __builtin_nontemporal_load((const f32x4*)(W + (size_t)(k0 + 4 * i + (lane >> 4)) * N + n0s + (lane & 15) * 4));
#pragma unroll
    for (int i = 0; i < 8; ++i) { LAS float* d = scr + (4 * i + (lane >> 4)) * 65 + (lane & 15) * 4; d[0] = wv[i][0]; d[1] = wv[i][1]; d[2] = wv[i][2]; d[3] = wv[i][3]; }
    LDS_WAIT();
    const int c = lane & 3;
#pragma unroll
    for (int j = 0; j < 4; ++j) { const int n = (lane >> 2) + 16 * j; const LAS float* sp = scr + (8 * c) * 65 + n;
        u32x4 o; o.x = pk2(sp[0 * 65], sp[1 * 65]); o.y = pk2(sp[2 * 65], sp[3 * 65]); o.z = pk2(sp[4 * 65], sp[5 * 65]); o.w = pk2(sp[6 * 65], sp[7 * 65]);
        const int kg = koff + k0 + 8 * c;
        if (ktiles == 0) *(u32x4*)(WT + (size_t)(row_off + n0 + n) * ldt + kg) = o;
        else { const int ng = row_off + n0 + n, nl = ng & 127, x = nl & 31; const int slot = perm ? ((nl & ~31) + 16 * ((x >> 2) & 1) + 4 * (x >> 3) + (x & 3)) : nl;
            *(u32x4*)((unsigned char*)WT + ((size_t)(ng >> 7) * ktiles + (kg >> 6)) * pg8::HTB + pg8::lds_byte(slot, kg & 63)) = o; } }
    LDS_WAIT();
}

__device__ __forceinline__ void p0_item_load(f32x4 (&wv)[8], const float* W, int N, int row, int col, int shape, int lane) {
    const int rs = shape ? 8 : 4, lr = shape ? (lane >> 3) : (lane >> 4), lc = shape ? (lane & 7) : (lane & 15);
#pragma unroll
    for (int i = 0; i < 8; ++i) wv[i] = __builtin_nontemporal_load((const f32x4*)(W + (size_t)(row + rs * i + lr) * N + col + lc * 4));
}
__device__ __forceinline__ void p0_item_fin_bf16(const f32x4 (&wv)[8], bf16_t* WT, int koff, int row_off, LAS float* scr, int kb, int nb, int lane, int ktiles) {
    const int k0 = 32 * kb, n0 = 64 * nb;
#pragma unroll
    for (int i = 0; i < 8; ++i) { LAS float* d = scr + (4 * i + (lane >> 4)) * 65 + (lane & 15) * 4; d[0] = wv[i][0]; d[1] = wv[i][1]; d[2] = wv[i][2]; d[3] = wv[i][3]; }
    LDS_WAIT();
    const int c = lane & 3;
#pragma unroll
    for (int j = 0; j < 4; ++j) { const int n = (lane >> 2) + 16 * j; const LAS float* sp = scr + (8 * c) * 65 + n;
        u32x4 o; o.x = pk2(sp[0 * 65], sp[1 * 65]); o.y = pk2(sp[2 * 65], sp[3 * 65]); o.z = pk2(sp[4 * 65], sp[5 * 65]); o.w = pk2(sp[6 * 65], sp[7 * 65]);
        const int kg = koff + k0 + 8 * c;
        const int ng = row_off + n0 + n, nl = ng & 127, x = nl & 31; const int slot = (nl & ~31) + 16 * ((x >> 2) & 1) + 4 * (x >> 3) + (x & 3);
        *(u32x4*)((unsigned char*)WT + ((size_t)(ng >> 7) * ktiles + (kg >> 6)) * pg8::HTB + pg8::lds_byte(slot, kg & 63)) = o; }
    LDS_WAIT();
}
__device__ __forceinline__ void p0_item_fin_f8(const f32x4 (&wv)[8], unsigned char* W8, LAS float* scr, int kb, int nb, int lane) {
    const int k0 = 64 * kb, n0 = 32 * nb;
#pragma unroll
    for (int i = 0; i < 8; ++i) { LAS float* d = scr + (8 * i + (lane >> 3)) * 33 + (i >> 2) * 16 + (lane & 7) * 4; d[0] = wv[i][0]; d[1] = wv[i][1]; d[2] = wv[i][2]; d[3] = wv[i][3]; }
    LDS_WAIT();
    const int c2 = lane & 1, n = lane >> 1; const LAS float* sp = scr + (16 * c2) * 33 + n;
    const int ng = n0 + n, nl = ng & 127, x = nl & 31, slot = (nl & ~31) + 16 * ((x >> 2) & 1) + 4 * (x >> 3) + (x & 3);
    unsigned char* dst = W8 + ((size_t)(ng >> 7) * 32 + (k0 >> 7)) * pg8::HTB;
#pragma unroll
    for (int j = 0; j < 2; ++j) { const LAS float* s2 = sp + (32 * j) * 33 + 16 * j;
        u32x4 o; o.x = pk4_fp8(s2[0 * 33] * 64.f, s2[1 * 33] * 64.f, s2[2 * 33] * 64.f, s2[3 * 33] * 64.f); o.y = pk4_fp8(s2[4 * 33] * 64.f, s2[5 * 33] * 64.f, s2[6 * 33] * 64.f, s2[7 * 33] * 64.f);
        o.z = pk4_fp8(s2[8 * 33] * 64.f, s2[9 * 33] * 64.f, s2[10 * 33] * 64.f, s2[11 * 33] * 64.f); o.w = pk4_fp8(s2[12 * 33] * 64.f, s2[13 * 33] * 64.f, s2[14 * 33] * 64.f, s2[15 * 33] * 64.f);
        const int kbyte = (k0 & 127) + 32 * j + 16 * c2;
        *(u32x4*)(dst + pg8::lds_byte(slot, kbyte >> 1)) = o; }
    LDS_WAIT();
}

__device__ __forceinline__ void phase_convert(const Args& a, LAS unsigned char* lds, const int tid) {
    const int lane = tid & 63, wave = tid >> 6, G = gridDim.x;
    unsigned char* ws = a.ws;
    bf16_t* XB = (bf16_t*)(ws + WS_XB); bf16_t* W1T = (bf16_t*)(ws + WS_W1T); bf16_t* WLT = (bf16_t*)(ws + WS_WLT);
    LAS float* scr = (LAS float*)(lds + wave * 8704);
    const int gw = blockIdx.x * 8 + wave, NGW = G * 8;
    constexpr int I1 = 128 * 332, I5 = 4 * 32, I6 = 4 * 32, NIT = I1 + I5 + I6;
    constexpr int I7 = 128 * 32;
    static_assert(I1 + I5 + I6 == NIT, "items"); constexpr int NIT2 = NIT + I7;
#define P0_LOAD(R, it_) do { int r_ = (it_); const float* W_; int N_, row_, col_, sh_; \
        if (r_ < I1) { const int kb_ = r_ / 332, nb_ = r_ % 332; W_ = a.in[6]; N_ = NZ; \
            if ((nb_ >= 32 && nb_ < 100) || (nb_ >= 164 && nb_ < 172)) { sh_ = 0; row_ = 32 * kb_; col_ = 64 * nb_; } else { sh_ = 1; row_ = 64 * (kb_ >> 1); col_ = 32 * (2 * nb_ + (kb_ & 1)); } } \
        else if (r_ < I1 + I5) { r_ -= I1; W_ = a.in[9]; N_ = RW; sh_ = 0; row_ = 32 * (r_ / 32); col_ = 64 * (r_ % 32); } \
        else if (r_ < NIT) { r_ -= I1 + I5; W_ = a.in[11]; N_ = RW; sh_ = 0; row_ = 32 * (r_ / 32); col_ = 64 * (r_ % 32); } \
        else { r_ -= NIT; W_ = a.in[6]; N_ = NZ; sh_ = 0; row_ = 32 * (r_ / 32); col_ = 64 * (r_ % 32); } \
        p0_item_load(R, W_, N_, row_, col_, sh_, lane); } while (0)
#define P0_FIN(R, it_) do { int r_ = (it_); \
        if (r_ < I1) { const int kb_ = r_ / 332, nb_ = r_ % 332; \
            if (nb_ < 32) p0_item_fin_f8(R, ws + WS_W8T, scr, kb_ >> 1, 2 * nb_ + (kb_ & 1), lane); \
            else if (nb_ < 100) p0_item_fin_bf16(R, W1T, 0, 0, scr, kb_, nb_ - 32, lane, 64); \
            else if (nb_ < 164) p0_item_fin_f8(R, ws + WS_W8T, scr, kb_ >> 1, 2 * (32 + nb_ - 100) + (kb_ & 1), lane); \
            else if (nb_ < 172) p0_item_fin_bf16(R, W1T, 0, 0, scr, kb_, 68 + nb_ - 164, lane, 64); \
            else p0_item_fin_f8(R, ws + WS_W8T, scr, kb_ >> 1, 2 * (96 + nb_ - 172) + (kb_ & 1), lane); } \
        else if (r_ < I1 + I5) { r_ -= I1; p0_item_fin_bf16(R, WLT, 0, 0, scr, r_ / 32, r_ % 32, lane, 4); } \
        else if (r_ < NIT) { r_ -= I1 + I5; p0_item_fin_bf16(R, WLT, 128, 2048, scr, r_ / 32, r_ % 32, lane, 4); } \
        else { r_ -= NIT; p0_item_fin_bf16(R, W1T, 0, 0, scr, r_ / 32, 76 + r_ % 32, lane, 64); } } while (0)
    { f32x4 RA[8], RB[8];
      const int ntrip = (NIT2 - gw + NGW - 1) / NGW;
      { const int i0 = gw, i1 = (gw + NGW < NIT2) ? gw + NGW : NIT2 - 1; P0_LOAD(RA, i0); P0_LOAD(RB, i1); }
      for (int k = 0; k < ntrip; k += 2) {
          const int iA = gw + k * NGW, iB = iA + NGW, nA = (iB + NGW < NIT2) ? iB + NGW : NIT2 - 1, nB = (iB + 2 * NGW < NIT2) ? iB + 2 * NGW : NIT2 - 1;
          P0_FIN(RA, iA); P0_LOAD(RA, nA);
          if (k + 1 < ntrip) P0_FIN(RB, iB);
          P0_LOAD(RB, nB);
      } }
#undef P0_LOAD
#undef P0_FIN
    const size_t gt = (size_t)blockIdx.x * NTHREADS + tid, NGT = (size_t)G * NTHREADS;
    for (size_t i = gt; i < (size_t)4096 * 16; i += NGT) { const int n = (int)(i >> 4), cc = (int)(i & 15); const int kc = (n < 2048 ? 128 : 0) + 8 * cc;
        const int nl = n & 127, x = nl & 31, slot = (nl & ~31) + 16 * ((x >> 2) & 1) + 4 * (x >> 3) + (x & 3);
        *(u32x4*)((unsigned char*)WLT + ((size_t)(n >> 7) * 4 + (kc >> 6)) * pg8::HTB + pg8::lds_byte(slot, kc & 63)) = (u32x4){0u, 0u, 0u, 0u}; }
    for (size_t i = gt; i < (size_t)(M_X - NB_P - NB_S) * (D / 8); i += NGT) { const int rx = M + NB_P + NB_S + (int)(i / (D / 8)), k = (int)(i % (D / 8)) * 8;
        *(u32x4*)((unsigned char*)XB + ((size_t)(rx >> 7) * (D / 64) + (k >> 6)) * pg8::HTB + pg8::lds_byte(rx & 127, k & 63)) = (u32x4){0u, 0u, 0u, 0u}; }
    const float* xp = a.in[0]; const float* xs = a.in[1]; unsigned char* XB8 = ws + WS_XB8;
    for (int it0 = gw; it0 < (M / 16) * (D / 64); it0 += 2 * NGW) {
        f32x4 v[2][4];
#pragma unroll
        for (int u = 0; u < 2; ++u) { const int it = it0 + u * NGW; if (it < (M / 16) * (D / 64)) {
            const int rt = it / (D / 64), ct = it % (D / 64); const int row0 = rt * 16 + (lane >> 4), k = ct * 64 + (lane & 15) * 4;
            const float* src = (row0 < M_P) ? xp + (size_t)row0 * D + k : xs + (size_t)(row0 - M_P) * D + k;
#pragma unroll
            for (int i = 0; i < 4; ++i) v[u][i] = __builtin_nontemporal_load((const f32x4*)(src + (size_t)(4 * i) * D)); } }
#pragma unroll
        for (int u = 0; u < 2; ++u) { const int it = it0 + u * NGW; if (it < (M / 16) * (D / 64)) {
            const int rt = it / (D / 64), ct = it % (D / 64); const int k = ct * 64 + (lane & 15) * 4;
#pragma unroll
            for (int i = 0; i < 4; ++i) { const int row = rt * 16 + 4 * i + (lane >> 4);
                const u32x2 ob = (u32x2){pk2(v[u][i][0], v[u][i][1]), pk2(v[u][i][2], v[u][i][3])}; const unsigned o8 = pk4_fp8(v[u][i][0], v[u][i][1], v[u][i][2], v[u][i][3]);
                *(u32x2*)((unsigned char*)XB + ((size_t)(row >> 7) * (D / 64) + (k >> 6)) * pg8::HTB + pg8::lds_byte(row & 127, k & 63)) = ob;
                { const bool lastp = (row < M_P) && ((row & (TP - 1)) == TP - 1), lasts = (row >= M_P) && (((row - M_P) & (TS - 1)) == TS - 1);
                  if (lastp || lasts) { const int rx = M + (lastp ? (row >> 11) : NB_P + ((row - M_P) >> 3));
                      *(u32x2*)((unsigned char*)XB + ((size_t)(rx >> 7) * (D / 64) + (k >> 6)) * pg8::HTB + pg8::lds_byte(rx & 127, k & 63)) = ob; } }
                *(unsigned*)(XB8 + ((size_t)(row >> 7) * (D / 128) + (k >> 7)) * pg8::HTB + pg8::lds_byte(row & 127, (k & 127) >> 1)) = o8; } } }
    }
    f32x2* rope = (f32x2*)(ws + WS_ROPE);
    for (size_t i = gt; i < (size_t)2056 * 8; i += NGT) { const int p = (int)(i >> 3), ii = (int)(i & 7); const double pos = (p < 2048) ? (double)p : (double)(8192 + p - 2048);
        const double inv = pow(500000.0, -(double)ii / 8.0), ang = pos * inv; rope[i] = (f32x2){(float)cos(ang), (float)sin(ang)}; }
}

__device__ __forceinline__ void convert_rest(const Args& a, LAS unsigned char* lds, const int tid, int hi, int nh) {
    const int lane = tid & 63, wave = tid >> 6;
    unsigned char* W2T = a.ws + WS_W2T; unsigned char* W3T = a.ws + WS_W3T;
    LAS float* scr = (LAS float*)(lds + wave * 8704);
    constexpr int I2 = 64 * 64, I3 = 64 * 64, I4 = 128 * 64, NITR = I2 + I3 + I4;
#define CR_LOAD(R, it_) do { int r_ = (it_); const int sg_ = __builtin_amdgcn_readfirstlane((r_ >= I2) + (r_ >= I2 + I3)); const float* W_ = (sg_ == 0) ? a.in[18] : ((sg_ == 1) ? a.in[19] : a.in[20]); r_ -= (sg_ == 0) ? 0 : ((sg_ == 1) ? I2 : I2 + I3); \
        const int kb_ = r_ / 64, nb_ = r_ % 64; p0_item_load(R, W_, D, 64 * (kb_ >> 1), 32 * (2 * nb_ + (kb_ & 1)), 1, lane); } while (0)
#define CR_FIN(R, it_) do { int r_ = (it_); const int sg_ = __builtin_amdgcn_readfirstlane((r_ >= I2) + (r_ >= I2 + I3)); unsigned char* W8_ = (sg_ == 2) ? W3T : W2T; const int kadd_ = (sg_ == 1) ? 32 : 0; r_ -= (sg_ == 0) ? 0 : ((sg_ == 1) ? I2 : I2 + I3); \
        const int kb_ = r_ / 64, nb_ = r_ % 64; p0_item_fin_f8(R, W8_, scr, (kb_ >> 1) + kadd_, 2 * nb_ + (kb_ & 1), lane); } while (0)
    const int first = hi * 8 + wave, stride = nh * 8;
    if (first >= NITR) return;
    f32x4 RA[8], RB[8];
    const int ntrip = (NITR - first + stride - 1) / stride;
    { const int i1 = (first + stride < NITR) ? first + stride : NITR - 1; CR_LOAD(RA, first); CR_LOAD(RB, i1); }
    for (int k = 0; k < ntrip; k += 2) {
        const int iA = first + k * stride, iB = iA + stride, nA = (iB + stride < NITR) ? iB + stride : NITR - 1, nB = (iB + 2 * stride < NITR) ? iB + 2 * stride : NITR - 1;
        CR_FIN(RA, iA); CR_LOAD(RA, nA);
        if (k + 1 < ntrip) CR_FIN(RB, iB);
        CR_LOAD(RB, nB);
    }
#undef CR_LOAD
#undef CR_FIN
}
__device__ __forceinline__ void lora_a_panel(const Args& a, int pm, const int tid, int first_it = -1, int stride = NTHREADS, int n_it = 256 * 32) {
    const bf16_t* Z = (const bf16_t*)(a.ws + WS_Z); bf16_t* AL = (bf16_t*)(a.ws + WS_AL); const float* mu = a.in[7] + OFF_WD; const float* sh = a.in[3];
#pragma unroll 4
    for (int it = (first_it >= 0 ? first_it : tid); it < n_it; it += stride) {
        const int r = (first_it >= 0 ? 0 : pm * 256) + (it >> 5), c = (it & 31) * 8;
        const bf16x8 cur = *(const bf16x8*)(Z + (size_t)r * LDZ + OFF_WD + c);
        const bf16x8 p = *(const bf16x8*)(Z + (size_t)(r > 0 ? r - 1 : 0) * LDZ + OFF_WD + c);
        float pv[8]; bool first;
        if (r < M_P) first = (r & (TP - 1)) == 0; else first = ((r - M_P) & (TS - 1)) == 0;
#pragma unroll
        for (int j = 0; j < 8; ++j) pv[j] = bfs2f(p[j]);
        if (first) {
            if (r >= M_P) { const float* s = sh + (size_t)((r - M_P) >> 3) * SHIFT_W + OFF_WD + c;
#pragma unroll
                for (int j = 0; j < 8; ++j) pv[j] = s[j]; }
            else {
#pragma unroll
                for (int j = 0; j < 8; ++j) pv[j] = 0.f; } }
        float o[8];
        const f32x4 mu0 = *(const f32x4*)(mu + c), mu1 = *(const f32x4*)(mu + c + 4);
#pragma unroll
        for (int j = 0; j < 8; ++j) { const float z = bfs2f(cur[j]); const float x = z + (j < 4 ? mu0[j & 3] : mu1[j & 3]) * (pv[j] - z); o[j] = (c < 128) ? (1.0f - 2.0f * frcp(1.0f + __expf(2.0f * x))) : x; }
        u32x4 w; w.x = pk2(o[0], o[1]); w.y = pk2(o[2], o[3]); w.z = pk2(o[4], o[5]); w.w = pk2(o[6], o[7]);
        *(u32x4*)((unsigned char*)AL + ((size_t)(r >> 7) * 4 + (c >> 6)) * pg8::HTB + pg8::lds_byte(r & 127, c & 63)) = w;
    }
}

__device__ __forceinline__ void lora_sample(const Args& a, const int tid) {
    const int lane = tid & 63, wave = tid >> 6, m = lane & 15, kg = lane >> 4;
    const bf16_t* Z = (const bf16_t*)(a.ws + WS_Z); const unsigned char* WLT = a.ws + WS_WLT; const float* mu = a.in[7] + OFF_WD; const float* sh = a.in[3];
    for (int t = (int)blockIdx.x * 8 + wave; t < (M_S / 16) * 32; t += (int)gridDim.x * 8) {
        const int rb = t >> 5, cb = t & 31; const bool isw = cb < 16; const int kofs = isw ? 0 : 128, cbase = (isw ? cb : cb - 16) * 128;
        const int row = M_P + rb * 16 + m; const bool first = (m & (TS - 1)) == 0;
        bf16x8 af[4];
#pragma unroll
        for (int ks = 0; ks < 4; ++ks) { const int k = kofs + 32 * ks + 8 * kg;
            const bf16x8 cur = *(const bf16x8*)(Z + (size_t)row * LDZ + OFF_WD + k);
            const bf16x8 pb = *(const bf16x8*)(Z + (size_t)(row - 1) * LDZ + OFF_WD + k);
            const float* s = sh + (size_t)((row - M_P) >> 3) * SHIFT_W + OFF_WD + k; const f32x4 s0 = *(const f32x4*)s, s1 = *(const f32x4*)(s + 4);
            const f32x4 mu0 = *(const f32x4*)(mu + k), mu1 = *(const f32x4*)(mu + k + 4);
            float o[8];
#pragma unroll
            for (int j = 0; j < 8; ++j) { const float z = bfs2f(cur[j]); const float pv = first ? (j < 4 ? s0[j & 3] : s1[j & 3]) : bfs2f(pb[j]);
                const float x = z + (j < 4 ? mu0[j & 3] : mu1[j & 3]) * (pv - z); o[j] = isw ? (1.0f - 2.0f * frcp(1.0f + __expf(2.0f * x))) : x; }
            const u32x4 w = (u32x4){pk2(o[0], o[1]), pk2(o[2], o[3]), pk2(o[4], o[5]), pk2(o[6], o[7])}; af[ks] = __builtin_bit_cast(bf16x8, w); }
        bf16_t* outp = (isw ? (bf16_t*)(a.ws + WS_DW) : (bf16_t*)(a.ws + WS_AA)) + (size_t)row * RW + cbase + 4 * kg;
        const float* bias = (isw ? a.in[8] : a.in[10]) + cbase + 4 * kg; const float sc = isw ? -0.6065306597126334f : 1.0f;
#pragma unroll
        for (int nb = 0; nb < 8; ++nb) {
            const int ng = (isw ? 0 : 2048) + cbase + 16 * nb + m, nl = ng & 127, x = nl & 31, slot = (nl & ~31) + 16 * ((x >> 2) & 1) + 4 * (x >> 3) + (x & 3);
            f32x4 acc = (f32x4){0.f, 0.f, 0.f, 0.f};
#pragma unroll
            for (int ks = 0; ks < 4; ++ks) { const int k = kofs + 32 * ks + 8 * kg;
                const bf16x8 bf = *(const bf16x8*)(WLT + ((size_t)(ng >> 7) * 4 + (k >> 6)) * pg8::HTB + pg8::lds_byte(slot, k & 63));
                acc = __builtin_amdgcn_mfma_f32_16x16x32_bf16(bf, af[ks], acc, 0, 0, 0); }
            const f32x4 bv = *(const f32x4*)(bias + 16 * nb);
            float v[4];
#pragma unroll
            for (int j = 0; j < 4; ++j) v[j] = sc * frcp(1.0f + __expf(-(acc[j] + bv[j])));
            *(u32x2*)(outp + 16 * nb) = (u32x2){pk2(v[0], v[1]), pk2(v[2], v[3])}; }
    }
}

namespace att {
constexpr int KT_STRIDE = 144, KT_ROWS = 272, VT_STRIDE = 552;
constexpr int KT_OFF = 0, VT_OFF = KT_ROWS * KT_STRIDE, SC_OFF = VT_OFF + 64 * VT_STRIDE, SC_STRIDE = 68, SC_WAVE = 16 * SC_STRIDE * 4;
static_assert(SC_OFF + 8 * SC_WAVE <= 131072 && VT_OFF % 16 == 0 && SC_OFF % 16 == 0, "attention LDS map");

__device__ __forceinline__ bf16x8 rope8(bf16x8 own, bf16x8 oth, const f32x2* tab, int c) {
    bf16x8 o;
#pragma unroll
    for (int j = 0; j < 8; ++j) { const f32x2 cs = tab[j]; const float x = bfs2f(own[j]), y = bfs2f(oth[j]); const float r = (c == 0) ? x * cs.x - y * cs.y : x * cs.x + y * cs.y; o[j] = (short)f2bf(r); }
    return o;
}

struct QFrag { bf16x8 q0, q1, oth, g0, g1; };
template <class RowFn>
__device__ __forceinline__ void attn_load(QFrag& F, int lane, const RowFn& rf, const bf16_t* Z) {
    const int qi = lane & 15, g = lane >> 4;
    int row, head, qpos2, ridx; rf(qi, row, head, qpos2, ridx);
    const bf16_t* qp = Z + (size_t)row * LDZ + OFF_Q + head * 64;
    F.q0 = *(const bf16x8*)(qp + 8 * g); F.q1 = *(const bf16x8*)(qp + 32 + 8 * g); F.oth = *(const bf16x8*)(qp + 8 * (g ^ 1));
    int row2, head2, d0, d1; rf(lane >> 2, row2, head2, d0, d1);
    const bf16_t* gp = Z + (size_t)row2 * LDZ + OFF_GA + head2 * 64 + (lane & 3) * 16;
    F.g0 = *(const bf16x8*)gp; F.g1 = *(const bf16x8*)(gp + 8);
}
template <class RowFn>
__device__ __forceinline__ void attn_group(const QFrag& F, LAS unsigned char* lds, int wave, int lane, const RowFn& rf, int T0, bool prev_valid, const float* sinks, bf16_t* Y, const f32x2* rope) {
    const int qi = lane & 15, g = lane >> 4;
    int row, head, qpos2, ridx; rf(qi, row, head, qpos2, ridx);
    bf16x8 q0 = F.q0; const bf16x8 q1 = F.q1;
    if (g < 2) q0 = rope8(q0, F.oth, rope + (size_t)ridx * 8, g);
    float s[9][4];
#pragma unroll
    for (int tl = 0; tl < 9; ++tl) {
        const LAS unsigned char* kp = lds + KT_OFF + ((T0 + tl) * 16 + qi) * KT_STRIDE + 16 * g;
        const bf16x8 k0 = *(const LAS bf16x8*)kp, k1 = *(const LAS bf16x8*)(kp + 64);
        f32x4 a = (f32x4){0.f, 0.f, 0.f, 0.f};
        a = __builtin_amdgcn_mfma_f32_16x16x32_bf16(k0, q0, a, 0, 0, 0);
        a = __builtin_amdgcn_mfma_f32_16x16x32_bf16(k1, q1, a, 0, 0, 0);
#pragma unroll
        for (int r = 0; r < 4; ++r) s[tl][r] = a[r];
    }
    const float sink = sinks[head];
    const int dq = (qpos2 & 15) - 4 * g;
    float mx = -1e30f;
#pragma unroll
    for (int tl = 0; tl < 9; ++tl) { const bool tile_ok = prev_valid || (T0 + tl >= 8);
#pragma unroll
        for (int r = 0; r < 4; ++r) { const bool ok = tile_ok && (tl == 0 ? (dq - r < 0) : (tl == 8 ? (dq - r >= 0) : true));
            s[tl][r] = ok ? s[tl][r] : -1e30f; mx = fmaxf(mx, s[tl][r]); } }
    mx = fmaxf(mx, __shfl_xor(mx, 16)); mx = fmaxf(mx, __shfl_xor(mx, 32));
    constexpr float SC = 0.125f * 1.4426950408889634f;
    const float m2 = fmaxf(mx * SC, sink * 1.4426950408889634f);
    float sum = 0.f;
#pragma unroll
    for (int tl = 0; tl < 9; ++tl)
#pragma unroll
        for (int r = 0; r < 4; ++r) { s[tl][r] = __builtin_amdgcn_exp2f(fmaf(s[tl][r], SC, -m2)); sum += s[tl][r]; }
    sum += __shfl_xor(sum, 16); sum += __shfl_xor(sum, 32);
    const float inv = frcp(sum + __builtin_amdgcn_exp2f(sink * 1.4426950408889634f - m2));
    bf16x8 pa[5];
#pragma unroll
    for (int pr = 0; pr < 4; ++pr)
        { u32x4 w_; w_.x = pk2(s[2 * pr][0] * inv, s[2 * pr][1] * inv); w_.y = pk2(s[2 * pr][2] * inv, s[2 * pr][3] * inv); w_.z = pk2(s[2 * pr + 1][0] * inv, s[2 * pr + 1][1] * inv); w_.w = pk2(s[2 * pr + 1][2] * inv, s[2 * pr + 1][3] * inv); pa[pr] = __builtin_bit_cast(bf16x8, w_); }
    { u32x4 w_; w_.x = pk2(s[8][0] * inv, s[8][1] * inv); w_.y = pk2(s[8][2] * inv, s[8][3] * inv); w_.z = 0u; w_.w = 0u; pa[4] = __builtin_bit_cast(bf16x8, w_); }
    f32x4 o[4];
#pragma unroll
    for (int n = 0; n < 4; ++n) { o[n] = (f32x4){0.f, 0.f, 0.f, 0.f};
#pragma unroll
        for (int pr = 0; pr < 5; ++pr) {
            const LAS unsigned char* vp = lds + VT_OFF + (16 * n + qi) * VT_STRIDE + ((T0 + 2 * pr) * 16 + 4 * g) * 2;
            const s16x4 lo = *(const LAS s16x4*)vp, hi = *(const LAS s16x4*)(vp + 32);
            bf16x8 vf; vf[0] = lo[0]; vf[1] = lo[1]; vf[2] = lo[2]; vf[3] = lo[3]; vf[4] = hi[0]; vf[5] = hi[1]; vf[6] = hi[2]; vf[7] = hi[3];
            o[n] = __builtin_amdgcn_mfma_f32_16x16x32_bf16(pa[pr], vf, o[n], 0, 0, 0);
        } }
    LAS float* sc = (LAS float*)(lds + SC_OFF + wave * SC_WAVE);
#pragma unroll
    for (int n = 0; n < 4; ++n)
#pragma unroll
        for (int r = 0; r < 4; ++r) sc[(4 * g + r) * SC_STRIDE + 16 * n + qi] = o[n][r];
    LDS_WAIT();
    const int q = lane >> 2, ch = lane & 3;
    int row2, head2, d0, d1; rf(q, row2, head2, d0, d1);
    const LAS float* sr = sc + q * SC_STRIDE + ch * 16;
    const bf16x8 g0 = F.g0, g1 = F.g1;
    float v[16];
#pragma unroll
    for (int i = 0; i < 4; ++i) { const f32x4 x = *(const LAS f32x4*)(sr + 4 * i); v[4 * i] = x[0]; v[4 * i + 1] = x[1]; v[4 * i + 2] = x[2]; v[4 * i + 3] = x[3]; }
#pragma unroll
    for (int j = 0; j < 8; ++j) { const float ga = bfs2f(g0[j]), gb = bfs2f(g1[j]); v[j] *= ga * frcp(1.0f + __expf(-ga)); v[8 + j] *= gb * frcp(1.0f + __expf(-gb)); }
    *(u32x4*)((unsigned char*)Y + (size_t)row2 * D + 2048 + head2 * 64 + ch * 16) = (u32x4){pk4_fp8(v[0], v[1], v[2], v[3]), pk4_fp8(v[4], v[5], v[6], v[7]), pk4_fp8(v[8], v[9], v[10], v[11]), pk4_fp8(v[12], v[13], v[14], v[15])};
    LDS_WAIT();
}

struct PromptRows { int rowbase, hq, q0, posbase; __device__ __forceinline__ void operator()(int i, int& row, int& head, int& qpos2, int& ridx) const { row = rowbase + q0 + i; head = hq; qpos2 = 128 + q0 + i; ridx = posbase + q0 + i; } };
struct SampleRows { int rowbase, h0; __device__ __forceinline__ void operator()(int i, int& row, int& head, int& qpos2, int& ridx) const { const int t = i & 7; row = rowbase + t; head = h0 + (i >> 3); qpos2 = 128 + t; ridx = 2048 + t; } };

__device__ __forceinline__ void store8f(float* p, bf16x8 v) { f32x4 a, b;
#pragma unroll
    for (int j = 0; j < 4; ++j) { a[j] = bfs2f(v[j]); b[j] = bfs2f(v[4 + j]); } *(f32x4*)p = a; *(f32x4*)(p + 4) = b; }

__device__ __forceinline__ void unit_prompt(const Args& a, LAS unsigned char* lds, int u, const int tid) {
    const int lane = tid & 63, wave = tid >> 6;
    const int kvh = u & 3, nb = (u >> 2) & 15, b = u >> 6;
    const bf16_t* Z = (const bf16_t*)(a.ws + WS_Z); bf16_t* Y = (bf16_t*)(a.ws + WS_Y); const f32x2* rope = (const f32x2*)(a.ws + WS_ROPE);
    float* wk = a.out + O_WKP; float* wv = a.out + O_WVP;
    bf16x8 kvr[5], othr[5], vvr[5];
#pragma unroll
    for (int u5 = 0; u5 < 5; ++u5) { const int it = tid + u5 * NTHREADS, key = it >> 3, c = it & 7;
        kvr[u5] = (bf16x8){0, 0, 0, 0, 0, 0, 0, 0}; othr[u5] = kvr[u5]; vvr[u5] = kvr[u5];
        if (it < KT_ROWS * 8 && key < 256 && (key >= 128 || nb > 0)) {
            const int tok = (nb - 1) * 128 + key; const size_t row = (size_t)b * TP + tok; const bf16_t* kp = Z + row * LDZ + OFF_K + kvh * 64;
            kvr[u5] = *(const bf16x8*)(kp + 8 * c); if (c < 2) othr[u5] = *(const bf16x8*)(kp + 8 * (c ^ 1)); vvr[u5] = *(const bf16x8*)(Z + row * LDZ + OFF_V + kvh * 64 + 8 * c); } }
    PromptRows rf; rf.rowbase = b * TP + nb * 128; rf.hq = kvh * 8 + wave; rf.posbase = nb * 128; rf.q0 = 0;
    QFrag FA, FB; attn_load(FA, lane, rf, Z);
#pragma unroll
    for (int u5 = 0; u5 < 5; ++u5) { const int it = tid + u5 * NTHREADS, key = it >> 3, c = it & 7;
        if (it < KT_ROWS * 8) {
            bf16x8 kv = kvr[u5]; const bf16x8 vv = vvr[u5];
            if (key < 256 && (key >= 128 || nb > 0)) {
                const int tok = (nb - 1) * 128 + key;
                if (c < 2) kv = rope8(kv, othr[u5], rope + (size_t)tok * 8, c);
                if (nb == 15 && key >= 128) { const size_t o = (((size_t)b * 128 + (key - 128)) * 4 + kvh) * 64 + 8 * c; store8f(wk + o, kv); store8f(wv + o, vv); } }
            *(LAS bf16x8*)(lds + KT_OFF + key * KT_STRIDE + 16 * c) = kv;
#pragma unroll
            for (int j = 0; j < 8; ++j) *(LAS short*)(lds + VT_OFF + (8 * c + j) * VT_STRIDE + key * 2) = vv[j]; } }
    __syncthreads();
    for (int grp = 0; grp < 8; grp += 2) {
        rf.q0 = 16 * (grp + 1); attn_load(FB, lane, rf, Z);
        rf.q0 = 16 * grp; attn_group(FA, lds, wave, lane, rf, grp, nb > 0, a.in[17], Y, rope);
        if (grp + 2 < 8) { rf.q0 = 16 * (grp + 2); attn_load(FA, lane, rf, Z); }
        rf.q0 = 16 * (grp + 1); attn_group(FB, lds, wave, lane, rf, grp + 1, nb > 0, a.in[17], Y, rope);
    }
    __syncthreads();
}

__device__ __forceinline__ void unit_sample(const Args& a, LAS unsigned char* lds, int u, const int tid) {
    const int lane = tid & 63, wave = tid >> 6;
    const int kvh = u & 3, b = u >> 2;
    const bf16_t* Z = (const bf16_t*)(a.ws + WS_Z); bf16_t* Y = (bf16_t*)(a.ws + WS_Y); const f32x2* rope = (const f32x2*)(a.ws + WS_ROPE);
    const float* ck = a.in[4]; const float* cv = a.in[5]; float* wk = a.out + O_WKS; float* wv = a.out + O_WVS;
    SampleRows rf; rf.rowbase = M_P + b * TS; rf.h0 = kvh * 8 + 2 * (wave & 3);
    QFrag FA; attn_load(FA, lane, rf, Z);
    f32x4 ck0[3], ck1[3], cv0[3], cv1[3]; bf16x8 nk[3], no[3], nv[3];
#pragma unroll
    for (int u3 = 0; u3 < 3; ++u3) { const int it = tid + u3 * NTHREADS, key = it >> 3, c = it & 7;
        ck0[u3] = (f32x4){0.f, 0.f, 0.f, 0.f}; ck1[u3] = ck0[u3]; cv0[u3] = ck0[u3]; cv1[u3] = ck0[u3]; nk[u3] = (bf16x8){0, 0, 0, 0, 0, 0, 0, 0}; no[u3] = nk[u3]; nv[u3] = nk[u3];
        if (it < 160 * 8) {
            if (key < 128) { const size_t so = (((size_t)b * 128 + key) * 4 + kvh) * 64 + 4 * c;
                ck0[u3] = __builtin_nontemporal_load((const f32x4*)(ck + so)); ck1[u3] = __builtin_nontemporal_load((const f32x4*)(ck + so + 32)); cv0[u3] = __builtin_nontemporal_load((const f32x4*)(cv + so)); cv1[u3] = __builtin_nontemporal_load((const f32x4*)(cv + so + 32)); }
            else if (key < 136) { const size_t row = (size_t)M_P + b * TS + (key - 128); const bf16_t* kp = Z + row * LDZ + OFF_K + kvh * 64;
                nk[u3] = *(const bf16x8*)(kp + 8 * c); if (c < 2) no[u3] = *(const bf16x8*)(kp + 8 * (c ^ 1)); nv[u3] = *(const bf16x8*)(Z + row * LDZ + OFF_V + kvh * 64 + 8 * c); } } }
#pragma unroll
    for (int u3 = 0; u3 < 3; ++u3) { const int it = tid + u3 * NTHREADS, key = it >> 3, c = it & 7;
        if (it < 160 * 8) {
            bf16x8 kv = nk[u3], vv = nv[u3];
            if (key < 128) {
                const f32x4 k0 = ck0[u3], k1 = ck1[u3], v0 = cv0[u3], v1 = cv1[u3];
                { u32x4 w_; w_.x = pk2(k0[0], k0[1]); w_.y = pk2(k0[2], k0[3]); w_.z = pk2(k1[0], k1[1]); w_.w = pk2(k1[2], k1[3]); kv = __builtin_bit_cast(bf16x8, w_);
                  w_.x = pk2(v0[0], v0[1]); w_.y = pk2(v0[2], v0[3]); w_.z = pk2(v1[0], v1[1]); w_.w = pk2(v1[2], v1[3]); vv = __builtin_bit_cast(bf16x8, w_); }
                if (key >= 8) { const size_t o = (((size_t)b * 128 + (key - 8)) * 4 + kvh) * 64 + 4 * c; __builtin_nontemporal_store(k0, (f32x4*)(wk + o)); __builtin_nontemporal_store(k1, (f32x4*)(wk + o + 32)); __builtin_nontemporal_store(v0, (f32x4*)(wv + o)); __builtin_nontemporal_store(v1, (f32x4*)(wv + o + 32)); }
            } else if (key < 136) {
                const int t = key - 128;
                if (c < 2) kv = rope8(kv, no[u3], rope + (size_t)(2048 + t) * 8, c);
                const size_t o = (((size_t)b * 128 + (120 + t)) * 4 + kvh) * 64 + 8 * c; store8f(wk + o, kv); store8f(wv + o, vv);
            }
            if (key < 128) {
                const u32x4 kw = __builtin_bit_cast(u32x4, kv);
                *(LAS u32x2*)(lds + KT_OFF + key * KT_STRIDE + 8 * c) = (u32x2){kw.x, kw.y}; *(LAS u32x2*)(lds + KT_OFF + key * KT_STRIDE + 64 + 8 * c) = (u32x2){kw.z, kw.w};
#pragma unroll
                for (int j = 0; j < 4; ++j) { *(LAS short*)(lds + VT_OFF + (4 * c + j) * VT_STRIDE + key * 2) = vv[j]; *(LAS short*)(lds + VT_OFF + (32 + 4 * c + j) * VT_STRIDE + key * 2) = vv[4 + j]; }
            } else {
                *(LAS bf16x8*)(lds + KT_OFF + key * KT_STRIDE + 16 * c) = kv;
#pragma unroll
                for (int j = 0; j < 8; ++j) *(LAS short*)(lds + VT_OFF + (8 * c + j) * VT_STRIDE + key * 2) = vv[j]; } } }
    __syncthreads();
    if (wave < 4) attn_group(FA, lds, wave, lane, rf, 0, true, a.in[17], Y, rope);
    __syncthreads();
}
}

namespace scan {
constexpr int CT = 32, IN_STRIDE = 1536, IN_BYTES = CT * IN_STRIDE, YB_OFF = 2 * IN_BYTES + 256  , RK_OFF = YB_OFF + CT * 64 * 4, JUNK_OFF = RK_OFF + CT * 4;
static_assert(JUNK_OFF % 16 == 0 && JUNK_OFF + 512 + (CT + 1) * 256 <= 131072, "scan LDS map");
struct Chunk { int row0, nsteps, h, first, last, kind, seq; };
struct Raw { u32x2 zr, zk, zv, pr, pk, pv, g, dw, aa; f32x4 fr, fk, fv, mur, muk, muv, kkc, kac, rkc, gw, gb; };
struct KV { f32x4 w, nk, bb, kh, rr; f32x2 vv; };

__device__ __forceinline__ float red16(float x) {
    x += __builtin_bit_cast(float, __builtin_amdgcn_update_dpp(0, __builtin_bit_cast(int, x), 0xB1, 0xF, 0xF, true));
    x += __builtin_bit_cast(float, __builtin_amdgcn_update_dpp(0, __builtin_bit_cast(int, x), 0x4E, 0xF, 0xF, true));
    x += __builtin_bit_cast(float, __builtin_amdgcn_update_dpp(0, __builtin_bit_cast(int, x), 0x141, 0xF, 0xF, true));
    x += __builtin_bit_cast(float, __builtin_amdgcn_update_dpp(0, __builtin_bit_cast(int, x), 0x140, 0xF, 0xF, true));
    return x;
}
__device__ __forceinline__ void red16x4(float& a, float& b, float& c, float& d) {
    asm volatile("s_nop 1\n\t"
        "v_add_f32_dpp %0, %0, %0 quad_perm:[1,0,3,2] row_mask:0xf bank_mask:0xf bound_ctrl:1\n\t"
        "v_add_f32_dpp %1, %1, %1 quad_perm:[1,0,3,2] row_mask:0xf bank_mask:0xf bound_ctrl:1\n\t"
        "v_add_f32_dpp %2, %2, %2 quad_perm:[1,0,3,2] row_mask:0xf bank_mask:0xf bound_ctrl:1\n\t"
        "v_add_f32_dpp %3, %3, %3 quad_perm:[1,0,3,2] row_mask:0xf bank_mask:0xf bound_ctrl:1\n\t"
        "v_add_f32_dpp %0, %0, %0 quad_perm:[2,3,0,1] row_mask:0xf bank_mask:0xf bound_ctrl:1\n\t"
        "v_add_f32_dpp %1, %1, %1 quad_perm:[2,3,0,1] row_mask:0xf bank_mask:0xf bound_ctrl:1\n\t"
        "v_add_f32_dpp %2, %2, %2 quad_perm:[2,3,0,1] row_mask:0xf bank_mask:0xf bound_ctrl:1\n\t"
        "v_add_f32_dpp %3, %3, %3 quad_perm:[2,3,0,1] row_mask:0xf bank_mask:0xf bound_ctrl:1\n\t"
        "v_add_f32_dpp %0, %0, %0 row_half_mirror row_mask:0xf bank_mask:0xf bound_ctrl:1\n\t"
        "v_add_f32_dpp %1, %1, %1 row_half_mirror row_mask:0xf bank_mask:0xf bound_ctrl:1\n\t"
        "v_add_f32_dpp %2, %2, %2 row_half_mirror row_mask:0xf bank_mask:0xf bound_ctrl:1\n\t"
        "v_add_f32_dpp %3, %3, %3 row_half_mirror row_mask:0xf bank_mask:0xf bound_ctrl:1\n\t"
        "v_add_f32_dpp %0, %0, %0 row_mirror row_mask:0xf bank_mask:0xf bound_ctrl:1\n\t"
        "v_add_f32_dpp %1, %1, %1 row_mirror row_mask:0xf bank_mask:0xf bound_ctrl:1\n\t"
        "v_add_f32_dpp %2, %2, %2 row_mirror row_mask:0xf bank_mask:0xf bound_ctrl:1\n\t"
        "v_add_f32_dpp %3, %3, %3 row_mirror row_mask:0xf bank_mask:0xf bound_ctrl:1\n\t"
        "s_nop 0"
        : "+v"(a), "+v"(b), "+v"(c), "+v"(d));
}
__device__ __forceinline__ float dot4(f32x4 a, f32x4 b) { return (a[0] * b[0] + a[1] * b[1]) + (a[2] * b[2] + a[3] * b[3]); }
__device__ __forceinline__ f32x4 unpack4(u32x2 v) { f32x4 r; r[0] = __builtin_bit_cast(float, v.x << 16); r[1] = __builtin_bit_cast(float, v.x & 0xffff0000u); r[2] = __builtin_bit_cast(float, v.y << 16); r[3] = __builtin_bit_cast(float, v.y & 0xffff0000u); return r; }

__device__ __forceinline__ bool get_chunk(int j, Chunk& C) {
    const int G = (int)gridDim.x, w = (int)blockIdx.x;
    if (G >= 256 && w < 128) return false;
    const int s = (G >= 256) ? (w - 128) + j * (G - 128) : w + j * G;
    if (s >= NB_S * NH) return false;
    C.kind = 1; C.seq = s >> 5; C.h = s & 31; C.row0 = M_P + C.seq * TS; C.nsteps = TS; C.first = 1; C.last = 1; return true;
}

__device__ __forceinline__ void phase_scan(const Args& a, LAS unsigned char* lds, const int tid) {
    const int lane = tid & 63, wave = tid >> 6;
    const bf16_t* Z = (const bf16_t*)(a.ws + WS_Z); const bf16_t* DW = (const bf16_t*)(a.ws + WS_DW); const bf16_t* AA = (const bf16_t*)(a.ws + WS_AA); bf16_t* Y = (bf16_t*)(a.ws + WS_Y);
    const float* mu = a.in[7]; const float* k_k = a.in[12]; const float* k_a = a.in[13]; const float* r_k = a.in[14]; const float* gn_w = a.in[15]; const float* gn_b = a.in[16];
    const int kq = lane & 15, rp = lane >> 4, srow = wave * 8 + rp * 2;
    const int pt = tid >> 4;
    LAS float* ybuf = (LAS float*)(lds + YB_OFF); LAS float* rkbuf = (LAS float*)(lds + RK_OFF);
    const unsigned ya = (kq == 0) ? (unsigned)(YB_OFF + srow * 4) : (unsigned)(JUNK_OFF + 256 + lane * 8);
    Chunk C, CN; Raw R;
    int j = 0;
    if (!get_chunk(0, C)) return;
    f32x4 S0 = (f32x4){0.f, 0.f, 0.f, 0.f}, S1 = S0, N0 = S0, N1 = S0;
    u32x2 gcur = (u32x2){0u, 0u}; f32x4 gwc = S0, gbc = S0;

#define SCAN_PREFETCH(CC) do { if (pt < (CC).nsteps) { const int col = (CC).h * 64 + 4 * kq; const size_t row = (size_t)((CC).row0 + pt); const size_t rprev = row > 0 ? row - 1 : 0; \
            const bf16_t* zp = Z + row * LDZ + col; const bf16_t* pp = Z + rprev * LDZ + col; \
            R.zr = *(const u32x2*)zp; R.zk = *(const u32x2*)(zp + 2048); R.zv = *(const u32x2*)(zp + 4096); R.g = *(const u32x2*)(zp + OFF_GR); \
            R.pr = *(const u32x2*)pp; R.pk = *(const u32x2*)(pp + 2048); R.pv = *(const u32x2*)(pp + 4096); \
            R.dw = *(const u32x2*)(DW + row * RW + col); R.aa = *(const u32x2*)(AA + row * RW + col); \
            R.mur = *(const f32x4*)(mu + col); R.muk = *(const f32x4*)(mu + 2048 + col); R.muv = *(const f32x4*)(mu + 4096 + col); \
            R.kkc = *(const f32x4*)(k_k + col); R.kac = *(const f32x4*)(k_a + col); R.rkc = *(const f32x4*)(r_k + col); R.gw = *(const f32x4*)(gn_w + col); R.gb = *(const f32x4*)(gn_b + col); \
            R.fr = (f32x4){0.f, 0.f, 0.f, 0.f}; R.fk = R.fr; R.fv = R.fr; \
            if ((CC).first && (CC).kind == 1 && pt == 0) { const float* sp = a.in[3] + (size_t)(CC).seq * SHIFT_W + col; R.fr = *(const f32x4*)sp; R.fk = *(const f32x4*)(sp + 2048); R.fv = *(const f32x4*)(sp + 4096); } } } while (0)
#define SCAN_LOADS0(CC, A0, A1) do { if ((CC).kind == 1) { const float* sp = a.in[2] + (((size_t)(CC).seq * NH + (CC).h) * 64 + srow) * 64 + 4 * kq; A0 = *(const f32x4*)sp; A1 = *(const f32x4*)(sp + 64); } \
        else { A0 = (f32x4){0.f, 0.f, 0.f, 0.f}; A1 = A0; } } while (0)
#define SCAN_PROCESS(CC, INB) do { if (pt < (CC).nsteps) { \
            const f32x4 zr = unpack4(R.zr), zk = unpack4(R.zk), zv = unpack4(R.zv); f32x4 pr = unpack4(R.pr), pkk = unpack4(R.pk), pv = unpack4(R.pv); \
            if ((CC).first && pt == 0) { pr = R.fr; pkk = R.fk; pv = R.fv; } \
            const f32x4 xr = zr + R.mur * (pr - zr), xk = zk + R.muk * (pkk - zk), xv = zv + R.muv * (pv - zv); const f32x4 av = unpack4(R.aa), ldv = unpack4(R.dw); \
            const f32x4 kkv = xk * R.kkc; const float ss = red16(dot4(kkv, kkv)); const f32x4 kkn = kkv * __builtin_amdgcn_rsqf(fmaxf(ss, 1e-24f)); \
            const f32x4 kh = xk * ((av - 1.0f) * R.kac + 1.0f); const float rk = red16(dot4(xr * kh, R.rkc)); \
            LAS unsigned char* ib = (INB) + pt * IN_STRIDE + kq * 16; \
            { f32x4 wd_; wd_[0] = __expf(ldv[0]); wd_[1] = __expf(ldv[1]); wd_[2] = __expf(ldv[2]); wd_[3] = __expf(ldv[3]); *(LAS f32x4*)ib = wd_; } *(LAS f32x4*)(ib + 256) = -kkn; *(LAS f32x4*)(ib + 512) = kkn * av; *(LAS f32x4*)(ib + 768) = kh; *(LAS f32x4*)(ib + 1024) = xr; *(LAS f32x4*)(ib + 1280) = xv; \
            if (kq == 0) rkbuf[pt] = rk; gcur = R.g; gwc = R.gw; gbc = R.gb; } } while (0)
#define SCAN_LOADK(K, tt) do { const LAS unsigned char* p_ = ibk + (tt) * IN_STRIDE; K.w = *(const LAS f32x4*)p_; K.nk = *(const LAS f32x4*)(p_ + 256); K.bb = *(const LAS f32x4*)(p_ + 512); \
            K.kh = *(const LAS f32x4*)(p_ + 768); K.rr = *(const LAS f32x4*)(p_ + 1024); K.vv = *(const LAS f32x2*)(vbk + (tt) * IN_STRIDE); } while (0)
#define SCAN_STEP(K, tt) do { float sa0 = dot4(S0, K.nk), sa1 = dot4(S1, K.nk); \
            const f32x4 T0 = S0 * K.w + K.kh * K.vv[0], T1 = S1 * K.w + K.kh * K.vv[1]; \
            red16x4(sa0, sa1, py0, py1); \
            *(LAS f32x2*)(lds + ya + ((tt) - 1) * 256) = (f32x2){py0, py1}; \
            S0 = T0 + K.bb * sa0; S1 = T1 + K.bb * sa1; \
            py0 = dot4(S0, K.rr); py1 = dot4(S1, K.rr); } while (0)

    SCAN_PREFETCH(C);
    SCAN_LOADS0(C, S0, S1);
    SCAN_PROCESS(C, lds);
    __syncthreads();
    for (;;) {
        const bool haveN = get_chunk(j + 1, CN);
        LAS unsigned char* inb = lds + (j & 1) * IN_BYTES;
        if (haveN) { SCAN_PREFETCH(CN); if (CN.first) SCAN_LOADS0(CN, N0, N1); }
        {
            const LAS unsigned char* ibk = inb + kq * 16;
            const LAS unsigned char* vbk = inb + 1280 + srow * 4;
            const int ns = C.nsteps;
            float py0 = 0.f, py1 = 0.f;
            KV KA, KB;
            SCAN_LOADK(KA, 0);
            for (int t = 0; t < ns; t += 2) {
                SCAN_LOADK(KB, t + 1);
                SCAN_STEP(KA, t);
                SCAN_LOADK(KA, t + 2);
                SCAN_STEP(KB, t + 1);
            }
            py0 = red16(py0); py1 = red16(py1);
            *(LAS f32x2*)(lds + ya + (ns - 1) * 256) = (f32x2){py0, py1};
        }
        if (C.last) { float* op = a.out + (C.kind == 0 ? O_WKVP : O_WKVS) + (((size_t)C.seq * NH + C.h) * 64 + srow) * 64 + 4 * kq; *(f32x4*)op = S0; *(f32x4*)(op + 64) = S1; }
        __syncthreads();
        if (pt < C.nsteps) {
            const f32x4 y = *(const LAS f32x4*)(ybuf + pt * 64 + 4 * kq);
            const float mean = red16((y[0] + y[1]) + (y[2] + y[3])) * (1.0f / 64.0f); const f32x4 d = y - mean; const float var = red16(dot4(d, d)) * (1.0f / 64.0f);
            const f32x4 xv = *(const LAS f32x4*)(inb + pt * IN_STRIDE + 1280 + kq * 16);
            const f32x4 gt = unpack4(gcur);
            const f32x4 yn = d * rsqrtf(var + GN_EPS) * gwc + gbc + xv * rkbuf[pt];
            f32x4 o;
#pragma unroll
            for (int i = 0; i < 4; ++i) o[i] = yn[i] * (gt[i] * frcp(1.0f + __expf(-gt[i])));
            u32x2 w; w.x = pk2(o[0], o[1]); w.y = pk2(o[2], o[3]);
            *(u32x2*)(Y + (size_t)(C.row0 + pt) * D + C.h * 64 + 4 * kq) = w;
        }
        if (haveN) SCAN_PROCESS(CN, lds + ((j + 1) & 1) * IN_BYTES);
        __syncthreads();
        if (!haveN) break;
        C = CN; ++j; if (C.first) { S0 = N0; S1 = N1; }
    }
#undef SCAN_PREFETCH
#undef SCAN_LOADS0
#undef SCAN_PROCESS
#undef SCAN_LOADK
#undef SCAN_STEP
}
}


namespace cscan {
constexpr int CB = 14336, CB_PT0 = 0, CB_PT1 = 1024, CB_RT0 = 2048, CB_RT1 = 3072, CB_NM = 4096, CB_BK = 5120, CB_QT = 9216, CB_V = 9728, CB_GAM = 11776, CB_RK = 12032, CB_GATE = 12288;
constexpr int NCH = 128, IMG = 144;
constexpr int A_AT = 0, A_BT = 2304, A_KT = 4608, A_RT = 6912, A_NS = 9216, A_MK = 10240, A_TS = 11264, A_PS = 12288, A_WAVE = 14592;
static_assert(8 * A_WAVE <= 131072, "chunk_pre LDS map");
constexpr int RING = 7, DEPTH = 5, YB_OFF = RING * CB, YB_SZ = 8704;
static_assert(YB_OFF + 2 * YB_SZ <= 131072, "chunk_scan LDS map");

__device__ __forceinline__ int kpos(int k) { const int s = k >> 5, kk = k & 31; return s * 32 + ((kk & 15) >> 2) * 8 + (kk & 3) + ((kk >> 4) << 2); }
__device__ __forceinline__ float wsum64(float x) {
    x = scan::red16(x); const int xi = __builtin_bit_cast(int, x);
    const float s0 = __builtin_bit_cast(float, __builtin_amdgcn_readlane(xi, 0)), s1 = __builtin_bit_cast(float, __builtin_amdgcn_readlane(xi, 16)),
                s2 = __builtin_bit_cast(float, __builtin_amdgcn_readlane(xi, 32)), s3 = __builtin_bit_cast(float, __builtin_amdgcn_readlane(xi, 48));
    return (s0 + s1) + (s2 + s3);
}
__device__ __forceinline__ float red8(float x) {
    x += __builtin_bit_cast(float, __builtin_amdgcn_update_dpp(0, __builtin_bit_cast(int, x), 0xB1, 0xF, 0xF, true));
    x += __builtin_bit_cast(float, __builtin_amdgcn_update_dpp(0, __builtin_bit_cast(int, x), 0x4E, 0xF, 0xF, true));
    x += __builtin_bit_cast(float, __builtin_amdgcn_update_dpp(0, __builtin_bit_cast(int, x), 0x141, 0xF, 0xF, true));
    return x;
}

constexpr int A_ATT = 6656;
constexpr int S_BK = 0, S_V = 4096, S_GAM = 6144, S_RK = 6400, S_YB = 6656;
template <bool SAMPLE>
__device__ __forceinline__ void chunk_pre(const Args& a, LAS unsigned char* wl, int task, int lane) {
    const int h = SAMPLE ? (task & 31) : ((task >> 7) & 31), c = SAMPLE ? 1 : (task & 127), k = lane, col = h * 64 + k, vc = lane & 15, g = lane >> 4;
    const size_t row0 = SAMPLE ? (size_t)M_P + (size_t)(task >> 5) * TS : (size_t)(task >> 12) * TP + 16 * c;
    constexpr int NT = SAMPLE ? 8 : 16;
    const bf16_t* Z = (const bf16_t*)(a.ws + WS_Z); const bf16_t* DW = (const bf16_t*)(a.ws + WS_DW); const bf16_t* AA = (const bf16_t*)(a.ws + WS_AA);
    unsigned char* blk = a.ws + WS_CB + (size_t)task * CB;
    const float mur = a.in[7][col], muk = a.in[7][2048 + col], muv = a.in[7][4096 + col], kkc = a.in[12][col], kac = a.in[13][col], rkc = a.in[14][col];
    unsigned short zr[17], zk[17], zv[17], dw[16], aa[16];
    u32x4 tg[2];
    { const int rr = lane >> 3, ch8 = (lane & 7) * 8;
      u32x4 tz[3][3], td[2][2];
#pragma unroll
      for (int i = 0; i < 3; ++i) { const int r = rr + 8 * i; const bool ok = SAMPLE ? (r >= 1 && r <= 8) : ((r < 17) && !(c == 0 && r == 0)); const size_t row = row0 + (size_t)(ok ? r : 1) - 1;
          const bf16_t* zp = Z + row * LDZ + h * 64 + ch8;
#pragma unroll
          for (int m3 = 0; m3 < 3; ++m3) { tz[m3][i] = *(const u32x4*)(zp + 2048 * m3); if (!ok) tz[m3][i] = (u32x4){0u, 0u, 0u, 0u}; } }
      if (SAMPLE && rr == 0) {
          const float* sp = a.in[3] + (size_t)(task >> 5) * SHIFT_W + h * 64 + ch8;
#pragma unroll
          for (int m3 = 0; m3 < 3; ++m3) { const f32x4 lo = *(const f32x4*)(sp + 2048 * m3), hi = *(const f32x4*)(sp + 2048 * m3 + 4);
              tz[m3][0] = (u32x4){pk2(lo[0], lo[1]), pk2(lo[2], lo[3]), pk2(hi[0], hi[1]), pk2(hi[2], hi[3])}; } }
#pragma unroll
      for (int i = 0; i < 2; ++i) { const size_t row = row0 + rr + (SAMPLE ? 0 : 8 * i); td[0][i] = *(const u32x4*)(DW + row * RW + h * 64 + ch8); td[1][i] = *(const u32x4*)(AA + row * RW + h * 64 + ch8);
          if (SAMPLE && i == 0) tg[0] = *(const u32x4*)(Z + row * LDZ + OFF_GR + h * 64 + ch8); }
#pragma unroll
      for (int i = 0; i < 3; ++i) { const int r = rr + 8 * i; if (r < 17) {
#pragma unroll
          for (int m3 = 0; m3 < 3; ++m3) *(LAS u32x4*)(wl + m3 * 2176 + r * 128 + ch8 * 2) = tz[m3][i]; } }
#pragma unroll
      for (int i = 0; i < 2; ++i) { const int r = rr + 8 * i; *(LAS u32x4*)(wl + 6528 + r * 128 + ch8 * 2) = td[0][i]; *(LAS u32x4*)(wl + 8576 + r * 128 + ch8 * 2) = td[1][i];
          }
      LDS_WAIT();
#pragma unroll
      for (int t = 0; t < NT + 1; ++t) { zr[t] = *(const LAS unsigned short*)(wl + t * 128 + 2 * k); zk[t] = *(const LAS unsigned short*)(wl + 2176 + t * 128 + 2 * k); zv[t] = *(const LAS unsigned short*)(wl + 4352 + t * 128 + 2 * k); }
#pragma unroll
      for (int t = 0; t < NT; ++t) { dw[t] = *(const LAS unsigned short*)(wl + 6528 + t * 128 + 2 * k); aa[t] = *(const LAS unsigned short*)(wl + 8576 + t * 128 + 2 * k); }
      LDS_WAIT(); }
    const int kp2 = 2 * kpos(k);
    float al[16], be[16], kt[16]; unsigned xvp[8]; float cum = 0.f, rkv = 0.f, ecl = 1.0f;
#pragma unroll
    for (int t = 0; t < NT; ++t) {
        const float z_r = bf2f(zr[t + 1]), z_k = bf2f(zk[t + 1]), z_v = bf2f(zv[t + 1]), p_r = bf2f(zr[t]), p_k = bf2f(zk[t]), p_v = bf2f(zv[t]);
        const float xr = z_r + mur * (p_r - z_r), xk = z_k + muk * (p_k - z_k), xv = z_v + muv * (p_v - z_v), av = bf2f(aa[t]);
        const float kkv = xk * kkc, ss = wsum64(kkv * kkv), kkn = kkv * __builtin_amdgcn_rsqf(fmaxf(ss, 1e-24f));
        const float kh = xk * (1.0f + (av - 1.0f) * kac), rkt = wsum64(xr * kh * rkc);
        rkv = (lane == t) ? rkt : rkv;
        const float ecp = ecl; cum += bf2f(dw[t]); const float ec = __expf(cum), eci = frcp(ec); ecl = ec;
        al[t] = -kkn * ecp; be[t] = kkn * av * eci; kt[t] = kh * eci;
        *(LAS unsigned short*)(wl + A_AT + t * IMG + kp2) = (unsigned short)f2bf(al[t]);
        *(LAS unsigned short*)(wl + A_BT + t * IMG + kp2) = (unsigned short)f2bf(be[t]);
        *(LAS unsigned short*)(wl + A_KT + t * IMG + kp2) = (unsigned short)f2bf(kt[t]);
        *(LAS unsigned short*)(wl + A_RT + t * IMG + kp2) = (unsigned short)f2bf(xr * ec);
        if (t & 1) xvp[t >> 1] |= f2bf(xv) << 16; else xvp[t >> 1] = f2bf(xv);
    }
    if (SAMPLE) {
#pragma unroll
        for (int t = NT; t < 16; ++t) { al[t] = 0.f; be[t] = 0.f; kt[t] = 0.f; if (!(t & 1)) xvp[t >> 1] = 0u;
            *(LAS unsigned short*)(wl + A_AT + t * IMG + kp2) = 0; *(LAS unsigned short*)(wl + A_BT + t * IMG + kp2) = 0; *(LAS unsigned short*)(wl + A_KT + t * IMG + kp2) = 0; *(LAS unsigned short*)(wl + A_RT + t * IMG + kp2) = 0; } }
    const float eL = ecl;
    u32x4 w4[4];
#pragma unroll
    for (int gg = 0; gg < 4; ++gg) { w4[gg].x = pk2(be[4 * gg] * eL, be[4 * gg + 1] * eL); w4[gg].y = pk2(be[4 * gg + 2] * eL, be[4 * gg + 3] * eL); w4[gg].z = pk2(kt[4 * gg] * eL, kt[4 * gg + 1] * eL); w4[gg].w = pk2(kt[4 * gg + 2] * eL, kt[4 * gg + 3] * eL); }
    if (!SAMPLE) { *(float*)(blk + CB_GAM + 4 * k) = eL; if (lane < 16) *(float*)(blk + CB_RK + 4 * lane) = rkv; }
    LDS_WAIT();
    f32x4 gN = (f32x4){0.f, 0.f, 0.f, 0.f}, gMk = gN, gNr = gN, gMkr = gN;
    bf16x8 frs[2];
#pragma unroll
    for (int sK = 0; sK < 2; ++sK) { const int fo = vc * IMG + sK * 64 + g * 16;
        const bf16x8 fa = *(const LAS bf16x8*)(wl + A_AT + fo), fb = *(const LAS bf16x8*)(wl + A_BT + fo), fk = *(const LAS bf16x8*)(wl + A_KT + fo), fr = *(const LAS bf16x8*)(wl + A_RT + fo);
        gN = __builtin_amdgcn_mfma_f32_16x16x32_bf16(fb, fa, gN, 0, 0, 0); gMk = __builtin_amdgcn_mfma_f32_16x16x32_bf16(fk, fa, gMk, 0, 0, 0);
        gNr = __builtin_amdgcn_mfma_f32_16x16x32_bf16(fb, fr, gNr, 0, 0, 0); gMkr = __builtin_amdgcn_mfma_f32_16x16x32_bf16(fk, fr, gMkr, 0, 0, 0);
        frs[sK] = fr;
        if (!SAMPLE) __builtin_nontemporal_store(__builtin_bit_cast(u32x4, fr), (u32x4*)(blk + CB_RT0 + sK * 1024 + vc * 64 + g * 16)); }
    { u32x4 lo_, hi_; lo_.x = pk2(al[0], al[1]); lo_.y = pk2(al[2], al[3]); lo_.z = pk2(al[4], al[5]); lo_.w = pk2(al[6], al[7]); hi_.x = pk2(al[8], al[9]); hi_.y = pk2(al[10], al[11]); hi_.z = pk2(al[12], al[13]); hi_.w = pk2(al[14], al[15]);
      *(LAS u32x4*)(wl + A_ATT + k * 32) = lo_; *(LAS u32x4*)(wl + A_ATT + k * 32 + 16) = hi_; }
    {
        LDS_WAIT();
#pragma unroll
        for (int gg = 0; gg < 4; ++gg) *(LAS u32x4*)(wl + S_BK + k * 64 + gg * 16) = w4[gg];
        *(LAS u32x4*)(wl + S_V + (k >> 4) * 512 + (k & 15) * 32) = (u32x4){xvp[0], xvp[1], xvp[2], xvp[3]}; *(LAS u32x4*)(wl + S_V + (k >> 4) * 512 + (k & 15) * 32 + 16) = (u32x4){xvp[4], xvp[5], xvp[6], xvp[7]};
        if (SAMPLE) { *(LAS float*)(wl + S_GAM + 4 * k) = eL; if (lane < 16) *(LAS float*)(wl + S_RK + 4 * lane) = rkv; }
        else { LDS_WAIT();
#pragma unroll
            for (int q = 0; q < 4; ++q) __builtin_nontemporal_store(*(const LAS u32x4*)(wl + S_BK + q * 1024 + lane * 16), (u32x4*)(blk + CB_BK + q * 1024 + lane * 16));
#pragma unroll
            for (int q = 0; q < 2; ++q) __builtin_nontemporal_store(*(const LAS u32x4*)(wl + S_V + q * 1024 + lane * 16), (u32x4*)(blk + CB_V + q * 1024 + lane * 16)); }
    }
#pragma unroll
    for (int r = 0; r < 4; ++r) { const int i = 4 * g + r; gN[r] = (i < vc) ? gN[r] : 0.f; gMk[r] = (i < vc) ? gMk[r] : 0.f; gNr[r] = (i <= vc) ? gNr[r] : 0.f; gMkr[r] = (i <= vc) ? gMkr[r] : 0.f;
        ((LAS float*)(wl + A_NS))[i * 16 + vc] = gN[r]; ((LAS float*)(wl + A_MK))[i * 16 + vc] = gMk[r]; }
    u32x4 nmw; nmw.x = pk2(gNr[0], gNr[1]); nmw.y = pk2(gNr[2], gNr[3]); nmw.z = pk2(gMkr[0], gMkr[1]); nmw.w = pk2(gMkr[2], gMkr[3]);
    if (!SAMPLE) __builtin_nontemporal_store(nmw, (u32x4*)(blk + CB_NM + vc * 64 + g * 16));
    LDS_WAIT();
    float Tc[16];
#pragma unroll
    for (int i = 15; i >= 0; --i) { float acc = (i == vc) ? 1.0f : 0.0f;
#pragma unroll
        for (int m = i + 1; m < 16; ++m) acc += ((const LAS float*)(wl + A_NS))[i * 16 + m] * Tc[m];
        Tc[i] = acc; }
    bf16x8 tfr;
    { float tb[8];
#pragma unroll
      for (int j = 0; j < 8; ++j) tb[j] = (g == 0) ? Tc[j] : ((g == 1) ? Tc[8 + j] : 0.f);
      const u32x4 w_ = (u32x4){pk2(tb[0], tb[1]), pk2(tb[2], tb[3]), pk2(tb[4], tb[5]), pk2(tb[6], tb[7])}; tfr = __builtin_bit_cast(bf16x8, w_); }
    u32x2 qw;
    { const LAS float* mp = (const LAS float*)(wl + A_MK) + vc * 16 + 8 * (g & 1); const f32x4 m0 = *(const LAS f32x4*)mp, m1 = *(const LAS f32x4*)(mp + 4);
      const u32x4 w_ = (u32x4){pk2(m0[0], m0[1]), pk2(m0[2], m0[3]), pk2(m1[0], m1[1]), pk2(m1[2], m1[3])};
      const f32x4 qd = __builtin_amdgcn_mfma_f32_16x16x32_bf16(__builtin_bit_cast(bf16x8, w_), tfr, (f32x4){0.f, 0.f, 0.f, 0.f}, 0, 0, 0);
      qw = (u32x2){pk2(qd[0], qd[1]), pk2(qd[2], qd[3])};
      if (!SAMPLE) *(u32x2*)(blk + CB_QT + vc * 32 + g * 8) = qw; }
#pragma unroll
    for (int kb = 0; kb < 4; ++kb) { const bf16x8 af = *(const LAS bf16x8*)(wl + A_ATT + (16 * kb + vc) * 32 + (g & 1) * 16);
        const f32x4 pd = __builtin_amdgcn_mfma_f32_16x16x32_bf16(af, tfr, (f32x4){0.f, 0.f, 0.f, 0.f}, 0, 0, 0);
        *(LAS u32x2*)(wl + A_PS + vc * IMG + 2 * (32 * (kb >> 1) + 8 * g + 4 * (kb & 1))) = (u32x2){pk2(pd[0], pd[1]), pk2(pd[2], pd[3])}; }
    LDS_WAIT();
    if (!SAMPLE) {
#pragma unroll
        for (int sK = 0; sK < 2; ++sK) __builtin_nontemporal_store(*(const LAS u32x4*)(wl + A_PS + vc * IMG + sK * 64 + g * 16), (u32x4*)(blk + CB_PT0 + sK * 1024 + vc * 64 + g * 16));
        LDS_WAIT();
    } else {
        const int fo = vc * IMG + g * 16;
        const bf16x8 pt0 = *(const LAS bf16x8*)(wl + A_PS + fo), pt1 = *(const LAS bf16x8*)(wl + A_PS + fo + 64), nm = __builtin_bit_cast(bf16x8, nmw);
        const f32x4 rk4 = *(const LAS f32x4*)(wl + S_RK + 16 * g);
        bf16x8 qt;
        { const s16x4 qt4 = __builtin_bit_cast(s16x4, qw);
#pragma unroll
          for (int jj = 0; jj < 4; ++jj) { qt[jj] = qt4[jj]; qt[4 + jj] = 0; } }
        bf16x8 bk[4]; f32x4 gm[4];
#pragma unroll
        for (int kb = 0; kb < 4; ++kb) { bk[kb] = *(const LAS bf16x8*)(wl + S_BK + (16 * kb + vc) * 64 + g * 16); gm[kb] = *(const LAS f32x4*)(wl + S_GAM + (16 * kb + 4 * g) * 4); }
        float* op = a.out + O_WKVS + ((size_t)task * 64 + vc) * 64 + 4 * g;
        const float* sp = a.in[2] + ((size_t)task * 64 + vc) * 64 + 4 * g;
        LAS float* yb = (LAS float*)(wl + S_YB);
        f32x4 St[4][4];
#pragma unroll
        for (int wv = 0; wv < 4; ++wv)
#pragma unroll
            for (int kb = 0; kb < 4; ++kb) St[wv][kb] = *(const f32x4*)(sp + (size_t)wv * 1024 + 16 * kb);
#pragma unroll
        for (int wv = 0; wv < 4; ++wv) {
            const s16x4 vw4 = *(const LAS s16x4*)(wl + S_V + wv * 512 + vc * 32 + g * 8);
            bf16x8 vv, sf0, sf1, uv;
#pragma unroll
            for (int jj = 0; jj < 4; ++jj) { vv[jj] = vw4[jj]; vv[4 + jj] = vw4[jj]; }
            { u32x4 w_; w_.x = pk2(St[wv][0][0], St[wv][0][1]); w_.y = pk2(St[wv][0][2], St[wv][0][3]); w_.z = pk2(St[wv][1][0], St[wv][1][1]); w_.w = pk2(St[wv][1][2], St[wv][1][3]); sf0 = __builtin_bit_cast(bf16x8, w_);
              w_.x = pk2(St[wv][2][0], St[wv][2][1]); w_.y = pk2(St[wv][2][2], St[wv][2][3]); w_.z = pk2(St[wv][3][0], St[wv][3][1]); w_.w = pk2(St[wv][3][2], St[wv][3][3]); sf1 = __builtin_bit_cast(bf16x8, w_); }
            f32x4 ut = (f32x4){0.f, 0.f, 0.f, 0.f}, y0 = ut;
            ut = __builtin_amdgcn_mfma_f32_16x16x32_bf16(pt0, sf0, ut, 0, 0, 0); y0 = __builtin_amdgcn_mfma_f32_16x16x32_bf16(frs[0], sf0, y0, 0, 0, 0);
            ut = __builtin_amdgcn_mfma_f32_16x16x32_bf16(pt1, sf1, ut, 0, 0, 0); y0 = __builtin_amdgcn_mfma_f32_16x16x32_bf16(frs[1], sf1, y0, 0, 0, 0);
            ut = __builtin_amdgcn_mfma_f32_16x16x32_bf16(qt, vv, ut, 0, 0, 0);
#pragma unroll
            for (int jj = 0; jj < 4; ++jj) uv[4 + jj] = vw4[jj];
            { const unsigned u0_ = pk2(ut[0], ut[1]), u1_ = pk2(ut[2], ut[3]); uv[0] = (short)(u0_ & 0xffffu); uv[1] = (short)(u0_ >> 16); uv[2] = (short)(u1_ & 0xffffu); uv[3] = (short)(u1_ >> 16); }
            const f32x4 yt = __builtin_amdgcn_mfma_f32_16x16x32_bf16(nm, uv, y0, 0, 0, 0);
#pragma unroll
            for (int kb = 0; kb < 4; ++kb) { const f32x4 sn = __builtin_amdgcn_mfma_f32_16x16x32_bf16(bk[kb], uv, St[wv][kb] * gm[kb], 0, 0, 0); *(f32x4*)(op + (size_t)wv * 1024 + 16 * kb) = sn; }
            if (g < 2) {
#pragma unroll
                for (int r = 0; r < 4; ++r) { yb[(4 * g + r) * 68 + 16 * wv + vc] = yt[r]; yb[544 + (4 * g + r) * 68 + 16 * wv + vc] = rk4[r] * bfs2f(vw4[r]); } }
        }
        LDS_WAIT();
        { const int pt = lane >> 3, vo = lane & 7;
          const float* gwp = a.in[15] + h * 64 + 8 * vo; const float* gbp = a.in[16] + h * 64 + 8 * vo;
          const f32x4 gw0 = *(const f32x4*)gwp, gw1 = *(const f32x4*)(gwp + 4), gb0 = *(const f32x4*)gbp, gb1 = *(const f32x4*)(gbp + 4);
          const LAS float* yp = yb + pt * 68 + 8 * vo;
          const f32x4 y0_ = *(const LAS f32x4*)yp, y1_ = *(const LAS f32x4*)(yp + 4), b0_ = *(const LAS f32x4*)(yp + 544), b1_ = *(const LAS f32x4*)(yp + 548);
          const bf16x8 gt_ = __builtin_bit_cast(bf16x8, tg[0]);
          const float mean_ = red8(((y0_[0] + y0_[1]) + (y0_[2] + y0_[3])) + ((y1_[0] + y1_[1]) + (y1_[2] + y1_[3]))) * (1.0f / 64.0f);
          const f32x4 d0_ = y0_ - mean_, d1_ = y1_ - mean_;
          const float var_ = red8(scan::dot4(d0_, d0_) + scan::dot4(d1_, d1_)) * (1.0f / 64.0f); const float rs_ = rsqrtf(var_ + GN_EPS);
          const f32x4 n0_ = d0_ * rs_ * gw0 + gb0 + b0_, n1_ = d1_ * rs_ * gw1 + gb1 + b1_; float o_[8];
#pragma unroll
          for (int i_ = 0; i_ < 4; ++i_) { const float ga_ = bfs2f(gt_[i_]), gb_ = bfs2f(gt_[4 + i_]); o_[i_] = n0_[i_] * (ga_ * frcp(1.0f + __expf(-ga_))); o_[4 + i_] = n1_[i_] * (gb_ * frcp(1.0f + __expf(-gb_))); }
          *(u32x2*)(a.ws + WS_Y + (row0 + pt) * D + h * 64 + 8 * vo) = (u32x2){pk4_fp8(o_[0], o_[1], o_[2], o_[3]), pk4_fp8(o_[4], o_[5], o_[6], o_[7])}; }
        LDS_WAIT();
    }
}

struct CFrag { bf16x8 pt0, pt1, rt0, rt1, nm, bk0, bk1, bk2, bk3; s16x4 qt4, vw4; f32x4 rk4, gm0, gm1, gm2, gm3; };
__device__ __forceinline__ void chunk_scan(const Args& a, LAS unsigned char* lds, const int tid, const int p) {
    const int wave = __builtin_amdgcn_readfirstlane(tid >> 6), lane = tid & 63, vc = lane & 15, g = lane >> 4;
    const int b = p >> 5, h = p & 31;
    const unsigned char* gblk = a.ws + WS_CB + (size_t)p * NCH * CB;
    bf16_t* Y = (bf16_t*)(a.ws + WS_Y);
#define CS_BAR() do { asm volatile("s_waitcnt lgkmcnt(0)" ::: "memory"); __builtin_amdgcn_s_barrier(); asm volatile("" ::: "memory"); } while (0)
    const unsigned char* zgt = a.ws + WS_Z + (((size_t)b * TP + (lane >> 3)) * LDZ + OFF_GR + h * 64) * 2 + (lane & 7) * 16;
#define CS_ISSUE(blkidx, slot) do { _Pragma("unroll") for (int q_ = 0; q_ < 4; ++q_) { int pc_ = (wave & 3) * 4 + q_; pc_ = (pc_ >= 14) ? pc_ - 2 : pc_; \
        const unsigned char* src_ = (pc_ < 12) ? gblk + (size_t)(blkidx) * CB + pc_ * 1024 + lane * 16 : zgt + ((size_t)(blkidx) * 16 + (pc_ - 12) * 8) * LDZ * 2; \
        __builtin_amdgcn_global_load_lds((const unsigned*)src_, (LAS unsigned*)(lds + (slot) * CB + pc_ * 1024), 16, 0, 0); } } while (0)
    f32x4 St[4];
#pragma unroll
    for (int kb = 0; kb < 4; ++kb) St[kb] = (f32x4){0.f, 0.f, 0.f, 0.f};
    const int lt = tid - 256, pt = (lt >> 4) & 15, vo = lt & 15;
    const f32x4 gw0 = *(const f32x4*)(a.in[15] + h * 64 + 4 * vo), gb0 = *(const f32x4*)(a.in[16] + h * 64 + 4 * vo);
    asm volatile("s_waitcnt vmcnt(0)" ::: "memory");
    if (wave < 4) {
#pragma unroll
        for (int i = 0; i < DEPTH; ++i) CS_ISSUE(i, i);
        asm volatile("s_waitcnt vmcnt(12)" ::: "memory");
    }
    CS_BAR();
    int slot = 0, islot = DEPTH;
#define CS_POST(cc, sl) do { const LAS float* yb_ = (const LAS float*)(lds + YB_OFF + ((cc) & 1) * YB_SZ) + pt * 68 + 4 * vo; \
        const f32x4 y0_ = *(const LAS f32x4*)yb_, b0_ = *(const LAS f32x4*)(yb_ + 1088); \
        const s16x4 gt_ = *(const LAS s16x4*)(lds + (sl) * CB + CB_GATE + pt * 128 + vo * 8); \
        const float mean_ = scan::red16((y0_[0] + y0_[1]) + (y0_[2] + y0_[3])) * (1.0f / 64.0f); \
        const f32x4 d0_ = y0_ - mean_; \
        const float var_ = scan::red16(scan::dot4(d0_, d0_)) * (1.0f / 64.0f); const float rs_ = rsqrtf(var_ + GN_EPS); \
        const f32x4 n0_ = d0_ * rs_ * gw0 + gb0 + b0_; float o_[4]; \
        _Pragma("unroll") for (int i_ = 0; i_ < 4; ++i_) { const float ga_ = bfs2f(gt_[i_]); o_[i_] = n0_[i_] * (ga_ * frcp(1.0f + __expf(-ga_))); } \
        *(unsigned*)((unsigned char*)Y + ((size_t)b * TP + 16 * (cc) + pt) * D + h * 64 + 4 * vo) = pk4_fp8(o_[0], o_[1], o_[2], o_[3]); } while (0)
    const int fo = vc * 64 + g * 16;
#define CS_LOADF(F, sl) do { const LAS unsigned char* sb_ = lds + (sl) * CB; \
        F.pt0 = *(const LAS bf16x8*)(sb_ + CB_PT0 + fo); F.pt1 = *(const LAS bf16x8*)(sb_ + CB_PT1 + fo); F.rt0 = *(const LAS bf16x8*)(sb_ + CB_RT0 + fo); F.rt1 = *(const LAS bf16x8*)(sb_ + CB_RT1 + fo); F.nm = *(const LAS bf16x8*)(sb_ + CB_NM + fo); \
        F.qt4 = *(const LAS s16x4*)(sb_ + CB_QT + vc * 32 + g * 8); F.vw4 = *(const LAS s16x4*)(sb_ + CB_V + wave * 512 + vc * 32 + g * 8); F.rk4 = *(const LAS f32x4*)(sb_ + CB_RK + 16 * g); \
        F.bk0 = *(const LAS bf16x8*)(sb_ + CB_BK + fo); F.bk1 = *(const LAS bf16x8*)(sb_ + CB_BK + 1024 + fo); F.bk2 = *(const LAS bf16x8*)(sb_ + CB_BK + 2048 + fo); F.bk3 = *(const LAS bf16x8*)(sb_ + CB_BK + 3072 + fo); \
        F.gm0 = *(const LAS f32x4*)(sb_ + CB_GAM + (4 * g) * 4); F.gm1 = *(const LAS f32x4*)(sb_ + CB_GAM + (16 + 4 * g) * 4); F.gm2 = *(const LAS f32x4*)(sb_ + CB_GAM + (32 + 4 * g) * 4); F.gm3 = *(const LAS f32x4*)(sb_ + CB_GAM + (48 + 4 * g) * 4); } while (0)
#define CS_COMPUTE(F, cc) do { bf16x8 qt, vv, sf0, sf1, uv; \
        _Pragma("unroll") for (int jj = 0; jj < 4; ++jj) { qt[jj] = F.qt4[jj]; qt[4 + jj] = 0; vv[jj] = F.vw4[jj]; vv[4 + jj] = F.vw4[jj]; } \
        { u32x4 w_; w_.x = pk2(St[0][0], St[0][1]); w_.y = pk2(St[0][2], St[0][3]); w_.z = pk2(St[1][0], St[1][1]); w_.w = pk2(St[1][2], St[1][3]); sf0 = __builtin_bit_cast(bf16x8, w_); \
          w_.x = pk2(St[2][0], St[2][1]); w_.y = pk2(St[2][2], St[2][3]); w_.z = pk2(St[3][0], St[3][1]); w_.w = pk2(St[3][2], St[3][3]); sf1 = __builtin_bit_cast(bf16x8, w_); } \
        f32x4 ut = (f32x4){0.f, 0.f, 0.f, 0.f}, y0 = ut; \
        ut = __builtin_amdgcn_mfma_f32_16x16x32_bf16(F.pt0, sf0, ut, 0, 0, 0); y0 = __builtin_amdgcn_mfma_f32_16x16x32_bf16(F.rt0, sf0, y0, 0, 0, 0); \
        ut = __builtin_amdgcn_mfma_f32_16x16x32_bf16(F.pt1, sf1, ut, 0, 0, 0); y0 = __builtin_amdgcn_mfma_f32_16x16x32_bf16(F.rt1, sf1, y0, 0, 0, 0); \
        ut = __builtin_amdgcn_mfma_f32_16x16x32_bf16(qt, vv, ut, 0, 0, 0); \
        _Pragma("unroll") for (int jj = 0; jj < 4; ++jj) uv[4 + jj] = F.vw4[jj]; \
        { const unsigned u0_ = pk2(ut[0], ut[1]), u1_ = pk2(ut[2], ut[3]); uv[0] = (short)(u0_ & 0xffffu); uv[1] = (short)(u0_ >> 16); uv[2] = (short)(u1_ & 0xffffu); uv[3] = (short)(u1_ >> 16); } \
        const f32x4 yt = __builtin_amdgcn_mfma_f32_16x16x32_bf16(F.nm, uv, y0, 0, 0, 0); \
        St[0] = __builtin_amdgcn_mfma_f32_16x16x32_bf16(F.bk0, uv, St[0] * F.gm0, 0, 0, 0); St[1] = __builtin_amdgcn_mfma_f32_16x16x32_bf16(F.bk1, uv, St[1] * F.gm1, 0, 0, 0); \
        St[2] = __builtin_amdgcn_mfma_f32_16x16x32_bf16(F.bk2, uv, St[2] * F.gm2, 0, 0, 0); St[3] = __builtin_amdgcn_mfma_f32_16x16x32_bf16(F.bk3, uv, St[3] * F.gm3, 0, 0, 0); \
        LAS float* yb = (LAS float*)(lds + YB_OFF + ((cc) & 1) * YB_SZ) + 16 * wave + vc; \
        _Pragma("unroll") for (int r = 0; r < 4; ++r) { yb[(4 * g + r) * 68] = yt[r]; yb[1088 + (4 * g + r) * 68] = F.rk4[r] * bfs2f(F.vw4[r]); } } while (0)
#define CS_STEP(FC, FN, cc) do { if (wave < 4) { const int s1 = (slot + 1 == RING) ? 0 : slot + 1; const int nb = ((cc) + DEPTH < NCH) ? (cc) + DEPTH : NCH - 1; \
            CS_ISSUE(nb, islot); CS_LOADF(FN, s1); CS_COMPUTE(FC, cc); \
            asm volatile("s_waitcnt vmcnt(12)" ::: "memory");             \
        } else { if ((cc) > 0) { const int ps = (slot == 0) ? RING - 1 : slot - 1; CS_POST((cc) - 1, ps); } } \
        CS_BAR(); slot = (slot + 1 == RING) ? 0 : slot + 1; islot = (islot + 1 == RING) ? 0 : islot + 1; } while (0)
    CFrag FA, FB;
    if (wave < 4) CS_LOADF(FA, 0);
    for (int c = 0; c < NCH; c += 2) { CS_STEP(FA, FB, c); CS_STEP(FB, FA, c + 1); }
#undef CS_LOADF
#undef CS_COMPUTE
#undef CS_STEP
    if (wave >= 4) { const int ps = (slot == 0) ? RING - 1 : slot - 1; CS_POST(NCH - 1, ps); }
    if (wave < 4) { float* op = a.out + O_WKVP + (((size_t)p) * 64 + 16 * wave + vc) * 64 + 4 * g;
#pragma unroll
        for (int kb = 0; kb < 4; ++kb) *(f32x4*)(op + 16 * kb) = St[kb]; }
    asm volatile("s_waitcnt vmcnt(0)" ::: "memory");
    CS_BAR();
#undef CS_BAR
#undef CS_ISSUE
#undef CS_POST
}
}

__device__ __forceinline__ void phase_ln(const Args& a, const int tid) {
    const int lane = tid & 63, wave = tid >> 6; const int gw = blockIdx.x * 8 + wave, NGW = gridDim.x * 8;
    const float* lg = a.in[21]; const float* lb = a.in[22]; const bf16_t* H = (const bf16_t*)(a.ws + WS_Y);
    for (int m = gw; m < M; m += NGW) {
        const u32x2* hr = (const u32x2*)(H + (size_t)m * D) + lane; f32x4 v[16]; float s = 0.f;
#pragma unroll
        for (int q = 0; q < 16; ++q) { const u32x2 w = hr[64 * q];
            v[q] = (f32x4){__builtin_bit_cast(float, w.x << 16), __builtin_bit_cast(float, w.x & 0xffff0000u), __builtin_bit_cast(float, w.y << 16), __builtin_bit_cast(float, w.y & 0xffff0000u)}; }
#pragma unroll
        for (int q = 0; q < 16; ++q) s += (v[q][0] + v[q][1]) + (v[q][2] + v[q][3]);
        const float mean = wave_sum(s) * (1.0f / D); float s2 = 0.f;
#pragma unroll
        for (int q = 0; q < 16; ++q) { v[q] = v[q] - mean; s2 += (v[q][0] * v[q][0] + v[q][1] * v[q][1]) + (v[q][2] * v[q][2] + v[q][3] * v[q][3]); }
        const float rstd = rsqrtf(wave_sum(s2) * (1.0f / D) + LN_EPS);
        float* yr = a.out + O_Y + (size_t)m * D;
#pragma unroll
        for (int q = 0; q < 16; ++q) { const int c = (lane + 64 * q) * 4; const f32x4 gg = *(const f32x4*)(lg + c), bb = *(const f32x4*)(lb + c); __builtin_nontemporal_store(v[q] * rstd * gg + bb, (f32x4*)(yr + c)); }
    }
}

#define XB_TMO      128
#define XB_XCNT(j)  (256  + 64 * (j))
#define XB_XSUB(j)  (1280 + 64 * (j))
#define XB_XGEN(j)  (2304 + 64 * (j))
#define XB_TOP      3328
#define XB_TOPGEN   3392
#define XCD_BAR_WORDS 3456
#define XB_SPIN_CAP (1u << 20)
__device__ __forceinline__ unsigned xb_ld(unsigned* p)              { return __hip_atomic_load(p, __ATOMIC_RELAXED, __HIP_MEMORY_SCOPE_AGENT); }
__device__ __forceinline__ unsigned xb_add(unsigned* p, unsigned v) { return __hip_atomic_fetch_add(p, v, __ATOMIC_RELAXED, __HIP_MEMORY_SCOPE_AGENT); }
__device__ __forceinline__ unsigned xb_xcc_id() { return (unsigned)__builtin_amdgcn_s_getreg((3 << 11) | 20) & 0xFu; }
#define XB_SPIN(cond, bar) do { unsigned _sp = 0; while (cond) { __builtin_amdgcn_s_sleep(1); \
    if ((++_sp & 255u) == 0u) { if (xb_ld(&(bar)[XB_TMO])) break; if (_sp > XB_SPIN_CAP) { atomicAdd(&(bar)[XB_TMO], 1u); break; } } } } while (0)
struct XcdBarrier { unsigned* bar; unsigned x; volatile LAS unsigned* st; };
__device__ __forceinline__ XcdBarrier xcd_barrier_post(unsigned* bar, volatile LAS unsigned* st, int tid) {
    XcdBarrier b; b.bar = bar; b.x = xb_xcc_id(); b.st = st;
    if (tid == 0) (void)xb_add(&bar[XB_XCNT(b.x)], 1u);
    return b;
}
__device__ __forceinline__ void xcd_barrier_complete(unsigned* bar, unsigned x, unsigned& nloc, unsigned& nx) {
    const unsigned G = gridDim.x * gridDim.y * gridDim.z;
    unsigned sum, cnt, mine, sp = 0u;
    for (;;) {
        sum = 0u; cnt = 0u; mine = 0u;
#pragma unroll
        for (unsigned j = 0; j < 16; ++j) { const unsigned c = xb_ld(&bar[XB_XCNT(j)]); sum += c; cnt += (c > 0u) ? 1u : 0u; mine = (j == x) ? c : mine; }
        if (sum == G) break;
        __builtin_amdgcn_s_sleep(1);
        if ((++sp & 255u) == 0u) { if (xb_ld(&bar[XB_TMO])) break; if (sp > XB_SPIN_CAP) { atomicAdd(&bar[XB_TMO], 1u); break; } }
    }
    nloc = mine > 0u ? mine : 1u; nx = cnt > 0u ? cnt : 1u;
}
__device__ __forceinline__ void xcd_barrier(const XcdBarrier& b, int tid) {
    asm volatile("s_waitcnt vmcnt(0)" ::: "memory");
    __syncthreads();
    if (tid == 0) {
        unsigned* bar = b.bar;
        __builtin_amdgcn_s_waitcnt(0);
        unsigned nloc = b.st[0], nx = b.st[1];
        if (nloc == 0u) { xcd_barrier_complete(bar, b.x, nloc, nx); b.st[0] = nloc; b.st[1] = nx; }
        const unsigned old = xb_add(&bar[XB_XSUB(b.x)], 1u);
        const unsigned gen = old / nloc;
        if (old + 1u == (gen + 1u) * nloc) {
            __builtin_amdgcn_fence(__ATOMIC_RELEASE, "agent");
            asm volatile("s_waitcnt vmcnt(0)" ::: "memory");
            const unsigned og = xb_add(&bar[XB_TOP], 1u);
            const unsigned tg = og / nx;
            if (og + 1u == (tg + 1u) * nx) xb_add(&bar[XB_TOPGEN], 1u);
            else XB_SPIN(xb_ld(&bar[XB_TOPGEN]) == tg, bar);
            __builtin_amdgcn_fence(__ATOMIC_ACQUIRE, "agent");
            xb_add(&bar[XB_XGEN(b.x)], 1u);
            asm volatile("s_waitcnt vmcnt(0)" ::: "memory");
        } else {
            XB_SPIN(xb_ld(&bar[XB_XGEN(b.x)]) == gen, bar);
            __builtin_amdgcn_fence(__ATOMIC_ACQUIRE, "agent");
            asm volatile("s_waitcnt vmcnt(0)" ::: "memory");
        }
    }
    __syncthreads();
}

template <bool COOP>
__global__ void __launch_bounds__(NTHREADS, 2) fwd_kernel(Args a) {
    extern __shared__ __attribute__((aligned(16))) unsigned char lds_raw[];
    LAS unsigned char* lds = (LAS unsigned char*)lds_raw;
    const int lo = a.ph_lo, hi = a.ph_hi;
    const int wid_s = __builtin_amdgcn_readfirstlane((int)(threadIdx.x >> 6));
#define TID() (wid_s * 64 + lane_id_opaque())
    unsigned char* ws = a.ws;
#define IN(k) (lo <= (k) && (k) < hi)
#define SEAM(k) do { if (COOP && IN(k) && IN((k) + 1)) { xcd_barrier(xbar, TID()); } } while (0)
    XcdBarrier xbar; xbar.bar = (unsigned*)(ws + WS_BAR); xbar.x = 0; xbar.st = (volatile LAS unsigned*)(lds + LDS_MISC);
    if (COOP) {
        if (a.ph_lo < 0) cg::this_grid().sync();
        if (threadIdx.x < 2) ((LAS unsigned*)(lds + LDS_MISC))[threadIdx.x] = 0u;
        __syncthreads();
        xbar = xcd_barrier_post((unsigned*)(ws + WS_BAR), (volatile LAS unsigned*)(lds + LDS_MISC), TID());
    }
    for (int rp_ = 0; rp_ < (PROBE_REP == 0 ? 2 : 1); ++rp_)
    if (IN(0)) { phase_convert(a, lds, TID()); __syncthreads(); }
    SEAM(0);
    for (int rp_ = 0; rp_ < (PROBE_REP == 1 ? 2 : 1); ++rp_)
    if (IN(1)) {
        const int G_ = (int)gridDim.x, c_ = (int)blockIdx.x; const bool full = (G_ == 256); const int cr_ = full ? ((c_ + 76) & 255) : c_;
        if (!full) { convert_rest(a, lds, TID(), c_, G_); __syncthreads(); }
        { pg8::Gemm g{(const bf16_t*)(ws + WS_XB), (const bf16_t*)(ws + WS_W1T), D, D, D / 64, 64, 64}; pg8::TileOrder S; S.init(M, N_BF, G_, c_, 1, D / 64);
          S.nextra = N_BFX / 256; S.ex_pm = M / 256; S.ex_pn0 = N_BF / 256;
          pg8::EpiZ E{(bf16_t*)(ws + WS_Z), LDZ, 17, 19, 2048, OFF_K, 0, 1.0f, ws + WS_G, 1 << 20};
          pg8::gemm_phase<pg8::EpiZ, true, true, false>(lds, g, S, E, TID()); }
        { pg8::Gemm g{(const bf16_t*)(ws + WS_XB8), (const bf16_t*)(ws + WS_W8T), D, D, D / 128, D / 128, D / 128}; pg8::TileOrder S; S.init(M, N_F8, G_, cr_, 1, D / 128);
          if (full) { S.gA = 76; S.tA = 11; S.nBt = S.nwg - 76 * 11; }
          pg8::EpiZ E{(bf16_t*)(ws + WS_Z), LDZ, 8, 24, 0, OFF_GR, OFF_GA, 1.0f / 64.0f, ws + WS_G, 32};
          pg8::gemm_phase<pg8::EpiZ, true, true, true>(lds, g, S, E, TID()); }
        if (full && cr_ >= 104) { __syncthreads(); convert_rest(a, lds, TID(), cr_ - 104, 152); }
    }
    SEAM(1);
    for (int rp_ = 0; rp_ < (PROBE_REP == 2 ? 2 : 1); ++rp_)
    if (IN(2)) {
        const int tid = TID();
        { const bf16_t* Z = (const bf16_t*)(ws + WS_Z);
          for (size_t i = (size_t)blockIdx.x * NTHREADS + tid; i < (size_t)(NB_P + NB_S) * (SHIFT_W / 8); i += (size_t)gridDim.x * NTHREADS) {
              const int r = (int)(i / (SHIFT_W / 8)), c = (int)(i % (SHIFT_W / 8)) * 8;
              const size_t zrow = (c < 2048) ? (size_t)(M + r) : ((r < NB_P) ? ((size_t)r * TP + TP - 1) : ((size_t)M_P + (size_t)(r - NB_P) * TS + TS - 1));
              float* op = (r < NB_P) ? a.out + O_SHP + (size_t)r * SHIFT_W + c : a.out + O_SHS + (size_t)(r - NB_P) * SHIFT_W + c;
              att::store8f(op, *(const bf16x8*)(Z + zrow * LDZ + c)); } }
        lora_sample(a, tid);
        if (COOP) { lora_a_panel(a, 0, tid, (int)blockIdx.x * NTHREADS + tid, (int)gridDim.x * NTHREADS, M_P * 32); VM_WAIT(); __syncthreads(); }
    }
    if (COOP && IN(2)) { xcd_barrier(xbar, TID()); }
    for (int rp_ = 0; rp_ < (PROBE_REP == 22 ? 2 : 1); ++rp_)
    if (IN(2)) {
        const int tid = TID();
        pg8::TileOrder S; S.init(M_P, 4096, gridDim.x, blockIdx.x, 1, 2); S.khalf_pn = 8;
        if (!COOP) { pg8::Unit u; int lastpm = -1; for (int i = 0; S.next(i, u); ++i) if (u.pm != lastpm) { lora_a_panel(a, u.pm, tid); lastpm = u.pm; } VM_WAIT(); __syncthreads(); }
        { pg8::Gemm g{(const bf16_t*)(ws + WS_AL), (const bf16_t*)(ws + WS_WLT), 256, 256, 4, 4, 4};
          pg8::EpiLora E{(bf16_t*)(ws + WS_DW), (bf16_t*)(ws + WS_AA), a.in[8], a.in[10]};
          pg8::gemm_phase<pg8::EpiLora, true, true>(lds, g, S, E, tid); }
    }
    SEAM(2);
    const bool full3 = ((int)gridDim.x == 256);
    for (int rp_ = 0; rp_ < (PROBE_REP == 3 ? 2 : 1); ++rp_)
    if (IN(3)) {
        const int tid = TID();
        if (!full3) for (int u = blockIdx.x; u < 256 + 512; u += gridDim.x) { if (u < 256) att::unit_prompt(a, lds, u, tid); else att::unit_sample(a, lds, u - 256, tid); }
        for (int r12 = 0; r12 < (PROBE_REP == 12 ? 2 : 1); ++r12)
        { const int wv = tid >> 6, NW = (int)gridDim.x * 8, gw = (int)blockIdx.x * 8 + wv; int tp = gw, tsm = gw;
          for (int i = gw % 5; ; ++i) { if (i >= 5) i -= 5;
              const bool hp = tp < 128 * cscan::NCH, hs = tsm < NB_S * NH; if (!hp && !hs) break;
              if (hs && (i == 4 || !hp)) { cscan::chunk_pre<true>(a, lds + wv * cscan::A_WAVE, tsm, tid & 63); tsm += NW; }
              else { const int task_ = ((((tp >> 12) * 32 + (tp & 31)) << 7) | ((tp >> 5) & 127));
                  cscan::chunk_pre<false>(a, lds + wv * cscan::A_WAVE, task_, tid & 63); tp += NW; } } }
        __syncthreads();
    }
    if (COOP && IN(3)) { xcd_barrier(xbar, TID()); }
    if (IN(3)) {
        const int tid = TID();
        if (full3) {
            if (blockIdx.x < 128) { for (int r13 = 0; r13 < (PROBE_REP == 13 ? 2 : 1); ++r13) cscan::chunk_scan(a, lds, tid, blockIdx.x);
                for (int u = (int)blockIdx.x; u < 384; u += 128) att::unit_sample(a, lds, u, tid); }
            else { const int j = (int)blockIdx.x - 128; for (int r10 = 0; r10 < (PROBE_REP == 10 ? 2 : 1); ++r10) { att::unit_prompt(a, lds, j, tid); att::unit_prompt(a, lds, j + 128, tid); att::unit_sample(a, lds, 384 + j, tid); } }
        } else {
            for (int p = blockIdx.x; p < 128; p += gridDim.x) cscan::chunk_scan(a, lds, tid, p);
        }
    }
    SEAM(3);
    for (int rp_ = 0; rp_ < (PROBE_REP == 4 ? 2 : 1); ++rp_)
    if (IN(4)) {
        pg8::Gemm g{(const bf16_t*)(ws + WS_Y), (const bf16_t*)(ws + WS_W2T), D / 2, D / 2, 16, 0, 32}; pg8::TileOrder S; S.init(M, D, gridDim.x, blockIdx.x, 2, 16, true, 0);
        pg8::EpiMix E{ws + WS_G, ws + WS_MIX};
        pg8::gemm_phase<pg8::EpiMix, true, true, true>(lds, g, S, E, TID());
        pg8::TileOrder S2; S2.init(M, D, gridDim.x, blockIdx.x, 2, 16, true, 1);
        pg8::EpiMixTail E2{ws + WS_G, ws + WS_MIX, pg8::TailCtx{(float*)(ws + WS_CB), (unsigned*)(ws + WS_TCNT), (volatile LAS unsigned*)(lds + LDS_MISC + 16)}};
        pg8::gemm_phase<pg8::EpiMixTail, true, true, true>(lds, g, S2, E2, TID());
    }
    SEAM(4);
    for (int rp_ = 0; rp_ < (PROBE_REP == 5 ? 2 : 1); ++rp_)
    if (IN(5)) {
        pg8::Gemm g{(const bf16_t*)(ws + WS_MIX), (const bf16_t*)(ws + WS_W3T), D / 2, D / 2, 32, 0, 32}; pg8::TileOrder S; S.init(M, D, gridDim.x, blockIdx.x, 1, 32, true, 0);
        pg8::EpiH E{a.in[0], a.in[1], (bf16_t*)(ws + WS_Y)};
        pg8::gemm_phase<pg8::EpiH, true, true, true>(lds, g, S, E, TID());
        pg8::TileOrder S2; S2.init(M, D, gridDim.x, blockIdx.x, 1, 32, true, 1);
        pg8::EpiHTail E2{a.in[0], a.in[1], (bf16_t*)(ws + WS_Y), pg8::TailCtx{(float*)(ws + WS_CB) + (size_t)64 * 4 * 65536, (unsigned*)(ws + WS_TCNT) + 1024, (volatile LAS unsigned*)(lds + LDS_MISC + 16)}};
        pg8::gemm_phase<pg8::EpiHTail, true, true, true>(lds, g, S2, E2, TID());
    }
    SEAM(5);
    if (IN(6)) { phase_ln(a, TID()); }
#undef IN
#undef SEAM
#undef TID
}

extern "C" void kernel_launch(void* const* d_in, const int* in_sizes, int n_in, void* d_out, int out_size, void* d_ws, size_t ws_size, hipStream_t stream) {
    static int grid = 0;
    if (grid == 0) {
        if (n_in != 23 || out_size != (int)O_END || ws_size < WS_END) { fprintf(stderr, "kernel_launch: unexpected shapes: n_in %d out %d ws %zu (need %zu)\n", n_in, out_size, ws_size, (size_t)WS_END); grid = -1; return; }
        int dev = 0, cus = 0, per_cu = 0;
        if (hipGetDevice(&dev) != hipSuccess || hipDeviceGetAttribute(&cus, hipDeviceAttributeMultiprocessorCount, dev) != hipSuccess) { grid = -1; return; }
        if (hipFuncSetAttribute((const void*)fwd_kernel<(MK_FUSED != 0)>, hipFuncAttributeMaxDynamicSharedMemorySize, LDS_BYTES) != hipSuccess) { fprintf(stderr, "kernel_launch: hipFuncSetAttribute failed\n"); grid = -1; return; }
        if (hipOccupancyMaxActiveBlocksPerMultiprocessor(&per_cu, (const void*)fwd_kernel<(MK_FUSED != 0)>, NTHREADS, LDS_BYTES) != hipSuccess || per_cu < 1) { fprintf(stderr, "kernel_launch: occupancy query says %d\n", per_cu); per_cu = 1; }
        (void)hipGetLastError();
        grid = cus;
    }
    if (grid < 0) return;
    Args a{};
    for (int i = 0; i < 23; ++i) a.in[i] = (const float*)d_in[i];
    a.out = (float*)d_out; a.ws = (unsigned char*)d_ws;
#if MK_FUSED
    a.ph_lo = 0; a.ph_hi = 7;
    if (hipMemsetAsync(d_ws, 0, 65536, stream) != hipSuccess) { fprintf(stderr, "kernel_launch: hipMemsetAsync of the control words failed\n"); return; }
    void* args[] = {&a};
    hipError_t e = hipLaunchCooperativeKernel((const void*)fwd_kernel<true>, dim3(grid), dim3(NTHREADS), args, LDS_BYTES, stream);
    if (e != hipSuccess) fprintf(stderr, "cooperative launch failed: %s (grid %d)\n", hipGetErrorString(e), grid);
#else
    for (int p = 0; p < 7; ++p) { a.ph_lo = p; a.ph_hi = p + 1; hipLaunchKernelGGL(fwd_kernel<false>, dim3(grid), dim3(NTHREADS), LDS_BYTES, stream, a); }
#endif
}
```

```cpp
#include <hip/hip_runtime.h>
#include <hip/hip_cooperative_groups.h>
#include <cstdio>
#include <cstdint>
namespace cg = cooperative_groups;

#ifndef MK_FUSED
#define MK_FUSED 1
#endif

#ifndef PROBE_REP
#define PROBE_REP -1
#endif
#define LAS __attribute__((address_space(3)))
typedef unsigned short bf16_t;
typedef short bf16x8 __attribute__((ext_vector_type(8)));
typedef short s16x4 __attribute__((ext_vector_type(4)));
typedef float f32x4 __attribute__((ext_vector_type(4)));
typedef float f32x2 __attribute__((ext_vector_type(2)));
typedef unsigned u32x4 __attribute__((ext_vector_type(4)));
typedef unsigned u32x2 __attribute__((ext_vector_type(2)));

constexpr int D = 4096, M_P = 8192, M_S = 1024, M = M_P + M_S;
constexpr int TP = 2048, TS = 8, NB_S = 128, NB_P = 4;
constexpr int NZ = 21248, LDZ = 13056;
constexpr int RW = 2048, SHIFT_W = 6400, NH = 32, HS = 64;
constexpr int N_BF = 4864, N_BFX = 2048, N_F8 = 16384, M_X = 256;
constexpr int OFF_WD = 6144, OFF_GR = 6400, OFF_Q = 8448, OFF_K = 10496, OFF_V = 10752, OFF_GA = 11008, OFF_MR = 13056, OFF_MA = 17152;
constexpr float ALPHA = 1.189207115002721f;
constexpr float LN_EPS = 1e-5f, GN_EPS = 64e-5f;
constexpr size_t O_Y = 0, O_WKVP = 37748736, O_SHP = 38273024, O_WKP = 38298624, O_WVP = 38429696, O_WKVS = 38560768, O_SHS = 55337984, O_WKS = 56157184, O_WVS = 60351488, O_END = 64545792;
constexpr size_t al1m(size_t x) { return (x + ((1u << 20) - 1)) & ~(size_t)((1u << 20) - 1); }
constexpr size_t WS_BAR = 0;
constexpr size_t WS_TCNT = 32768;
constexpr size_t WS_ROPE = 1u << 20;
constexpr size_t WS_XB = 2u << 20;
constexpr size_t WS_W1T = al1m(WS_XB + (size_t)(M + M_X) * D * 2);
constexpr size_t WS_W2T = al1m(WS_W1T + (size_t)NZ * D * 2);
constexpr size_t WS_W3T = al1m(WS_W2T + (size_t)D * D * 2);
constexpr size_t WS_WLT = al1m(WS_W3T + (size_t)D * D * 2);
constexpr size_t WS_Z = al1m(WS_WLT + (size_t)4096 * 256 * 2);
constexpr size_t WS_AL = al1m(WS_Z + (size_t)(M + M_X) * LDZ * 2);
constexpr size_t WS_DW = al1m(WS_AL + (size_t)M * 256 * 2);
constexpr size_t WS_AA = al1m(WS_DW + (size_t)M * 2048 * 4);
constexpr size_t WS_Y = al1m(WS_AA + (size_t)M * 2048 * 4);
constexpr size_t WS_MIX = al1m(WS_Y + (size_t)M * D * 2);
constexpr size_t WS_CB = al1m(WS_MIX + (size_t)M * D * 2);
constexpr size_t WS_XB8 = al1m(WS_CB + (size_t)16384 * 14336);
constexpr size_t WS_W8T = al1m(WS_XB8 + (size_t)M * D);
constexpr size_t WS_G = al1m(WS_W8T + (size_t)N_F8 * D);
constexpr size_t GTILE = 131072;
constexpr size_t WS_END = al1m(WS_G + (size_t)(M / 256) * 32 * GTILE);

constexpr int LDS_BYTES = 147456;
constexpr int NTHREADS = 512;
constexpr int LDS_MISC = 131072;

typedef __bf16 bf16x2_t __attribute__((ext_vector_type(2)));
__device__ __forceinline__ unsigned pk2(float lo, float hi) { const f32x2 v = {lo, hi}; return __builtin_bit_cast(unsigned, __builtin_convertvector(v, bf16x2_t)); }
__device__ __forceinline__ unsigned f2bf(float f) { return pk2(f, 0.f) & 0xffffu; }
__device__ __forceinline__ unsigned pk4_fp8(float a, float b, float c, float d) { int p = __builtin_amdgcn_cvt_pk_fp8_f32(a, b, 0, false); p = __builtin_amdgcn_cvt_pk_fp8_f32(c, d, p, true); return (unsigned)p; }
__device__ __forceinline__ float frcp(float x) { return __builtin_amdgcn_rcpf(x); }
__device__ __forceinline__ float bf2f(unsigned short b) { return __builtin_bit_cast(float, ((unsigned)b) << 16); }
__device__ __forceinline__ float bfs2f(short b) { return __builtin_bit_cast(float, ((unsigned)(unsigned short)b) << 16); }
__device__ __forceinline__ float wave_sum(float v) {
#pragma unroll
    for (int o = 1; o < 64; o <<= 1) v += __shfl_xor(v, o);
    return v;
}
__device__ __forceinline__ float sigmoidf_(float x) { return frcp(1.0f + __expf(-x)); }
__device__ __forceinline__ int lane_id_opaque() { int l; asm volatile("v_mbcnt_lo_u32_b32 %0, -1, 0\n\tv_mbcnt_hi_u32_b32 %0, -1, %0" : "=v"(l)); return l; }
#define LDS_WAIT() asm volatile("s_waitcnt lgkmcnt(0)" ::: "memory")
#define VM_WAIT() asm volatile("s_waitcnt vmcnt(0)" ::: "memory")

namespace pg8 {
constexpr int BM = 256, BK = 64, HALF = 128, HTB = HALF * BK * 2  , STAGE_BYTES = 8 * HTB, NXCD = 8, WGM = 8;
__host__ __device__ __forceinline__ int lds_byte(int r, int c) { const int st = (r >> 4) * 2 + (c >> 5), rr = r & 15, cc = c & 31, ob = rr * 64 + cc * 2; return st * 1024 + (ob ^ (((ob >> 9) & 1) << 5)); }
__host__ __device__ __forceinline__ void stage_rc(int b, int& R, int& C) { const int st = b / 1024, sb = b % 1024, swz = sb ^ (((sb >> 9) & 1) << 5); R = (st >> 1) * 16 + swz / 64; C = (st & 1) * 32 + (swz % 64) / 2; }
__host__ __device__ __forceinline__ int perm32(int rho) { const int n = rho >> 4, i = rho & 15; return 8 * (i >> 2) + 4 * n + (i & 3); }

struct Unit { int pm, pn, kt0, mode, nt, tt; };
struct Gemm { const bf16_t* A; const bf16_t* Bt; int lda, ldb, nt, ablk, bblk; };

struct TileOrder {
    int nM, nN, nwg, G, c, halves, nth, nfull, part;
    int khalf_pn;
    int nextra, ex_pm, ex_pn0;
    int gA, tA, nBt;
    __device__ __forceinline__ void init(int M_, int N_, int G_, int c_, int halves_, int nth_, bool split_tail = false, int part_ = 0) { part = part_; gA = 0; tA = 0; nBt = 0; nextra = 0; ex_pm = 0; ex_pn0 = 0; khalf_pn = 0; nM = M_ / BM; nN = N_ / BM; nwg = nM * nN; G = G_; c = c_; halves = halves_; nth = nth_;
        nfull = (split_tail && G == 256 && (nwg % 256) == 64) ? nwg - 64 : nwg; }
    __device__ __forceinline__ void tile(long L, Unit& u) const {
        int wgid = (int)L; { const int q = nwg / NXCD, r = nwg % NXCD, xcd = wgid % NXCD, off = wgid / NXCD; wgid = (xcd < r ? xcd * (q + 1) : r * (q + 1) + (xcd - r) * q) + off; }
        const int nig = WGM * nN, gid = wgid / nig, fm = gid * WGM, gsz = (nM - fm) < WGM ? (nM - fm) : WGM;
        u.pm = fm + ((wgid % nig) % gsz); u.pn = (wgid % nig) / gsz; }
    __device__ __forceinline__ bool next(int i, Unit& u) const {
        const int ti = (halves == 2) ? (i >> 1) : i, hf = (halves == 2) ? (i & 1) : 0;
        if (gA > 0) { int L2; if (c >= gA) { L2 = i * (G - gA) + (c - gA); if (L2 >= nBt) return false; } else { if (i >= tA) return false; L2 = nBt + i * gA + c; }
            tile(L2, u); u.kt0 = 0; u.mode = 2; u.nt = nth; u.tt = 0; return true; }
        const int L = ti * G + c;
        if (part == 0) { if (L >= nfull + nextra) return false; if (L >= nfull) { u.pm = ex_pm; u.pn = ex_pn0 + (L - nfull); } else tile(L, u); u.kt0 = hf * nth + ((khalf_pn > 0 && u.pn >= khalf_pn) ? nth : 0); u.mode = (halves == 2) ? hf : 2; u.nt = nth; u.tt = 0; return true; }
        if (nfull == nwg || i != 0) return false;
        const int xcd = c & 7, j = c >> 3, q = j & 3; u.tt = xcd + 8 * (j >> 2);
        tile((long)nfull + u.tt, u); u.nt = (halves * nth) / 4; u.kt0 = q * u.nt; u.mode = 4 + q; return true;
    }
};

struct TailCtx { float* slabs; unsigned* cnt; volatile LAS unsigned* flag; };
__device__ __forceinline__ void tail_exchange(f32x4 (&acc)[2][2][4][2], const Unit& u, const TailCtx& T, int wid, int lane) {
    const int q = u.mode - 4;
    float* base = T.slabs + (size_t)u.tt * 4 * 65536 + (size_t)(wid * 32) * 256 + lane * 4;
    { float* my = base + (size_t)q * 65536;
#pragma unroll
      for (int ai = 0; ai < 2; ++ai)
#pragma unroll
        for (int bj = 0; bj < 2; ++bj) if (ai * 2 + bj != q) {
#pragma unroll
            for (int m = 0; m < 4; ++m)
#pragma unroll
                for (int n = 0; n < 2; ++n) *(f32x4*)(my + (((ai * 2 + bj) * 4 + m) * 2 + n) * 256) = acc[ai][bj][m][n]; } }
    asm volatile("s_waitcnt vmcnt(0)" ::: "memory");
    __builtin_amdgcn_s_barrier();
    if (wid == 0 && lane == 0) {
        __builtin_amdgcn_fence(__ATOMIC_RELEASE, "agent");
        asm volatile("s_waitcnt vmcnt(0)" ::: "memory");
        (void)__hip_atomic_fetch_add(T.cnt + 16 * u.tt, 1u, __ATOMIC_RELAXED, __HIP_MEMORY_SCOPE_AGENT);
        unsigned sp = 0;
        while (__hip_atomic_load(T.cnt + 16 * u.tt, __ATOMIC_RELAXED, __HIP_MEMORY_SCOPE_AGENT) < 4u) { __builtin_amdgcn_s_sleep(2); if (++sp > (1u << 22)) break; }
        __builtin_amdgcn_fence(__ATOMIC_ACQUIRE, "agent");
        asm volatile("s_waitcnt vmcnt(0)" ::: "memory");
    }
    asm volatile("s_waitcnt vmcnt(0) lgkmcnt(0)" ::: "memory");
    __builtin_amdgcn_s_barrier();
    asm volatile("" ::: "memory");
#pragma unroll
    for (int ai = 0; ai < 2; ++ai)
#pragma unroll
        for (int bj = 0; bj < 2; ++bj) if (ai * 2 + bj == q) {
            f32x4 tv[3][4][2];
#pragma unroll
            for (int o = 0; o < 3; ++o) { const int qq = (q + 1 + o) & 3; const float* ot = base + (size_t)qq * 65536;
#pragma unroll
                for (int m = 0; m < 4; ++m)
#pragma unroll
                    for (int n = 0; n < 2; ++n) tv[o][m][n] = *(const f32x4*)(ot + (((ai * 2 + bj) * 4 + m) * 2 + n) * 256); }
#pragma unroll
            for (int m = 0; m < 4; ++m)
#pragma unroll
                for (int n = 0; n < 2; ++n) acc[ai][bj][m][n] += (tv[0][m][n] + tv[1][m][n]) + tv[2][m][n];
        }
}

__device__ __forceinline__ unsigned cvt_pk_bf16(float lo, float hi) { unsigned r; asm volatile("v_cvt_pk_bf16_f32 %0, %1, %2" : "=v"(r) : "v"(lo), "v"(hi)); return r; }

typedef int i32x4_t __attribute__((ext_vector_type(4))); typedef int i32x8_t __attribute__((ext_vector_type(8)));
__device__ __forceinline__ i32x8_t cat8(bf16x8 lo, bf16x8 hi) { return __builtin_shufflevector(__builtin_bit_cast(i32x4_t, lo), __builtin_bit_cast(i32x4_t, hi), 0, 1, 2, 3, 4, 5, 6, 7); }
template <class Epi, bool ALIGN_EPI, bool SP2, bool F8 = false>
__device__ __forceinline__ void gemm_phase(LAS unsigned char* lds, const Gemm g, const TileOrder& S, const Epi& E, const int tid) {
    const int wid = __builtin_amdgcn_readfirstlane(tid >> 6), lane = tid & 63, wr = wid >> 2, wc = wid & 3, fr = lane & 15, fq = lane >> 4;
    unsigned voffA[2], voffB[2];
#pragma unroll
    for (int i = 0; i < 2; ++i) { int R, C; stage_rc(tid * 16 + i * 8192, R, C); const int Rb = Epi::PERM ? ((R & ~31) + perm32(R & 31)) : R;
        voffA[i] = g.ablk ? (unsigned)(tid * 16 + i * 8192) : (unsigned)(R * g.lda + C) * 2u; voffB[i] = g.bblk ? (unsigned)(tid * 16 + i * 8192) : (unsigned)(Rb * g.ldb + C) * 2u; }
    const size_t kstepA = g.ablk ? (size_t)HTB : (size_t)(BK * 2), kstepB = g.bblk ? (size_t)HTB : (size_t)(BK * 2);
    const size_t hstepA = g.ablk ? (size_t)g.ablk * HTB : (size_t)HALF * g.lda * 2, hstepB = g.bblk ? (size_t)g.bblk * HTB : (size_t)HALF * g.ldb * 2;
    const size_t tstepA = 2 * hstepA, tstepB = 2 * hstepB;
    const unsigned ldsw = (unsigned)wid * 1024u;
    const int aoff = lds_byte(wr * 64 + fr, fq * 8), boff = lds_byte(wc * 32 + fr, fq * 8);
#define PG8_SA(b, h) (((b) * 2 + (h)) * HTB)
#define PG8_SB(b, h) ((4 + (b) * 2 + (h)) * HTB)
#define PG8_STAGE(bufoff, gbase, voff) do { _Pragma("unroll") for (int _i = 0; _i < 2; ++_i) { unsigned vo_ = (voff)[_i]; asm volatile("" : "+v"(vo_));     \
        __builtin_amdgcn_global_load_lds((const unsigned*)((const char*)(gbase) + vo_), (LAS unsigned*)(lds + (bufoff) + ldsw + _i * 8192), 16, 0, 0); } } while (0)
#define PG8_LDA(dst, b, h) do { _Pragma("unroll") for (int m = 0; m < 4; ++m) { const i32x4_t l0_ = *(const LAS i32x4_t*)(lds + PG8_SA(b, h) + aoff + m * 2048), l1_ = *(const LAS i32x4_t*)(lds + PG8_SA(b, h) + aoff + m * 2048 + 1024); \
        dst[m] = __builtin_shufflevector(l0_, l1_, 0, 1, 2, 3, 4, 5, 6, 7); } } while (0)
#define PG8_LDB(dst, b, h) do { _Pragma("unroll") for (int n = 0; n < 2; ++n) { const i32x4_t l0_ = *(const LAS i32x4_t*)(lds + PG8_SB(b, h) + boff + n * 2048), l1_ = *(const LAS i32x4_t*)(lds + PG8_SB(b, h) + boff + n * 2048 + 1024); \
        dst[n] = __builtin_shufflevector(l0_, l1_, 0, 1, 2, 3, 4, 5, 6, 7); } } while (0)
#define PG8_H(x, k) __builtin_bit_cast(bf16x8, __builtin_shufflevector(x, x, 4 * (k), 4 * (k) + 1, 4 * (k) + 2, 4 * (k) + 3))
#define PG8_MMA(ai, bj, At, Bt) do { __builtin_amdgcn_s_setprio(1); _Pragma("unroll") for (int m = 0; m < 4; ++m) _Pragma("unroll") for (int n = 0; n < 2; ++n) { \
        if constexpr (F8) acc[ai][bj][m][n] = __builtin_amdgcn_mfma_scale_f32_16x16x128_f8f6f4(Bt[n], At[m], acc[ai][bj][m][n], 0, 0, 0, 0x7F7F7F7F, 0, 0x7F7F7F7F); \
        else { acc[ai][bj][m][n] = __builtin_amdgcn_mfma_f32_16x16x32_bf16(PG8_H(Bt[n], 0), PG8_H(At[m], 0), acc[ai][bj][m][n], 0, 0, 0); \
               acc[ai][bj][m][n] = __builtin_amdgcn_mfma_f32_16x16x32_bf16(PG8_H(Bt[n], 1), PG8_H(At[m], 1), acc[ai][bj][m][n], 0, 0, 0); } } \
        __builtin_amdgcn_s_setprio(0); } while (0)
#define PG8_WAIT_V(n) asm volatile("s_waitcnt vmcnt(" #n ")" ::: "memory")
#define PG8_WAIT_L(n) asm volatile("s_waitcnt lgkmcnt(" #n ")" ::: "memory")
#define PG8_BAR __builtin_amdgcn_s_barrier()
#define PG8_SCHED __builtin_amdgcn_sched_barrier(0)
    Unit cur, nxt; int ui = 0;
    if (!S.next(0, cur)) return;
    f32x4 acc[2][2][4][2];
#pragma unroll
    for (int a = 0; a < 2; ++a)
#pragma unroll
        for (int b = 0; b < 2; ++b)
#pragma unroll
            for (int m = 0; m < 4; ++m)
#pragma unroll
                for (int n = 0; n < 2; ++n) acc[a][b][m][n] = (f32x4){0.f, 0.f, 0.f, 0.f};
    i32x8_t At[4], B0[2], B1[2];
    const char* cA = (const char*)g.A + (size_t)cur.pm * tstepA + (size_t)cur.kt0 * kstepA; const char* cB = (const char*)g.Bt + (size_t)cur.pn * tstepB + (size_t)cur.kt0 * kstepB;
    if constexpr (SP2) {
        PG8_STAGE(PG8_SB(0, 0), cB, voffB); PG8_STAGE(PG8_SB(0, 1), cB + hstepB, voffB); PG8_STAGE(PG8_SA(0, 0), cA, voffA); PG8_STAGE(PG8_SA(0, 1), cA + hstepA, voffA);
        if (wr == 1) PG8_BAR;
        PG8_WAIT_V(2); PG8_BAR;
        PG8_STAGE(PG8_SB(1, 0), cB + kstepB, voffB); PG8_STAGE(PG8_SA(1, 0), cA + kstepA, voffA); PG8_STAGE(PG8_SB(1, 1), cB + hstepB + kstepB, voffB);
        PG8_WAIT_V(6); PG8_BAR;
    } else {
        PG8_STAGE(PG8_SB(0, 0), cB, voffB); PG8_STAGE(PG8_SA(0, 0), cA, voffA); PG8_STAGE(PG8_SB(0, 1), cB + hstepB, voffB); PG8_STAGE(PG8_SA(0, 1), cA + hstepA, voffA);
        if (wr == 1) PG8_BAR;
        PG8_WAIT_V(4); PG8_BAR;
        PG8_STAGE(PG8_SB(1, 0), cB + kstepB, voffB); PG8_STAGE(PG8_SA(1, 0), cA + kstepA, voffA); PG8_STAGE(PG8_SB(1, 1), cB + hstepB + kstepB, voffB);
        PG8_WAIT_V(6); PG8_BAR;
    }
    for (;;) {
        const bool has_next = S.next(ui + 1, nxt);
        const char* nA = has_next ? (const char*)g.A + (size_t)nxt.pm * tstepA + (size_t)nxt.kt0 * kstepA : cA; const char* nB = has_next ? (const char*)g.Bt + (size_t)nxt.pn * tstepB + (size_t)nxt.kt0 * kstepB : cB;
        const int nt = cur.nt;
        for (int t = 0; t < nt; t += 2) {
            const bool last = (t == nt - 2);
            const char* a1 = cA + (size_t)(t + 1) * kstepA;
            const char* a2 = last ? nA : cA + (size_t)(t + 2) * kstepA; const char* b2 = last ? nB : cB + (size_t)(t + 2) * kstepB;
            const char* a3 = a2 + kstepA; const char* b3 = b2 + kstepB;
            if constexpr (SP2) {
            PG8_LDB(B0, 0, 0); PG8_LDB(B1, 0, 1); PG8_SCHED; PG8_LDA(At, 0, 0); PG8_STAGE(PG8_SA(1, 1), a1 + hstepA, voffA);
            PG8_WAIT_V(8); PG8_WAIT_L(0); PG8_BAR; PG8_MMA(0, 0, At, B0); PG8_MMA(0, 1, At, B1); PG8_BAR; PG8_SCHED;
            PG8_LDA(At, 0, 1); PG8_STAGE(PG8_SB(0, 0), b2, voffB); PG8_STAGE(PG8_SB(0, 1), b2 + hstepB, voffB); PG8_STAGE(PG8_SA(0, 0), a2, voffA);
            PG8_WAIT_V(8); PG8_WAIT_L(0); PG8_BAR; PG8_MMA(1, 0, At, B0); PG8_MMA(1, 1, At, B1); PG8_BAR; PG8_SCHED;
            PG8_LDB(B0, 1, 0); PG8_LDB(B1, 1, 1); PG8_SCHED; PG8_LDA(At, 1, 0); PG8_STAGE(PG8_SA(0, 1), a2 + hstepA, voffA);
            PG8_WAIT_V(8); PG8_WAIT_L(0); PG8_BAR; PG8_MMA(0, 0, At, B0); PG8_MMA(0, 1, At, B1); PG8_BAR; PG8_SCHED;
            PG8_LDA(At, 1, 1); PG8_STAGE(PG8_SB(1, 0), b3, voffB); PG8_STAGE(PG8_SB(1, 1), b3 + hstepB, voffB); PG8_STAGE(PG8_SA(1, 0), a3, voffA);
            PG8_WAIT_V(8); PG8_WAIT_L(0); PG8_BAR; PG8_MMA(1, 0, At, B0); PG8_MMA(1, 1, At, B1); PG8_BAR; PG8_SCHED;
            } else {
            PG8_LDB(B0, 0, 0); PG8_SCHED; PG8_LDA(At, 0, 0); PG8_STAGE(PG8_SA(1, 1), a1 + hstepA, voffA);
            PG8_WAIT_L(8); PG8_BAR; PG8_WAIT_L(0); PG8_MMA(0, 0, At, B0); PG8_BAR; PG8_SCHED;
            PG8_LDB(B1, 0, 1); PG8_STAGE(PG8_SB(0, 0), b2, voffB);
            PG8_BAR; PG8_WAIT_L(0); PG8_MMA(0, 1, At, B1); PG8_BAR;
            PG8_LDA(At, 0, 1); PG8_STAGE(PG8_SA(0, 0), a2, voffA);
            PG8_BAR; PG8_WAIT_L(0); PG8_MMA(1, 0, At, B0); PG8_BAR; PG8_SCHED;
            PG8_STAGE(PG8_SB(0, 1), b2 + hstepB, voffB);
            PG8_WAIT_V(6); PG8_BAR; PG8_MMA(1, 1, At, B1); PG8_BAR;
            PG8_LDB(B0, 1, 0); PG8_SCHED; PG8_LDA(At, 1, 0); PG8_STAGE(PG8_SA(0, 1), a2 + hstepA, voffA);
            PG8_WAIT_L(8); PG8_BAR; PG8_WAIT_L(0); PG8_MMA(0, 0, At, B0); PG8_BAR; PG8_SCHED;
            PG8_LDB(B1, 1, 1); PG8_STAGE(PG8_SB(1, 0), b3, voffB);
            PG8_BAR; PG8_WAIT_L(0); PG8_MMA(0, 1, At, B1); PG8_BAR;
            PG8_LDA(At, 1, 1); PG8_STAGE(PG8_SA(1, 0), a3, voffA);
            PG8_BAR; PG8_WAIT_L(0); PG8_MMA(1, 0, At, B0); PG8_BAR; PG8_SCHED;
            PG8_STAGE(PG8_SB(1, 1), b3 + hstepB, voffB);
            PG8_WAIT_V(6); PG8_BAR; PG8_MMA(1, 1, At, B1); PG8_BAR;
            }
        }
        if constexpr (ALIGN_EPI) { if (wr == 0) PG8_BAR; }
        E(acc, cur, wr, wc, fr, fq);
        if (!has_next) break;
        if (cur.mode != 0) {
#pragma unroll
        for (int a = 0; a < 2; ++a)
#pragma unroll
            for (int b = 0; b < 2; ++b)
#pragma unroll
                for (int m = 0; m < 4; ++m)
#pragma unroll
                    for (int n = 0; n < 2; ++n) acc[a][b][m][n] = (f32x4){0.f, 0.f, 0.f, 0.f};
        }
        cur = nxt; cA = nA; cB = nB; ++ui;
        if constexpr (ALIGN_EPI) { if (wr == 1) PG8_BAR; }
    }
    PG8_WAIT_V(0);
    if constexpr (!ALIGN_EPI) { if (wr == 0) PG8_BAR; }
    PG8_BAR;
#undef PG8_SA
#undef PG8_SB
#undef PG8_STAGE
#undef PG8_LDA
#undef PG8_LDB
#undef PG8_MMA
#undef PG8_H
#undef PG8_WAIT_V
#undef PG8_WAIT_L
#undef PG8_BAR
#undef PG8_SCHED
}

struct EpiZ {
    static constexpr bool PERM = true;
    bf16_t* O; int ldc; int split, split2, off0, off1, off2; float sc; unsigned char* G; int gpn0;
    __device__ __forceinline__ void operator()(f32x4 (&acc)[2][2][4][2], const Unit& u, int wr, int wc, int fr, int fq) const {
        if (u.pn >= gpn0) {
            unsigned char* gp = G + ((size_t)u.pm * 32 + (u.pn - gpn0)) * GTILE + (size_t)(wr * 4 + wc) * 16384 + lane_id_opaque() * 16;
#pragma unroll
            for (int ai = 0; ai < 2; ++ai)
#pragma unroll
                for (int m = 0; m < 4; ++m)
#pragma unroll
                    for (int bj = 0; bj < 2; ++bj) { const f32x4 v0 = acc[ai][bj][m][0] * sc, v1 = acc[ai][bj][m][1] * sc;
                        u32x4 w; w.x = cvt_pk_bf16(v0[0], v0[1]); w.y = cvt_pk_bf16(v0[2], v0[3]); w.z = cvt_pk_bf16(v1[0], v1[1]); w.w = cvt_pk_bf16(v1[2], v1[3]);
                        __builtin_nontemporal_store(w, (u32x4*)(gp + ((ai * 4 + m) * 2 + bj) * 1024)); }
            return; }
        const int row0 = u.pm * BM + wr * 64 + fr, col0 = (u.pn < split ? off0 + u.pn * BM : (u.pn < split2 ? off1 + (u.pn - split) * BM : off2 + (u.pn - split2) * BM)) + wc * 32 + 8 * fq;
#pragma unroll
        for (int ai = 0; ai < 2; ++ai)
#pragma unroll
            for (int m = 0; m < 4; ++m) { bf16_t* rowp = O + (size_t)(row0 + ai * HALF + m * 16) * ldc + col0;
#pragma unroll
                for (int bj = 0; bj < 2; ++bj) { const f32x4 v0 = acc[ai][bj][m][0] * sc, v1 = acc[ai][bj][m][1] * sc;
                    u32x4 w; w.x = cvt_pk_bf16(v0[0], v0[1]); w.y = cvt_pk_bf16(v0[2], v0[3]); w.z = cvt_pk_bf16(v1[0], v1[1]); w.w = cvt_pk_bf16(v1[2], v1[3]);
                    __builtin_nontemporal_store(w, (u32x4*)(rowp + bj * HALF)); } }
    }
};
struct EpiLora {
    static constexpr bool PERM = true;
    bf16_t* DW; bf16_t* AA; const float* w0; const float* a0;
    __device__ __forceinline__ void operator()(f32x4 (&acc)[2][2][4][2], const Unit& u, int wr, int wc, int fr, int fq) const {
        const int row0 = u.pm * BM + wr * 64 + fr; const bool isw = u.pn < 8; const int colt = (isw ? u.pn : u.pn - 8) * BM + wc * 32 + 8 * fq;
        bf16_t* outp = isw ? DW : AA; const float* bias = isw ? w0 : a0; const float sc = isw ? -0.6065306597126334f : 1.0f;
        f32x4 bv[2][2];
#pragma unroll
        for (int bj = 0; bj < 2; ++bj)
#pragma unroll
            for (int n = 0; n < 2; ++n) bv[bj][n] = *(const f32x4*)(bias + colt + bj * HALF + 4 * n);
#pragma unroll
        for (int ai = 0; ai < 2; ++ai)
#pragma unroll
            for (int m = 0; m < 4; ++m) { bf16_t* rowp = outp + (size_t)(row0 + ai * HALF + m * 16) * RW + colt;
#pragma unroll
                for (int bj = 0; bj < 2; ++bj) { float o[8];
#pragma unroll
                    for (int n = 0; n < 2; ++n) { const f32x4 x = acc[ai][bj][m][n] + bv[bj][n];
#pragma unroll
                        for (int j = 0; j < 4; ++j) o[4 * n + j] = sc * frcp(1.0f + __expf(-x[j])); }
                    u32x4 w; w.x = cvt_pk_bf16(o[0], o[1]); w.y = cvt_pk_bf16(o[2], o[3]); w.z = cvt_pk_bf16(o[4], o[5]); w.w = cvt_pk_bf16(o[6], o[7]);
                    *(u32x4*)(rowp + bj * HALF) = w; } }
    }
};
struct EpiMix {
    static constexpr bool PERM = true;
    const unsigned char* Z; unsigned char* O;
    __device__ __forceinline__ void operator()(f32x4 (&acc)[2][2][4][2], const Unit& u, int wr, int wc, int fr_, int fq_) const {
        const int l_ = lane_id_opaque(), fr = l_ & 15, fq = l_ >> 4;
        const int row0 = u.pm * BM + wr * 64 + fr, col0 = u.pn * BM + wc * 32 + 8 * fq;
        const unsigned char* Z = this->Z; unsigned char* O = this->O; asm volatile("" : "+s"(Z), "+s"(O));
        const unsigned char* gR = Z + ((size_t)u.pm * 32 + u.pn) * GTILE + (size_t)(wr * 4 + wc) * 16384 + l_ * 16; const unsigned char* gA = gR + 16 * GTILE;
        const bool m0_ = (u.mode == 0);
        bf16x8 gaA[2], grA[2], gaB[2], grB[2];
#define EM_LOAD(GA, GR, it_) do { GA[0] = *(const bf16x8*)(gA + ((it_) * 2) * 1024); GA[1] = *(const bf16x8*)(gA + ((it_) * 2 + 1) * 1024); \
            if (m0_) { GR[0] = *(const bf16x8*)(gR + ((it_) * 2) * 1024); GR[1] = *(const bf16x8*)(gR + ((it_) * 2 + 1) * 1024); } } while (0)
#define EM_FIN(GA, GR, it_) do { const int ai_ = (it_) >> 2, m_ = (it_) & 3; const size_t r_ = (size_t)(row0 + ai_ * HALF + m_ * 16); \
            _Pragma("unroll") for (int bj = 0; bj < 2; ++bj) { \
                if (m0_) { \
                    _Pragma("unroll") for (int n = 0; n < 2; ++n) _Pragma("unroll") for (int j = 0; j < 4; ++j) { \
                        const float ea = __expf(-bfs2f(GA[bj][4 * n + j])), er = __expf(-bfs2f(GR[bj][4 * n + j])); acc[ai_][bj][m_][n][j] *= (1.0f + ea) * frcp(1.0f + er); } \
                } else { float v[8]; \
                    _Pragma("unroll") for (int n = 0; n < 2; ++n) _Pragma("unroll") for (int j = 0; j < 4; ++j) \
                        v[4 * n + j] = acc[ai_][bj][m_][n][j] * (1.0f / 64.0f) * frcp(1.0f + __expf(-bfs2f(GA[bj][4 * n + j]))); \
                    *(u32x2*)(O + r_ * D + col0 + bj * HALF) = (u32x2){pk4_fp8(v[0], v[1], v[2], v[3]), pk4_fp8(v[4], v[5], v[6], v[7])}; } } \
            asm volatile("" ::: "memory"); } while (0)
        EM_LOAD(gaA, grA, 0);
#pragma unroll
        for (int it = 0; it < 8; it += 2) { EM_LOAD(gaB, grB, it + 1); EM_FIN(gaA, grA, it); if (it + 2 < 8) EM_LOAD(gaA, grA, it + 2); EM_FIN(gaB, grB, it + 1); }
#undef EM_LOAD
#undef EM_FIN
    }
};
struct EpiH {
    static constexpr bool PERM = true;
    const float* xp; const float* xs; bf16_t* H;
    __device__ __forceinline__ void operator()(f32x4 (&acc)[2][2][4][2], const Unit& u, int wr, int wc, int fr, int fq, int quad = -1) const {
        const int row0 = u.pm * BM + wr * 64 + fr, col0 = u.pn * BM + wc * 32 + 8 * fq;
#pragma unroll
        for (int ai = 0; ai < 2; ++ai)
#pragma unroll
            for (int m = 0; m < 4; ++m) { if (quad >= 0 && (quad >> 1) != ai) continue;
                const int r = row0 + ai * HALF + m * 16; const float* xr = (r < M_P) ? xp + (size_t)r * D : xs + (size_t)(r - M_P) * D; bf16_t* hr = H + (size_t)r * D;
#pragma unroll
                for (int bj = 0; bj < 2; ++bj) { if (quad >= 0 && (quad & 1) != bj) continue;
                    const int c = col0 + bj * HALF; const f32x4 x0 = __builtin_nontemporal_load((const f32x4*)(xr + c)), x1 = __builtin_nontemporal_load((const f32x4*)(xr + c + 4));
                    const f32x4 v0 = x0 * ALPHA + acc[ai][bj][m][0] * (1.0f / 64.0f), v1 = x1 * ALPHA + acc[ai][bj][m][1] * (1.0f / 64.0f);
                    u32x4 w; w.x = cvt_pk_bf16(v0[0], v0[1]); w.y = cvt_pk_bf16(v0[2], v0[3]); w.z = cvt_pk_bf16(v1[0], v1[1]); w.w = cvt_pk_bf16(v1[2], v1[3]);
                    *(u32x4*)(hr + c) = w; }
                asm volatile("" ::: "memory"); }
    }
};
struct EpiMixTail {
    static constexpr bool PERM = true;
    const unsigned char* Z; unsigned char* O; TailCtx T;
    __device__ __forceinline__ void operator()(f32x4 (&acc)[2][2][4][2], const Unit& u, int wr, int wc, int fr_, int fq_) const {
        const int l_ = lane_id_opaque(), fr = l_ & 15, fq = l_ >> 4;
        const int row0 = u.pm * BM + wr * 64 + fr, col0 = u.pn * BM + wc * 32 + 8 * fq;
        {
            const unsigned char* Zg = this->Z; asm volatile("" : "+s"(Zg));
            const unsigned char* gQ = Zg + ((size_t)u.pm * 32 + ((u.mode < 6) ? 0 : 16) + u.pn) * GTILE + (size_t)(wr * 4 + wc) * 16384 + l_ * 16;
#pragma unroll
            for (int ai = 0; ai < 2; ++ai)
#pragma unroll
                for (int m = 0; m < 4; ++m) {
#pragma unroll
                    for (int bj = 0; bj < 2; ++bj) { const bf16x8 gg = *(const bf16x8*)(gQ + ((ai * 4 + m) * 2 + bj) * 1024);
#pragma unroll
                        for (int n = 0; n < 2; ++n)
#pragma unroll
                            for (int j = 0; j < 4; ++j) acc[ai][bj][m][n][j] *= frcp(1.0f + __expf(-bfs2f(gg[4 * n + j]))); } }
            tail_exchange(acc, u, T, wr * 4 + wc, fq * 16 + fr);
            const int q = u.mode - 4;
#pragma unroll
            for (int ai = 0; ai < 2; ++ai)
#pragma unroll
              for (int bj = 0; bj < 2; ++bj) if (ai * 2 + bj == q) {
#pragma unroll
                for (int m = 0; m < 4; ++m) { const size_t r = (size_t)(row0 + ai * HALF + m * 16);
                    const f32x4 v0 = acc[ai][bj][m][0] * (1.0f / 64.0f), v1 = acc[ai][bj][m][1] * (1.0f / 64.0f);
                    *(u32x2*)(O + r * D + col0 + bj * HALF) = (u32x2){pk4_fp8(v0[0], v0[1], v0[2], v0[3]), pk4_fp8(v1[0], v1[1], v1[2], v1[3])}; } }
            return;
        }
    }
};
struct EpiHTail {
    static constexpr bool PERM = false;
    const float* xp; const float* xs; bf16_t* H; TailCtx T;
    __device__ __forceinline__ void operator()(f32x4 (&acc)[2][2][4][2], const Unit& u, int wr, int wc, int fr_, int fq_) const {
        tail_exchange(acc, u, T, wr * 4 + wc, lane_id_opaque());
        const int l_ = lane_id_opaque();
        EpiH E{xp, xs, H}; E(acc, u, wr, wc, l_ & 15, l_ >> 4, u.mode - 4);
    }
};
}

struct Args { const float* in[23]; float* out; unsigned char* ws; int ph_lo, ph_hi; };

__device__ __forceinline__ void p0_transpose_item_f8(const float* W, int N, int nbs, unsigned char* W8, LAS float* scr, int kb, int nb, int lane, int koff = 0) {
    const int k0 = 64 * kb, n0 = 32 * nb;
    f32x4 wv[8];
#pragma unroll
    for (int i = 0; i < 8; ++i) wv[i] = __builtin_nontemporal_load((const f32x4*)(W + (size_t)(k0 + 8 * i + (lane >> 3)) * N + 32 * nbs + (lane & 7) * 4));
#pragma unroll
    for (int i = 0; i < 8; ++i) { LAS float* d = scr + (8 * i + (lane >> 3)) * 33 + (i >> 2) * 16 + (lane & 7) * 4; d[0] = wv[i][0]; d[1] = wv[i][1]; d[2] = wv[i][2]; d[3] = wv[i][3]; }
    LDS_WAIT();
    const int c2 = lane & 1, n = lane >> 1; const LAS float* sp = scr + (16 * c2) * 33 + n;
    const int ng = n0 + n, nl = ng & 127, x = nl & 31, slot = (nl & ~31) + 16 * ((x >> 2) & 1) + 4 * (x >> 3) + (x & 3); const int kd = koff + k0;
    unsigned char* dst = W8 + ((size_t)(ng >> 7) * 32 + (kd >> 7)) * pg8::HTB;
#pragma unroll
    for (int j = 0; j < 2; ++j) { const LAS float* s2 = sp + (32 * j) * 33 + 16 * j;
        u32x4 o; o.x = pk4_fp8(s2[0 * 33] * 64.f, s2[1 * 33] * 64.f, s2[2 * 33] * 64.f, s2[3 * 33] * 64.f); o.y = pk4_fp8(s2[4 * 33] * 64.f, s2[5 * 33] * 64.f, s2[6 * 33] * 64.f, s2[7 * 33] * 64.f);
        o.z = pk4_fp8(s2[8 * 33] * 64.f, s2[9 * 33] * 64.f, s2[10 * 33] * 64.f, s2[11 * 33] * 64.f); o.w = pk4_fp8(s2[12 * 33] * 64.f, s2[13 * 33] * 64.f, s2[14 * 33] * 64.f, s2[15 * 33] * 64.f);
        const int kbyte = (kd & 127) + 32 * j + 16 * c2;
        *(u32x4*)(dst + pg8::lds_byte(slot, kbyte >> 1)) = o; }
    LDS_WAIT();
}
__device__ __forceinline__ void p0_transpose_item(const float* W, int N, bf16_t* WT, int ldt, int koff, int row_off, LAS float* scr, int kb, int nb, int lane, int ktiles = 0, bool perm = false, int nbs = -1) {
    const int k0 = 32 * kb, n0 = 64 * nb, n0s = 64 * (nbs < 0 ? nb : nbs);
    f32x4 wv[8];
#pragma unroll
    for (int i = 0; i < 8; ++i) wv[i] = __builtin_nontemporal_load((const f32x4*)(W + (size_t)(k0 + 4 * i + (lane >> 4)) * N + n0s + (lane & 15) * 4));
#pragma unroll
    for (int i = 0; i < 8; ++i) { LAS float* d = scr + (4 * i + (lane >> 4)) * 65 + (lane & 15) * 4; d[0] = wv[i][0]; d[1] = wv[i][1]; d[2] = wv[i][2]; d[3] = wv[i][3]; }
    LDS_WAIT();
    const int c = lane & 3;
#pragma unroll
    for (int j = 0; j < 4; ++j) { const int n = (lane >> 2) + 16 * j; const LAS float* sp = scr + (8 * c) * 65 + n;
        u32x4 o; o.x = pk2(sp[0 * 65], sp[1 * 65]); o.y = pk2(sp[2 * 65], sp[3 * 65]); o.z = pk2(sp[4 * 65], sp[5 * 65]); o.w = pk2(sp[6 * 65], sp[7 * 65]);
        const int kg = koff + k0 + 8 * c;
        if (ktiles == 0) *(u32x4*)(WT + (size_t)(row_off + n0 + n) * ldt + kg) = o;
        else { const int ng = row_off + n0 + n, nl = ng & 127, x = nl & 31; const int slot = perm ? ((nl & ~31) + 16 * ((x >> 2) & 1) + 4 * (x >> 3) + (x & 3)) : nl;
            *(u32x4*)((unsigned char*)WT + ((size_t)(ng >> 7) * ktiles + (kg >> 6)) * pg8::HTB + pg8::lds_byte(slot, kg & 63)) = o; } }
    LDS_WAIT();
}

__device__ __forceinline__ void p0_item_load(f32x4 (&wv)[8], const float* W, int N, int row, int col, int shape, int lane) {
    const int rs = shape ? 8 : 4, lr = shape ? (lane >> 3) : (lane >> 4), lc = shape ? (lane & 7) : (lane & 15);
#pragma unroll
    for (int i = 0; i < 8; ++i) wv[i] = __builtin_nontemporal_load((const f32x4*)(W + (size_t)(row + rs * i + lr) * N + col + lc * 4));
}
__device__ __forceinline__ void p0_item_fin_bf16(const f32x4 (&wv)[8], bf16_t* WT, int koff, int row_off, LAS float* scr, int kb, int nb, int lane, int ktiles) {
    const int k0 = 32 * kb, n0 = 64 * nb;
#pragma unroll
    for (int i = 0; i < 8; ++i) { LAS float* d = scr + (4 * i + (lane >> 4)) * 65 + (lane & 15) * 4; d[0] = wv[i][0]; d[1] = wv[i][1]; d[2] = wv[i][2]; d[3] = wv[i][3]; }
    LDS_WAIT();
    const int c = lane & 3;
#pragma unroll
    for (int j = 0; j < 4; ++j) { const int n = (lane >> 2) + 16 * j; const LAS float* sp = scr + (8 * c) * 65 + n;
        u32x4 o; o.x = pk2(sp[0 * 65], sp[1 * 65]); o.y = pk2(sp[2 * 65], sp[3 * 65]); o.z = pk2(sp[4 * 65], sp[5 * 65]); o.w = pk2(sp[6 * 65], sp[7 * 65]);
        const int kg = koff + k0 + 8 * c;
        const int ng = row_off + n0 + n, nl = ng & 127, x = nl & 31; const int slot = (nl & ~31) + 16 * ((x >> 2) & 1) + 4 * (x >> 3) + (x & 3);
        *(u32x4*)((unsigned char*)WT + ((size_t)(ng >> 7) * ktiles + (kg >> 6)) * pg8::HTB + pg8::lds_byte(slot, kg & 63)) = o; }
    LDS_WAIT();
}
__device__ __forceinline__ void p0_item_fin_f8(const f32x4 (&wv)[8], unsigned char* W8, LAS float* scr, int kb, int nb, int lane) {
    const int k0 = 64 * kb, n0 = 32 * nb;
#pragma unroll
    for (int i = 0; i < 8; ++i) { LAS float* d = scr + (8 * i + (lane >> 3)) * 33 + (i >> 2) * 16 + (lane & 7) * 4; d[0] = wv[i][0]; d[1] = wv[i][1]; d[2] = wv[i][2]; d[3] = wv[i][3]; }
    LDS_WAIT();
    const int c2 = lane & 1, n = lane >> 1; const LAS float* sp = scr + (16 * c2) * 33 + n;
    const int ng = n0 + n, nl = ng & 127, x = nl & 31, slot = (nl & ~31) + 16 * ((x >> 2) & 1) + 4 * (x >> 3) + (x & 3);
    unsigned char* dst = W8 + ((size_t)(ng >> 7) * 32 + (k0 >> 7)) * pg8::HTB;
#pragma unroll
    for (int j = 0; j < 2; ++j) { const LAS float* s2 = sp + (32 * j) * 33 + 16 * j;
        u32x4 o; o.x = pk4_fp8(s2[0 * 33] * 64.f, s2[1 * 33] * 64.f, s2[2 * 33] * 64.f, s2[3 * 33] * 64.f); o.y = pk4_fp8(s2[4 * 33] * 64.f, s2[5 * 33] * 64.f, s2[6 * 33] * 64.f, s2[7 * 33] * 64.f);
        o.z = pk4_fp8(s2[8 * 33] * 64.f, s2[9 * 33] * 64.f, s2[10 * 33] * 64.f, s2[11 * 33] * 64.f); o.w = pk4_fp8(s2[12 * 33] * 64.f, s2[13 * 33] * 64.f, s2[14 * 33] * 64.f, s2[15 * 33] * 64.f);
        const int kbyte = (k0 & 127) + 32 * j + 16 * c2;
        *(u32x4*)(dst + pg8::lds_byte(slot, kbyte >> 1)) = o; }
    LDS_WAIT();
}

__device__ __forceinline__ void phase_convert(const Args& a, LAS unsigned char* lds, const int tid) {
    const int lane = tid & 63, wave = tid >> 6, G = gridDim.x;
    unsigned char* ws = a.ws;
    bf16_t* XB = (bf16_t*)(ws + WS_XB); bf16_t* W1T = (bf16_t*)(ws + WS_W1T); bf16_t* WLT = (bf16_t*)(ws + WS_WLT);
    LAS float* scr = (LAS float*)(lds + wave * 8704);
    const int gw = blockIdx.x * 8 + wave, NGW = G * 8;
    constexpr int I1 = 128 * 332, I5 = 4 * 32, I6 = 4 * 32, NIT = I1 + I5 + I6;
    constexpr int I7 = 128 * 32;
    static_assert(I1 + I5 + I6 == NIT, "items"); constexpr int NIT2 = NIT + I7;
#define P0_LOAD(R, it_) do { int r_ = (it_); const float* W_; int N_, row_, col_, sh_; \
        if (r_ < I1) { const int kb_ = r_ / 332, nb_ = r_ % 332; W_ = a.in[6]; N_ = NZ; \
            if ((nb_ >= 32 && nb_ < 100) || (nb_ >= 164 && nb_ < 172)) { sh_ = 0; row_ = 32 * kb_; col_ = 64 * nb_; } else { sh_ = 1; row_ = 64 * (kb_ >> 1); col_ = 32 * (2 * nb_ + (kb_ & 1)); } } \
        else if (r_ < I1 + I5) { r_ -= I1; W_ = a.in[9]; N_ = RW; sh_ = 0; row_ = 32 * (r_ / 32); col_ = 64 * (r_ % 32); } \
        else if (r_ < NIT) { r_ -= I1 + I5; W_ = a.in[11]; N_ = RW; sh_ = 0; row_ = 32 * (r_ / 32); col_ = 64 * (r_ % 32); } \
        else { r_ -= NIT; W_ = a.in[6]; N_ = NZ; sh_ = 0; row_ = 32 * (r_ / 32); col_ = 64 * (r_ % 32); } \
        p0_item_load(R, W_, N_, row_, col_, sh_, lane); } while (0)
#define P0_FIN(R, it_) do { int r_ = (it_); \
        if (r_ < I1) { const int kb_ = r_ / 332, nb_ = r_ % 332; \
            if (nb_ < 32) p0_item_fin_f8(R, ws + WS_W8T, scr, kb_ >> 1, 2 * nb_ + (kb_ & 1), lane); \
            else if (nb_ < 100) p0_item_fin_bf16(R, W1T, 0, 0, scr, kb_, nb_ - 32, lane, 64); \
            else if (nb_ < 164) p0_item_fin_f8(R, ws + WS_W8T, scr, kb_ >> 1, 2 * (32 + nb_ - 100) + (kb_ & 1), lane); \
            else if (nb_ < 172) p0_item_fin_bf16(R, W1T, 0, 0, scr, kb_, 68 + nb_ - 164, lane, 64); \
            else p0_item_fin_f8(R, ws + WS_W8T, scr, kb_ >> 1, 2 * (96 + nb_ - 172) + (kb_ & 1), lane); } \
        else if (r_ < I1 + I5) { r_ -= I1; p0_item_fin_bf16(R, WLT, 0, 0, scr, r_ / 32, r_ % 32, lane, 4); } \
        else if (r_ < NIT) { r_ -= I1 + I5; p0_item_fin_bf16(R, WLT, 128, 2048, scr, r_ / 32, r_ % 32, lane, 4); } \
        else { r_ -= NIT; p0_item_fin_bf16(R, W1T, 0, 0, scr, r_ / 32, 76 + r_ % 32, lane, 64); } } while (0)
    { f32x4 RA[8], RB[8];
      const int ntrip = (NIT2 - gw + NGW - 1) / NGW;
      { const int i0 = gw, i1 = (gw + NGW < NIT2) ? gw + NGW : NIT2 - 1; P0_LOAD(RA, i0); P0_LOAD(RB, i1); }
      for (int k = 0; k < ntrip; k += 2) {
          const int iA = gw + k * NGW, iB = iA + NGW, nA = (iB + NGW < NIT2) ? iB + NGW : NIT2 - 1, nB = (iB + 2 * NGW < NIT2) ? iB + 2 * NGW : NIT2 - 1;
          P0_FIN(RA, iA); P0_LOAD(RA, nA);
          if (k + 1 < ntrip) P0_FIN(RB, iB);
          P0_LOAD(RB, nB);
      } }
#undef P0_LOAD
#undef P0_FIN
    const size_t gt = (size_t)blockIdx.x * NTHREADS + tid, NGT = (size_t)G * NTHREADS;
    for (size_t i = gt; i < (size_t)4096 * 16; i += NGT) { const int n = (int)(i >> 4), cc = (int)(i & 15); const int kc = (n < 2048 ? 128 : 0) + 8 * cc;
        const int nl = n & 127, x = nl & 31, slot = (nl & ~31) + 16 * ((x >> 2) & 1) + 4 * (x >> 3) + (x & 3);
        *(u32x4*)((unsigned char*)WLT + ((size_t)(n >> 7) * 4 + (kc >> 6)) * pg8::HTB + pg8::lds_byte(slot, kc & 63)) = (u32x4){0u, 0u, 0u, 0u}; }
    for (size_t i = gt; i < (size_t)(M_X - NB_P - NB_S) * (D / 8); i += NGT) { const int rx = M + NB_P + NB_S + (int)(i / (D / 8)), k = (int)(i % (D / 8)) * 8;
        *(u32x4*)((unsigned char*)XB + ((size_t)(rx >> 7) * (D / 64) + (k >> 6)) * pg8::HTB + pg8::lds_byte(rx & 127, k & 63)) = (u32x4){0u, 0u, 0u, 0u}; }
    const float* xp = a.in[0]; const float* xs = a.in[1]; unsigned char* XB8 = ws + WS_XB8;
    for (int it0 = gw; it0 < (M / 16) * (D / 64); it0 += 2 * NGW) {
        f32x4 v[2][4];
#pragma unroll
        for (int u = 0; u < 2; ++u) { const int it = it0 + u * NGW; if (it < (M / 16) * (D / 64)) {
            const int rt = it / (D / 64), ct = it % (D / 64); const int row0 = rt * 16 + (lane >> 4), k = ct * 64 + (lane & 15) * 4;
            const float* src = (row0 < M_P) ? xp + (size_t)row0 * D + k : xs + (size_t)(row0 - M_P) * D + k;
#pragma unroll
            for (int i = 0; i < 4; ++i) v[u][i] = __builtin_nontemporal_load((const f32x4*)(src + (size_t)(4 * i) * D)); } }
#pragma unroll
        for (int u = 0; u < 2; ++u) { const int it = it0 + u * NGW; if (it < (M / 16) * (D / 64)) {
            const int rt = it / (D / 64), ct = it % (D / 64); const int k = ct * 64 + (lane & 15) * 4;
#pragma unroll
            for (int i = 0; i < 4; ++i) { const int row = rt * 16 + 4 * i + (lane >> 4);
                const u32x2 ob = (u32x2){pk2(v[u][i][0], v[u][i][1]), pk2(v[u][i][2], v[u][i][3])}; const unsigned o8 = pk4_fp8(v[u][i][0], v[u][i][1], v[u][i][2], v[u][i][3]);
                *(u32x2*)((unsigned char*)XB + ((size_t)(row >> 7) * (D / 64) + (k >> 6)) * pg8::HTB + pg8::lds_byte(row & 127, k & 63)) = ob;
                { const bool lastp = (row < M_P) && ((row & (TP - 1)) == TP - 1), lasts = (row >= M_P) && (((row - M_P) & (TS - 1)) == TS - 1);
                  if (lastp || lasts) { const int rx = M + (lastp ? (row >> 11) : NB_P + ((row - M_P) >> 3));
                      *(u32x2*)((unsigned char*)XB + ((size_t)(rx >> 7) * (D / 64) + (k >> 6)) * pg8::HTB + pg8::lds_byte(rx & 127, k & 63)) = ob; } }
                *(unsigned*)(XB8 + ((size_t)(row >> 7) * (D / 128) + (k >> 7)) * pg8::HTB + pg8::lds_byte(row & 127, (k & 127) >> 1)) = o8; } } }
    }
    f32x2* rope = (f32x2*)(ws + WS_ROPE);
    for (size_t i = gt; i < (size_t)2056 * 8; i += NGT) { const int p = (int)(i >> 3), ii = (int)(i & 7); const double pos = (p < 2048) ? (double)p : (double)(8192 + p - 2048);
        const double inv = pow(500000.0, -(double)ii / 8.0), ang = pos * inv; rope[i] = (f32x2){(float)cos(ang), (float)sin(ang)}; }
}

__device__ __forceinline__ void convert_rest(const Args& a, LAS unsigned char* lds, const int tid, int hi, int nh) {
    const int lane = tid & 63, wave = tid >> 6;
    unsigned char* W2T = a.ws + WS_W2T; unsigned char* W3T = a.ws + WS_W3T;
    LAS float* scr = (LAS float*)(lds + wave * 8704);
    constexpr int I2 = 64 * 64, I3 = 64 * 64, I4 = 128 * 64, NITR = I2 + I3 + I4;
#define CR_LOAD(R, it_) do { int r_ = (it_); const int sg_ = __builtin_amdgcn_readfirstlane((r_ >= I2) + (r_ >= I2 + I3)); const float* W_ = (sg_ == 0) ? a.in[18] : ((sg_ == 1) ? a.in[19] : a.in[20]); r_ -= (sg_ == 0) ? 0 : ((sg_ == 1) ? I2 : I2 + I3); \
        const int kb_ = r_ / 64, nb_ = r_ % 64; p0_item_load(R, W_, D, 64 * (kb_ >> 1), 32 * (2 * nb_ + (kb_ & 1)), 1, lane); } while (0)
#define CR_FIN(R, it_) do { int r_ = (it_); const int sg_ = __builtin_amdgcn_readfirstlane((r_ >= I2) + (r_ >= I2 + I3)); unsigned char* W8_ = (sg_ == 2) ? W3T : W2T; const int kadd_ = (sg_ == 1) ? 32 : 0; r_ -= (sg_ == 0) ? 0 : ((sg_ == 1) ? I2 : I2 + I3); \
        const int kb_ = r_ / 64, nb_ = r_ % 64; p0_item_fin_f8(R, W8_, scr, (kb_ >> 1) + kadd_, 2 * nb_ + (kb_ & 1), lane); } while (0)
    const int first = hi * 8 + wave, stride = nh * 8;
    if (first >= NITR) return;
    f32x4 RA[8], RB[8];
    const int ntrip = (NITR - first + stride - 1) / stride;
    { const int i1 = (first + stride < NITR) ? first + stride : NITR - 1; CR_LOAD(RA, first); CR_LOAD(RB, i1); }
    for (int k = 0; k < ntrip; k += 2) {
        const int iA = first + k * stride, iB = iA + stride, nA = (iB + stride < NITR) ? iB + stride : NITR - 1, nB = (iB + 2 * stride < NITR) ? iB + 2 * stride : NITR - 1;
        CR_FIN(RA, iA); CR_LOAD(RA, nA);
        if (k + 1 < ntrip) CR_FIN(RB, iB);
        CR_LOAD(RB, nB);
    }
#undef CR_LOAD
#undef CR_FIN
}
__device__ __forceinline__ void lora_a_panel(const Args& a, int pm, const int tid, int first_it = -1, int stride = NTHREADS, int n_it = 256 * 32) {
    const bf16_t* Z = (const bf16_t*)(a.ws + WS_Z); bf16_t* AL = (bf16_t*)(a.ws + WS_AL); const float* mu = a.in[7] + OFF_WD; const float* sh = a.in[3];
#pragma unroll 4
    for (int it = (first_it >= 0 ? first_it : tid); it < n_it; it += stride) {
        const int r = (first_it >= 0 ? 0 : pm * 256) + (it >> 5), c = (it & 31) * 8;
        const bf16x8 cur = *(const bf16x8*)(Z + (size_t)r * LDZ + OFF_WD + c);
        const bf16x8 p = *(const bf16x8*)(Z + (size_t)(r > 0 ? r - 1 : 0) * LDZ + OFF_WD + c);
        float pv[8]; bool first;
        if (r < M_P) first = (r & (TP - 1)) == 0; else first = ((r - M_P) & (TS - 1)) == 0;
#pragma unroll
        for (int j = 0; j < 8; ++j) pv[j] = bfs2f(p[j]);
        if (first) {
            if (r >= M_P) { const float* s = sh + (size_t)((r - M_P) >> 3) * SHIFT_W + OFF_WD + c;
#pragma unroll
                for (int j = 0; j < 8; ++j) pv[j] = s[j]; }
            else {
#pragma unroll
                for (int j = 0; j < 8; ++j) pv[j] = 0.f; } }
        float o[8];
        const f32x4 mu0 = *(const f32x4*)(mu + c), mu1 = *(const f32x4*)(mu + c + 4);
#pragma unroll
        for (int j = 0; j < 8; ++j) { const float z = bfs2f(cur[j]); const float x = z + (j < 4 ? mu0[j & 3] : mu1[j & 3]) * (pv[j] - z); o[j] = (c < 128) ? (1.0f - 2.0f * frcp(1.0f + __expf(2.0f * x))) : x; }
        u32x4 w; w.x = pk2(o[0], o[1]); w.y = pk2(o[2], o[3]); w.z = pk2(o[4], o[5]); w.w = pk2(o[6], o[7]);
        *(u32x4*)((unsigned char*)AL + ((size_t)(r >> 7) * 4 + (c >> 6)) * pg8::HTB + pg8::lds_byte(r & 127, c & 63)) = w;
    }
}

__device__ __forceinline__ void lora_sample(const Args& a, const int tid) {
    const int lane = tid & 63, wave = tid >> 6, m = lane & 15, kg = lane >> 4;
    const bf16_t* Z = (const bf16_t*)(a.ws + WS_Z); const unsigned char* WLT = a.ws + WS_WLT; const float* mu = a.in[7] + OFF_WD; const float* sh = a.in[3];
    for (int t = (int)blockIdx.x * 8 + wave; t < (M_S / 16) * 32; t += (int)gridDim.x * 8) {
        const int rb = t >> 5, cb = t & 31; const bool isw = cb < 16; const int kofs = isw ? 0 : 128, cbase = (isw ? cb : cb - 16) * 128;
        const int row = M_P + rb * 16 + m; const bool first = (m & (TS - 1)) == 0;
        bf16x8 af[4];
#pragma unroll
        for (int ks = 0; ks < 4; ++ks) { const int k = kofs + 32 * ks + 8 * kg;
            const bf16x8 cur = *(const bf16x8*)(Z + (size_t)row * LDZ + OFF_WD + k);
            const bf16x8 pb = *(const bf16x8*)(Z + (size_t)(row - 1) * LDZ + OFF_WD + k);
            const float* s = sh + (size_t)((row - M_P) >> 3) * SHIFT_W + OFF_WD + k; const f32x4 s0 = *(const f32x4*)s, s1 = *(const f32x4*)(s + 4);
            const f32x4 mu0 = *(const f32x4*)(mu + k), mu1 = *(const f32x4*)(mu + k + 4);
            float o[8];
#pragma unroll
            for (int j = 0; j < 8; ++j) { const float z = bfs2f(cur[j]); const float pv = first ? (j < 4 ? s0[j & 3] : s1[j & 3]) : bfs2f(pb[j]);
                const float x = z + (j < 4 ? mu0[j & 3] : mu1[j & 3]) * (pv - z); o[j] = isw ? (1.0f - 2.0f * frcp(1.0f + __expf(2.0f * x))) : x; }
            const u32x4 w = (u32x4){pk2(o[0], o[1]), pk2(o[2], o[3]), pk2(o[4], o[5]), pk2(o[6], o[7])}; af[ks] = __builtin_bit_cast(bf16x8, w); }
        bf16_t* outp = (isw ? (bf16_t*)(a.ws + WS_DW) : (bf16_t*)(a.ws + WS_AA)) + (size_t)row * RW + cbase + 4 * kg;
        const float* bias = (isw ? a.in[8] : a.in[10]) + cbase + 4 * kg; const float sc = isw ? -0.6065306597126334f : 1.0f;
#pragma unroll
        for (int nb = 0; nb < 8; ++nb) {
            const int ng = (isw ? 0 : 2048) + cbase + 16 * nb + m, nl = ng & 127, x = nl & 31, slot = (nl & ~31) + 16 * ((x >> 2) & 1) + 4 * (x >> 3) + (x & 3);
            f32x4 acc = (f32x4){0.f, 0.f, 0.f, 0.f};
#pragma unroll
            for (int ks = 0; ks < 4; ++ks) { const int k = kofs + 32 * ks + 8 * kg;
                const bf16x8 bf = *(const bf16x8*)(WLT + ((size_t)(ng >> 7) * 4 + (k >> 6)) * pg8::HTB + pg8::lds_byte(slot, k & 63));
                acc = __builtin_amdgcn_mfma_f32_16x16x32_bf16(bf, af[ks], acc, 0, 0, 0); }
            const f32x4 bv = *(const f32x4*)(bias + 16 * nb);
            float v[4];
#pragma unroll
            for (int j = 0; j < 4; ++j) v[j] = sc * frcp(1.0f + __expf(-(acc[j] + bv[j])));
            *(u32x2*)(outp + 16 * nb) = (u32x2){pk2(v[0], v[1]), pk2(v[2], v[3])}; }
    }
}

namespace att {
constexpr int KT_STRIDE = 144, KT_ROWS = 272, VT_STRIDE = 552;
constexpr int KT_OFF = 0, VT_OFF = KT_ROWS * KT_STRIDE, SC_OFF = VT_OFF + 64 * VT_STRIDE, SC_STRIDE = 68, SC_WAVE = 16 * SC_STRIDE * 4;
static_assert(SC_OFF + 8 * SC_WAVE <= 131072 && VT_OFF % 16 == 0 && SC_OFF % 16 == 0, "attention LDS map");

__device__ __forceinline__ bf16x8 rope8(bf16x8 own, bf16x8 oth, const f32x2* tab, int c) {
    bf16x8 o;
#pragma unroll
    for (int j = 0; j < 8; ++j) { const f32x2 cs = tab[j]; const float x = bfs2f(own[j]), y = bfs2f(oth[j]); const float r = (c == 0) ? x * cs.x - y * cs.y : x * cs.x + y * cs.y; o[j] = (short)f2bf(r); }
    return o;
}

struct QFrag { bf16x8 q0, q1, oth, g0, g1; };
template <class RowFn>
__device__ __forceinline__ void attn_load(QFrag& F, int lane, const RowFn& rf, const bf16_t* Z) {
    const int qi = lane & 15, g = lane >> 4;
    int row, head, qpos2, ridx; rf(qi, row, head, qpos2, ridx);
    const bf16_t* qp = Z + (size_t)row * LDZ + OFF_Q + head * 64;
    F.q0 = *(const bf16x8*)(qp + 8 * g); F.q1 = *(const bf16x8*)(qp + 32 + 8 * g); F.oth = *(const bf16x8*)(qp + 8 * (g ^ 1));
    int row2, head2, d0, d1; rf(lane >> 2, row2, head2, d0, d1);
    const bf16_t* gp = Z + (size_t)row2 * LDZ + OFF_GA + head2 * 64 + (lane & 3) * 16;
    F.g0 = *(const bf16x8*)gp; F.g1 = *(const bf16x8*)(gp + 8);
}
template <class RowFn>
__device__ __forceinline__ void attn_group(const QFrag& F, LAS unsigned char* lds, int wave, int lane, const RowFn& rf, int T0, bool prev_valid, const float* sinks, bf16_t* Y, const f32x2* rope) {
    const int qi = lane & 15, g = lane >> 4;
    int row, head, qpos2, ridx; rf(qi, row, head, qpos2, ridx);
    bf16x8 q0 = F.q0; const bf16x8 q1 = F.q1;
    if (g < 2) q0 = rope8(q0, F.oth, rope + (size_t)ridx * 8, g);
    float s[9][4];
#pragma unroll
    for (int tl = 0; tl < 9; ++tl) {
        const LAS unsigned char* kp = lds + KT_OFF + ((T0 + tl) * 16 + qi) * KT_STRIDE + 16 * g;
        const bf16x8 k0 = *(const LAS bf16x8*)kp, k1 = *(const LAS bf16x8*)(kp + 64);
        f32x4 a = (f32x4){0.f, 0.f, 0.f, 0.f};
        a = __builtin_amdgcn_mfma_f32_16x16x32_bf16(k0, q0, a, 0, 0, 0);
        a = __builtin_amdgcn_mfma_f32_16x16x32_bf16(k1, q1, a, 0, 0, 0);
#pragma unroll
        for (int r = 0; r < 4; ++r) s[tl][r] = a[r];
    }
    const float sink = sinks[head];
    const int dq = (qpos2 & 15) - 4 * g;
    float mx = -1e30f;
#pragma unroll
    for (int tl = 0; tl < 9; ++tl) { const bool tile_ok = prev_valid || (T0 + tl >= 8);
#pragma unroll
        for (int r = 0; r < 4; ++r) { const bool ok = tile_ok && (tl == 0 ? (dq - r < 0) : (tl == 8 ? (dq - r >= 0) : true));
            s[tl][r] = ok ? s[tl][r] : -1e30f; mx = fmaxf(mx, s[tl][r]); } }
    mx = fmaxf(mx, __shfl_xor(mx, 16)); mx = fmaxf(mx, __shfl_xor(mx, 32));
    constexpr float SC = 0.125f * 1.4426950408889634f;
    const float m2 = fmaxf(mx * SC, sink * 1.4426950408889634f);
    float sum = 0.f;
#pragma unroll
    for (int tl = 0; tl < 9; ++tl)
#pragma unroll
        for (int r = 0; r < 4; ++r) { s[tl][r] = __builtin_amdgcn_exp2f(fmaf(s[tl][r], SC, -m2)); sum += s[tl][r]; }
    sum += __shfl_xor(sum, 16); sum += __shfl_xor(sum, 32);
    const float inv = frcp(sum + __builtin_amdgcn_exp2f(sink * 1.4426950408889634f - m2));
    bf16x8 pa[5];
#pragma unroll
    for (int pr = 0; pr < 4; ++pr)
        { u32x4 w_; w_.x = pk2(s[2 * pr][0] * inv, s[2 * pr][1] * inv); w_.y = pk2(s[2 * pr][2] * inv, s[2 * pr][3] * inv); w_.z = pk2(s[2 * pr + 1][0] * inv, s[2 * pr + 1][1] * inv); w_.w = pk2(s[2 * pr + 1][2] * inv, s[2 * pr + 1][3] * inv); pa[pr] = __builtin_bit_cast(bf16x8, w_); }
    { u32x4 w_; w_.x = pk2(s[8][0] * inv, s[8][1] * inv); w_.y = pk2(s[8][2] * inv, s[8][3] * inv); w_.z = 0u; w_.w = 0u; pa[4] = __builtin_bit_cast(bf16x8, w_); }
    f32x4 o[4];
#pragma unroll
    for (int n = 0; n < 4; ++n) { o[n] = (f32x4){0.f, 0.f, 0.f, 0.f};
#pragma unroll
        for (int pr = 0; pr < 5; ++pr) {
            const LAS unsigned char* vp = lds + VT_OFF + (16 * n + qi) * VT_STRIDE + ((T0 + 2 * pr) * 16 + 4 * g) * 2;
            const s16x4 lo = *(const LAS s16x4*)vp, hi = *(const LAS s16x4*)(vp + 32);
            bf16x8 vf; vf[0] = lo[0]; vf[1] = lo[1]; vf[2] = lo[2]; vf[3] = lo[3]; vf[4] = hi[0]; vf[5] = hi[1]; vf[6] = hi[2]; vf[7] = hi[3];
            o[n] = __builtin_amdgcn_mfma_f32_16x16x32_bf16(pa[pr], vf, o[n], 0, 0, 0);
        } }
    LAS float* sc = (LAS float*)(lds + SC_OFF + wave * SC_WAVE);
#pragma unroll
    for (int n = 0; n < 4; ++n)
#pragma unroll
        for (int r = 0; r < 4; ++r) sc[(4 * g + r) * SC_STRIDE + 16 * n + qi] = o[n][r];
    LDS_WAIT();
    const int q = lane >> 2, ch = lane & 3;
    int row2, head2, d0, d1; rf(q, row2, head2, d0, d1);
    const LAS float* sr = sc + q * SC_STRIDE + ch * 16;
    const bf16x8 g0 = F.g0, g1 = F.g1;
    float v[16];
#pragma unroll
    for (int i = 0; i < 4; ++i) { const f32x4 x = *(const LAS f32x4*)(sr + 4 * i); v[4 * i] = x[0]; v[4 * i + 1] = x[1]; v[4 * i + 2] = x[2]; v[4 * i + 3] = x[3]; }
#pragma unroll
    for (int j = 0; j < 8; ++j) { const float ga = bfs2f(g0[j]), gb = bfs2f(g1[j]); v[j] *= ga * frcp(1.0f + __expf(-ga)); v[8 + j] *= gb * frcp(1.0f + __expf(-gb)); }
    *(u32x4*)((unsigned char*)Y + (size_t)row2 * D + 2048 + head2 * 64 + ch * 16) = (u32x4){pk4_fp8(v[0], v[1], v[2], v[3]), pk4_fp8(v[4], v[5], v[6], v[7]), pk4_fp8(v[8], v[9], v[10], v[11]), pk4_fp8(v[12], v[13], v[14], v[15])};
    LDS_WAIT();
}

struct PromptRows { int rowbase, hq, q0, posbase; __device__ __forceinline__ void operator()(int i, int& row, int& head, int& qpos2, int& ridx) const { row = rowbase + q0 + i; head = hq; qpos2 = 128 + q0 + i; ridx = posbase + q0 + i; } };
struct SampleRows { int rowbase, h0; __device__ __forceinline__ void operator()(int i, int& row, int& head, int& qpos2, int& ridx) const { const int t = i & 7; row = rowbase + t; head = h0 + (i >> 3); qpos2 = 128 + t; ridx = 2048 + t; } };

__device__ __forceinline__ void store8f(float* p, bf16x8 v) { f32x4 a, b;
#pragma unroll
    for (int j = 0; j < 4; ++j) { a[j] = bfs2f(v[j]); b[j] = bfs2f(v[4 + j]); } *(f32x4*)p = a; *(f32x4*)(p + 4) = b; }

__device__ __forceinline__ void unit_prompt(const Args& a, LAS unsigned char* lds, int u, const int tid) {
    const int lane = tid & 63, wave = tid >> 6;
    const int kvh = u & 3, nb = (u >> 2) & 15, b = u >> 6;
    const bf16_t* Z = (const bf16_t*)(a.ws + WS_Z); bf16_t* Y = (bf16_t*)(a.ws + WS_Y); const f32x2* rope = (const f32x2*)(a.ws + WS_ROPE);
    float* wk = a.out + O_WKP; float* wv = a.out + O_WVP;
    bf16x8 kvr[5], othr[5], vvr[5];
#pragma unroll
    for (int u5 = 0; u5 < 5; ++u5) { const int it = tid + u5 * NTHREADS, key = it >> 3, c = it & 7;
        kvr[u5] = (bf16x8){0, 0, 0, 0, 0, 0, 0, 0}; othr[u5] = kvr[u5]; vvr[u5] = kvr[u5];
        if (it < KT_ROWS * 8 && key < 256 && (key >= 128 || nb > 0)) {
            const int tok = (nb - 1) * 128 + key; const size_t row = (size_t)b * TP + tok; const bf16_t* kp = Z + row * LDZ + OFF_K + kvh * 64;
            kvr[u5] = *(const bf16x8*)(kp + 8 * c); if (c < 2) othr[u5] = *(const bf16x8*)(kp + 8 * (c ^ 1)); vvr[u5] = *(const bf16x8*)(Z + row * LDZ + OFF_V + kvh * 64 + 8 * c); } }
    PromptRows rf; rf.rowbase = b * TP + nb * 128; rf.hq = kvh * 8 + wave; rf.posbase = nb * 128; rf.q0 = 0;
    QFrag FA, FB; attn_load(FA, lane, rf, Z);
#pragma unroll
    for (int u5 = 0; u5 < 5; ++u5) { const int it = tid + u5 * NTHREADS, key = it >> 3, c = it & 7;
        if (it < KT_ROWS * 8) {
            bf16x8 kv = kvr[u5]; const bf16x8 vv = vvr[u5];
            if (key < 256 && (key >= 128 || nb > 0)) {
                const int tok = (nb - 1) * 128 + key;
                if (c < 2) kv = rope8(kv, othr[u5], rope + (size_t)tok * 8, c);
                if (nb == 15 && key >= 128) { const size_t o = (((size_t)b * 128 + (key - 128)) * 4 + kvh) * 64 + 8 * c; store8f(wk + o, kv); store8f(wv + o, vv); } }
            *(LAS bf16x8*)(lds + KT_OFF + key * KT_STRIDE + 16 * c) = kv;
#pragma unroll
            for (int j = 0; j < 8; ++j) *(LAS short*)(lds + VT_OFF + (8 * c + j) * VT_STRIDE + key * 2) = vv[j]; } }
    __syncthreads();
    for (int grp = 0; grp < 8; grp += 2) {
        rf.q0 = 16 * (grp + 1); attn_load(FB, lane, rf, Z);
        rf.q0 = 16 * grp; attn_group(FA, lds, wave, lane, rf, grp, nb > 0, a.in[17], Y, rope);
        if (grp + 2 < 8) { rf.q0 = 16 * (grp + 2); attn_load(FA, lane, rf, Z); }
        rf.q0 = 16 * (grp + 1); attn_group(FB, lds, wave, lane, rf, grp + 1, nb > 0, a.in[17], Y, rope);
    }
    __syncthreads();
}

__device__ __forceinline__ void unit_sample(const Args& a, LAS unsigned char* lds, int u, const int tid) {
    const int lane = tid & 63, wave = tid >> 6;
    const int kvh = u & 3, b = u >> 2;
    const bf16_t* Z = (const bf16_t*)(a.ws + WS_Z); bf16_t* Y = (bf16_t*)(a.ws + WS_Y); const f32x2* rope = (const f32x2*)(a.ws + WS_ROPE);
    const float* ck = a.in[4]; const float* cv = a.in[5]; float* wk = a.out + O_WKS; float* wv = a.out + O_WVS;
    SampleRows rf; rf.rowbase = M_P + b * TS; rf.h0 = kvh * 8 + 2 * (wave & 3);
    QFrag FA; attn_load(FA, lane, rf, Z);
    f32x4 ck0[3], ck1[3], cv0[3], cv1[3]; bf16x8 nk[3], no[3], nv[3];
#pragma unroll
    for (int u3 = 0; u3 < 3; ++u3) { const int it = tid + u3 * NTHREADS, key = it >> 3, c = it & 7;
        ck0[u3] = (f32x4){0.f, 0.f, 0.f, 0.f}; ck1[u3] = ck0[u3]; cv0[u3] = ck0[u3]; cv1[u3] = ck0[u3]; nk[u3] = (bf16x8){0, 0, 0, 0, 0, 0, 0, 0}; no[u3] = nk[u3]; nv[u3] = nk[u3];
        if (it < 160 * 8) {
            if (key < 128) { const size_t so = (((size_t)b * 128 + key) * 4 + kvh) * 64 + 4 * c;
                ck0[u3] = __builtin_nontemporal_load((const f32x4*)(ck + so)); ck1[u3] = __builtin_nontemporal_load((const f32x4*)(ck + so + 32)); cv0[u3] = __builtin_nontemporal_load((const f32x4*)(cv + so)); cv1[u3] = __builtin_nontemporal_load((const f32x4*)(cv + so + 32)); }
            else if (key < 136) { const size_t row = (size_t)M_P + b * TS + (key - 128); const bf16_t* kp = Z + row * LDZ + OFF_K + kvh * 64;
                nk[u3] = *(const bf16x8*)(kp + 8 * c); if (c < 2) no[u3] = *(const bf16x8*)(kp + 8 * (c ^ 1)); nv[u3] = *(const bf16x8*)(Z + row * LDZ + OFF_V + kvh * 64 + 8 * c); } } }
#pragma unroll
    for (int u3 = 0; u3 < 3; ++u3) { const int it = tid + u3 * NTHREADS, key = it >> 3, c = it & 7;
        if (it < 160 * 8) {
            bf16x8 kv = nk[u3], vv = nv[u3];
            if (key < 128) {
                const f32x4 k0 = ck0[u3], k1 = ck1[u3], v0 = cv0[u3], v1 = cv1[u3];
                { u32x4 w_; w_.x = pk2(k0[0], k0[1]); w_.y = pk2(k0[2], k0[3]); w_.z = pk2(k1[0], k1[1]); w_.w = pk2(k1[2], k1[3]); kv = __builtin_bit_cast(bf16x8, w_);
                  w_.x = pk2(v0[0], v0[1]); w_.y = pk2(v0[2], v0[3]); w_.z = pk2(v1[0], v1[1]); w_.w = pk2(v1[2], v1[3]); vv = __builtin_bit_cast(bf16x8, w_); }
                if (key >= 8) { const size_t o = (((size_t)b * 128 + (key - 8)) * 4 + kvh) * 64 + 4 * c; __builtin_nontemporal_store(k0, (f32x4*)(wk + o)); __builtin_nontemporal_store(k1, (f32x4*)(wk + o + 32)); __builtin_nontemporal_store(v0, (f32x4*)(wv + o)); __builtin_nontemporal_store(v1, (f32x4*)(wv + o + 32)); }
            } else if (key < 136) {
                const int t = key - 128;
                if (c < 2) kv = rope8(kv, no[u3], rope + (size_t)(2048 + t) * 8, c);
                const size_t o = (((size_t)b * 128 + (120 + t)) * 4 + kvh) * 64 + 8 * c; store8f(wk + o, kv); store8f(wv + o, vv);
            }
            if (key < 128) {
                const u32x4 kw = __builtin_bit_cast(u32x4, kv);
                *(LAS u32x2*)(lds + KT_OFF + key * KT_STRIDE + 8 * c) = (u32x2){kw.x, kw.y}; *(LAS u32x2*)(lds + KT_OFF + key * KT_STRIDE + 64 + 8 * c) = (u32x2){kw.z, kw.w};
#pragma unroll
                for (int j = 0; j < 4; ++j) { *(LAS short*)(lds + VT_OFF + (4 * c + j) * VT_STRIDE + key * 2) = vv[j]; *(LAS short*)(lds + VT_OFF + (32 + 4 * c + j) * VT_STRIDE + key * 2) = vv[4 + j]; }
            } else {
                *(LAS bf16x8*)(lds + KT_OFF + key * KT_STRIDE + 16 * c) = kv;
#pragma unroll
                for (int j = 0; j < 8; ++j) *(LAS short*)(lds + VT_OFF + (8 * c + j) * VT_STRIDE + key * 2) = vv[j]; } } }
    __syncthreads();
    if (wave < 4) attn_group(FA, lds, wave, lane, rf, 0, true, a.in[17], Y, rope);
    __syncthreads();
}
}

namespace scan {
constexpr int CT = 32, IN_STRIDE = 1536, IN_BYTES = CT * IN_STRIDE, YB_OFF = 2 * IN_BYTES + 256  , RK_OFF = YB_OFF + CT * 64 * 4, JUNK_OFF = RK_OFF + CT * 4;
static_assert(JUNK_OFF % 16 == 0 && JUNK_OFF + 512 + (CT + 1) * 256 <= 131072, "scan LDS map");
struct Chunk { int row0, nsteps, h, first, last, kind, seq; };
struct Raw { u32x2 zr, zk, zv, pr, pk, pv, g, dw, aa; f32x4 fr, fk, fv, mur, muk, muv, kkc, kac, rkc, gw, gb; };
struct KV { f32x4 w, nk, bb, kh, rr; f32x2 vv; };

__device__ __forceinline__ float red16(float x) {
    x += __builtin_bit_cast(float, __builtin_amdgcn_update_dpp(0, __builtin_bit_cast(int, x), 0xB1, 0xF, 0xF, true));
    x += __builtin_bit_cast(float, __builtin_amdgcn_update_dpp(0, __builtin_bit_cast(int, x), 0x4E, 0xF, 0xF, true));
    x += __builtin_bit_cast(float, __builtin_amdgcn_update_dpp(0, __builtin_bit_cast(int, x), 0x141, 0xF, 0xF, true));
    x += __builtin_bit_cast(float, __builtin_amdgcn_update_dpp(0, __builtin_bit_cast(int, x), 0x140, 0xF, 0xF, true));
    return x;
}
__device__ __forceinline__ void red16x4(float& a, float& b, float& c, float& d) {
    asm volatile("s_nop 1\n\t"
        "v_add_f32_dpp %0, %0, %0 quad_perm:[1,0,3,2] row_mask:0xf bank_mask:0xf bound_ctrl:1\n\t"
        "v_add_f32_dpp %1, %1, %1 quad_perm:[1,0,3,2] row_mask:0xf bank_mask:0xf bound_ctrl:1\n\t"
        "v_add_f32_dpp %2, %2, %2 quad_perm:[1,0,3,2] row_mask:0xf bank_mask:0xf bound_ctrl:1\n\t"
        "v_add_f32_dpp %3, %3, %3 quad_perm:[1,0,3,2] row_mask:0xf bank_mask:0xf bound_ctrl:1\n\t"
        "v_add_f32_dpp %0, %0, %0 quad_perm:[2,3,0,1] row_mask:0xf bank_mask:0xf bound_ctrl:1\n\t"
        "v_add_f32_dpp %1, %1, %1 quad_perm:[2,3,0,1] row_mask:0xf bank_mask:0xf bound_ctrl:1\n\t"
        "v_add_f32_dpp %2, %2, %2 quad_perm:[2,3,0,1] row_mask:0xf bank_mask:0xf bound_ctrl:1\n\t"
        "v_add_f32_dpp %3, %3, %3 quad_perm:[2,3,0,1] row_mask:0xf bank_mask:0xf bound_ctrl:1\n\t"
        "v_add_f32_dpp %0, %0, %0 row_half_mirror row_mask:0xf bank_mask:0xf bound_ctrl:1\n\t"
        "v_add_f32_dpp %1, %1, %1 row_half_mirror row_mask:0xf bank_mask:0xf bound_ctrl:1\n\t"
        "v_add_f32_dpp %2, %2, %2 row_half_mirror row_mask:0xf bank_mask:0xf bound_ctrl:1\n\t"
        "v_add_f32_dpp %3, %3, %3 row_half_mirror row_mask:0xf bank_mask:0xf bound_ctrl:1\n\t"
        "v_add_f32_dpp %0, %0, %0 row_mirror row_mask:0xf bank_mask:0xf bound_ctrl:1\n\t"
        "v_add_f32_dpp %1, %1, %1 row_mirror row_mask:0xf bank_mask:0xf bound_ctrl:1\n\t"
        "v_add_f32_dpp %2, %2, %2 row_mirror row_mask:0xf bank_mask:0xf bound_ctrl:1\n\t"
        "v_add_f32_dpp %3, %3, %3 row_mirror row_mask:0xf bank_mask:0xf bound_ctrl:1\n\t"
        "s_nop 0"
        : "+v"(a), "+v"(b), "+v"(c), "+v"(d));
}
__device__ __forceinline__ float dot4(f32x4 a, f32x4 b) { return (a[0] * b[0] + a[1] * b[1]) + (a[2] * b[2] + a[3] * b[3]); }
__device__ __forceinline__ f32x4 unpack4(u32x2 v) { f32x4 r; r[0] = __builtin_bit_cast(float, v.x << 16); r[1] = __builtin_bit_cast(float, v.x & 0xffff0000u); r[2] = __builtin_bit_cast(float, v.y << 16); r[3] = __builtin_bit_cast(float, v.y & 0xffff0000u); return r; }

__device__ __forceinline__ bool get_chunk(int j, Chunk& C) {
    const int G = (int)gridDim.x, w = (int)blockIdx.x;
    if (G >= 256 && w < 128) return false;
    const int s = (G >= 256) ? (w - 128) + j * (G - 128) : w + j * G;
    if (s >= NB_S * NH) return false;
    C.kind = 1; C.seq = s >> 5; C.h = s & 31; C.row0 = M_P + C.seq * TS; C.nsteps = TS; C.first = 1; C.last = 1; return true;
}

__device__ __forceinline__ void phase_scan(const Args& a, LAS unsigned char* lds, const int tid) {
    const int lane = tid & 63, wave = tid >> 6;
    const bf16_t* Z = (const bf16_t*)(a.ws + WS_Z); const bf16_t* DW = (const bf16_t*)(a.ws + WS_DW); const bf16_t* AA = (const bf16_t*)(a.ws + WS_AA); bf16_t* Y = (bf16_t*)(a.ws + WS_Y);
    const float* mu = a.in[7]; const float* k_k = a.in[12]; const float* k_a = a.in[13]; const float* r_k = a.in[14]; const float* gn_w = a.in[15]; const float* gn_b = a.in[16];
    const int kq = lane & 15, rp = lane >> 4, srow = wave * 8 + rp * 2;
    const int pt = tid >> 4;
    LAS float* ybuf = (LAS float*)(lds + YB_OFF); LAS float* rkbuf = (LAS float*)(lds + RK_OFF);
    const unsigned ya = (kq == 0) ? (unsigned)(YB_OFF + srow * 4) : (unsigned)(JUNK_OFF + 256 + lane * 8);
    Chunk C, CN; Raw R;
    int j = 0;
    if (!get_chunk(0, C)) return;
    f32x4 S0 = (f32x4){0.f, 0.f, 0.f, 0.f}, S1 = S0, N0 = S0, N1 = S0;
    u32x2 gcur = (u32x2){0u, 0u}; f32x4 gwc = S0, gbc = S0;

#define SCAN_PREFETCH(CC) do { if (pt < (CC).nsteps) { const int col = (CC).h * 64 + 4 * kq; const size_t row = (size_t)((CC).row0 + pt); const size_t rprev = row > 0 ? row - 1 : 0; \
            const bf16_t* zp = Z + row * LDZ + col; const bf16_t* pp = Z + rprev * LDZ + col; \
            R.zr = *(const u32x2*)zp; R.zk = *(const u32x2*)(zp + 2048); R.zv = *(const u32x2*)(zp + 4096); R.g = *(const u32x2*)(zp + OFF_GR); \
            R.pr = *(const u32x2*)pp; R.pk = *(const u32x2*)(pp + 2048); R.pv = *(const u32x2*)(pp + 4096); \
            R.dw = *(const u32x2*)(DW + row * RW + col); R.aa = *(const u32x2*)(AA + row * RW + col); \
            R.mur = *(const f32x4*)(mu + col); R.muk = *(const f32x4*)(mu + 2048 + col); R.muv = *(const f32x4*)(mu + 4096 + col); \
            R.kkc = *(const f32x4*)(k_k + col); R.kac = *(const f32x4*)(k_a + col); R.rkc = *(const f32x4*)(r_k + col); R.gw = *(const f32x4*)(gn_w + col); R.gb = *(const f32x4*)(gn_b + col); \
            R.fr = (f32x4){0.f, 0.f, 0.f, 0.f}; R.fk = R.fr; R.fv = R.fr; \
            if ((CC).first && (CC).kind == 1 && pt == 0) { const float* sp = a.in[3] + (size_t)(CC).seq * SHIFT_W + col; R.fr = *(const f32x4*)sp; R.fk = *(const f32x4*)(sp + 2048); R.fv = *(const f32x4*)(sp + 4096); } } } while (0)
#define SCAN_LOADS0(CC, A0, A1) do { if ((CC).kind == 1) { const float* sp = a.in[2] + (((size_t)(CC).seq * NH + (CC).h) * 64 + srow) * 64 + 4 * kq; A0 = *(const f32x4*)sp; A1 = *(const f32x4*)(sp + 64); } \
        else { A0 = (f32x4){0.f, 0.f, 0.f, 0.f}; A1 = A0; } } while (0)
#define SCAN_PROCESS(CC, INB) do { if (pt < (CC).nsteps) { \
            const f32x4 zr = unpack4(R.zr), zk = unpack4(R.zk), zv = unpack4(R.zv); f32x4 pr = unpack4(R.pr), pkk = unpack4(R.pk), pv = unpack4(R.pv); \
            if ((CC).first && pt == 0) { pr = R.fr; pkk = R.fk; pv = R.fv; } \
            const f32x4 xr = zr + R.mur * (pr - zr), xk = zk + R.muk * (pkk - zk), xv = zv + R.muv * (pv - zv); const f32x4 av = unpack4(R.aa), ldv = unpack4(R.dw); \
            const f32x4 kkv = xk * R.kkc; const float ss = red16(dot4(kkv, kkv)); const f32x4 kkn = kkv * __builtin_amdgcn_rsqf(fmaxf(ss, 1e-24f)); \
            const f32x4 kh = xk * ((av - 1.0f) * R.kac + 1.0f); const float rk = red16(dot4(xr * kh, R.rkc)); \
            LAS unsigned char* ib = (INB) + pt * IN_STRIDE + kq * 16; \
            { f32x4 wd_; wd_[0] = __expf(ldv[0]); wd_[1] = __expf(ldv[1]); wd_[2] = __expf(ldv[2]); wd_[3] = __expf(ldv[3]); *(LAS f32x4*)ib = wd_; } *(LAS f32x4*)(ib + 256) = -kkn; *(LAS f32x4*)(ib + 512) = kkn * av; *(LAS f32x4*)(ib + 768) = kh; *(LAS f32x4*)(ib + 1024) = xr; *(LAS f32x4*)(ib + 1280) = xv; \
            if (kq == 0) rkbuf[pt] = rk; gcur = R.g; gwc = R.gw; gbc = R.gb; } } while (0)
#define SCAN_LOADK(K, tt) do { const LAS unsigned char* p_ = ibk + (tt) * IN_STRIDE; K.w = *(const LAS f32x4*)p_; K.nk = *(const LAS f32x4*)(p_ + 256); K.bb = *(const LAS f32x4*)(p_ + 512); \
            K.kh = *(const LAS f32x4*)(p_ + 768); K.rr = *(const LAS f32x4*)(p_ + 1024); K.vv = *(const LAS f32x2*)(vbk + (tt) * IN_STRIDE); } while (0)
#define SCAN_STEP(K, tt) do { float sa0 = dot4(S0, K.nk), sa1 = dot4(S1, K.nk); \
            const f32x4 T0 = S0 * K.w + K.kh * K.vv[0], T1 = S1 * K.w + K.kh * K.vv[1]; \
            red16x4(sa0, sa1, py0, py1); \
            *(LAS f32x2*)(lds + ya + ((tt) - 1) * 256) = (f32x2){py0, py1}; \
            S0 = T0 + K.bb * sa0; S1 = T1 + K.bb * sa1; \
            py0 = dot4(S0, K.rr); py1 = dot4(S1, K.rr); } while (0)

    SCAN_PREFETCH(C);
    SCAN_LOADS0(C, S0, S1);
    SCAN_PROCESS(C, lds);
    __syncthreads();
    for (;;) {
        const bool haveN = get_chunk(j + 1, CN);
        LAS unsigned char* inb = lds + (j & 1) * IN_BYTES;
        if (haveN) { SCAN_PREFETCH(CN); if (CN.first) SCAN_LOADS0(CN, N0, N1); }
        {
            const LAS unsigned char* ibk = inb + kq * 16;
            const LAS unsigned char* vbk = inb + 1280 + srow * 4;
            const int ns = C.nsteps;
            float py0 = 0.f, py1 = 0.f;
            KV KA, KB;
            SCAN_LOADK(KA, 0);
            for (int t = 0; t < ns; t += 2) {
                SCAN_LOADK(KB, t + 1);
                SCAN_STEP(KA, t);
                SCAN_LOADK(KA, t + 2);
                SCAN_STEP(KB, t + 1);
            }
            py0 = red16(py0); py1 = red16(py1);
            *(LAS f32x2*)(lds + ya + (ns - 1) * 256) = (f32x2){py0, py1};
        }
        if (C.last) { float* op = a.out + (C.kind == 0 ? O_WKVP : O_WKVS) + (((size_t)C.seq * NH + C.h) * 64 + srow) * 64 + 4 * kq; *(f32x4*)op = S0; *(f32x4*)(op + 64) = S1; }
        __syncthreads();
        if (pt < C.nsteps) {
            const f32x4 y = *(const LAS f32x4*)(ybuf + pt * 64 + 4 * kq);
            const float mean = red16((y[0] + y[1]) + (y[2] + y[3])) * (1.0f / 64.0f); const f32x4 d = y - mean; const float var = red16(dot4(d, d)) * (1.0f / 64.0f);
            const f32x4 xv = *(const LAS f32x4*)(inb + pt * IN_STRIDE + 1280 + kq * 16);
            const f32x4 gt = unpack4(gcur);
            const f32x4 yn = d * rsqrtf(var + GN_EPS) * gwc + gbc + xv * rkbuf[pt];
            f32x4 o;
#pragma unroll
            for (int i = 0; i < 4; ++i) o[i] = yn[i] * (gt[i] * frcp(1.0f + __expf(-gt[i])));
            u32x2 w; w.x = pk2(o[0], o[1]); w.y = pk2(o[2], o[3]);
            *(u32x2*)(Y + (size_t)(C.row0 + pt) * D + C.h * 64 + 4 * kq) = w;
        }
        if (haveN) SCAN_PROCESS(CN, lds + ((j + 1) & 1) * IN_BYTES);
        __syncthreads();
        if (!haveN) break;
        C = CN; ++j; if (C.first) { S0 = N0; S1 = N1; }
    }
#undef SCAN_PREFETCH
#undef SCAN_LOADS0
#undef SCAN_PROCESS
#undef SCAN_LOADK
#undef SCAN_STEP
}
}


namespace cscan {
constexpr int CB = 14336, CB_PT0 = 0, CB_PT1 = 1024, CB_RT0 = 2048, CB_RT1 = 3072, CB_NM = 4096, CB_BK = 5120, CB_QT = 9216, CB_V = 9728, CB_GAM = 11776, CB_RK = 12032, CB_GATE = 12288;
constexpr int NCH = 128, IMG = 144;
constexpr int A_AT = 0, A_BT = 2304, A_KT = 4608, A_RT = 6912, A_NS = 9216, A_MK = 10240, A_TS = 11264, A_PS = 12288, A_WAVE = 14592;
static_assert(8 * A_WAVE <= 131072, "chunk_pre LDS map");
constexpr int RING = 7, DEPTH = 5, YB_OFF = RING * CB, YB_SZ = 8704;
static_assert(YB_OFF + 2 * YB_SZ <= 131072, "chunk_scan LDS map");

__device__ __forceinline__ int kpos(int k) { const int s = k >> 5, kk = k & 31; return s * 32 + ((kk & 15) >> 2) * 8 + (kk & 3) + ((kk >> 4) << 2); }
__device__ __forceinline__ float wsum64(float x) {
    x = scan::red16(x); const int xi = __builtin_bit_cast(int, x);
    const float s0 = __builtin_bit_cast(float, __builtin_amdgcn_readlane(xi, 0)), s1 = __builtin_bit_cast(float, __builtin_amdgcn_readlane(xi, 16)),
                s2 = __builtin_bit_cast(float, __builtin_amdgcn_readlane(xi, 32)), s3 = __builtin_bit_cast(float, __builtin_amdgcn_readlane(xi, 48));
    return (s0 + s1) + (s2 + s3);
}
__device__ __forceinline__ float red8(float x) {
    x += __builtin_bit_cast(float, __builtin_amdgcn_update_dpp(0, __builtin_bit_cast(int, x), 0xB1, 0xF, 0xF, true));
    x += __builtin_bit_cast(float, __builtin_amdgcn_update_dpp(0, __builtin_bit_cast(int, x), 0x4E, 0xF, 0xF, true));
    x += __builtin_bit_cast(float, __builtin_amdgcn_update_dpp(0, __builtin_bit_cast(int, x), 0x141, 0xF, 0xF, true));
    return x;
}

constexpr int A_ATT = 6656;
constexpr int S_BK = 0, S_V = 4096, S_GAM = 6144, S_RK = 6400, S_YB = 6656;
template <bool SAMPLE>
__device__ __forceinline__ void chunk_pre(const Args& a, LAS unsigned char* wl, int task, int lane) {
    const int h = SAMPLE ? (task & 31) : ((task >> 7) & 31), c = SAMPLE ? 1 : (task & 127), k = lane, col = h * 64 + k, vc = lane & 15, g = lane >> 4;
    const size_t row0 = SAMPLE ? (size_t)M_P + (size_t)(task >> 5) * TS : (size_t)(task >> 12) * TP + 16 * c;
    constexpr int NT = SAMPLE ? 8 : 16;
    const bf16_t* Z = (const bf16_t*)(a.ws + WS_Z); const bf16_t* DW = (const bf16_t*)(a.ws + WS_DW); const bf16_t* AA = (const bf16_t*)(a.ws + WS_AA);
    unsigned char* blk = a.ws + WS_CB + (size_t)task * CB;
    const float mur = a.in[7][col], muk = a.in[7][2048 + col], muv = a.in[7][4096 + col], kkc = a.in[12][col], kac = a.in[13][col], rkc = a.in[14][col];
    unsigned short zr[17], zk[17], zv[17], dw[16], aa[16];
    u32x4 tg[2];
    { const int rr = lane >> 3, ch8 = (lane & 7) * 8;
      u32x4 tz[3][3], td[2][2];
#pragma unroll
      for (int i = 0; i < 3; ++i) { const int r = rr + 8 * i; const bool ok = SAMPLE ? (r >= 1 && r <= 8) : ((r < 17) && !(c == 0 && r == 0)); const size_t row = row0 + (size_t)(ok ? r : 1) - 1;
          const bf16_t* zp = Z + row * LDZ + h * 64 + ch8;
#pragma unroll
          for (int m3 = 0; m3 < 3; ++m3) { tz[m3][i] = *(const u32x4*)(zp + 2048 * m3); if (!ok) tz[m3][i] = (u32x4){0u, 0u, 0u, 0u}; } }
      if (SAMPLE && rr == 0) {
          const float* sp = a.in[3] + (size_t)(task >> 5) * SHIFT_W + h * 64 + ch8;
#pragma unroll
          for (int m3 = 0; m3 < 3; ++m3) { const f32x4 lo = *(const f32x4*)(sp + 2048 * m3), hi = *(const f32x4*)(sp + 2048 * m3 + 4);
              tz[m3][0] = (u32x4){pk2(lo[0], lo[1]), pk2(lo[2], lo[3]), pk2(hi[0], hi[1]), pk2(hi[2], hi[3])}; } }
#pragma unroll
      for (int i = 0; i < 2; ++i) { const size_t row = row0 + rr + (SAMPLE ? 0 : 8 * i); td[0][i] = *(const u32x4*)(DW + row * RW + h * 64 + ch8); td[1][i] = *(const u32x4*)(AA + row * RW + h * 64 + ch8);
          if (SAMPLE && i == 0) tg[0] = *(const u32x4*)(Z + row * LDZ + OFF_GR + h * 64 + ch8); }
#pragma unroll
      for (int i = 0; i < 3; ++i) { const int r = rr + 8 * i; if (r < 17) {
#pragma unroll
          for (int m3 = 0; m3 < 3; ++m3) *(LAS u32x4*)(wl + m3 * 2176 + r * 128 + ch8 * 2) = tz[m3][i]; } }
#pragma unroll
      for (int i = 0; i < 2; ++i) { const int r = rr + 8 * i; *(LAS u32x4*)(wl + 6528 + r * 128 + ch8 * 2) = td[0][i]; *(LAS u32x4*)(wl + 8576 + r * 128 + ch8 * 2) = td[1][i];
          }
      LDS_WAIT();
#pragma unroll
      for (int t = 0; t < NT + 1; ++t) { zr[t] = *(const LAS unsigned short*)(wl + t * 128 + 2 * k); zk[t] = *(const LAS unsigned short*)(wl + 2176 + t * 128 + 2 * k); zv[t] = *(const LAS unsigned short*)(wl + 4352 + t * 128 + 2 * k); }
#pragma unroll
      for (int t = 0; t < NT; ++t) { dw[t] = *(const LAS unsigned short*)(wl + 6528 + t * 128 + 2 * k); aa[t] = *(const LAS unsigned short*)(wl + 8576 + t * 128 + 2 * k); }
      LDS_WAIT(); }
    const int kp2 = 2 * kpos(k);
    float al[16], be[16], kt[16]; unsigned xvp[8]; float cum = 0.f, rkv = 0.f, ecl = 1.0f;
#pragma unroll
    for (int t = 0; t < NT; ++t) {
        const float z_r = bf2f(zr[t + 1]), z_k = bf2f(zk[t + 1]), z_v = bf2f(zv[t + 1]), p_r = bf2f(zr[t]), p_k = bf2f(zk[t]), p_v = bf2f(zv[t]);
        const float xr = z_r + mur * (p_r - z_r), xk = z_k + muk * (p_k - z_k), xv = z_v + muv * (p_v - z_v), av = bf2f(aa[t]);
        const float kkv = xk * kkc, ss = wsum64(kkv * kkv), kkn = kkv * __builtin_amdgcn_rsqf(fmaxf(ss, 1e-24f));
        const float kh = xk * (1.0f + (av - 1.0f) * kac), rkt = wsum64(xr * kh * rkc);
        rkv = (lane == t) ? rkt : rkv;
        const float ecp = ecl; cum += bf2f(dw[t]); const float ec = __expf(cum), eci = frcp(ec); ecl = ec;
        al[t] = -kkn * ecp; be[t] = kkn * av * eci; kt[t] = kh * eci;
        *(LAS unsigned short*)(wl + A_AT + t * IMG + kp2) = (unsigned short)f2bf(al[t]);
        *(LAS unsigned short*)(wl + A_BT + t * IMG + kp2) = (unsigned short)f2bf(be[t]);
        *(LAS unsigned short*)(wl + A_KT + t * IMG + kp2) = (unsigned short)f2bf(kt[t]);
        *(LAS unsigned short*)(wl + A_RT + t * IMG + kp2) = (unsigned short)f2bf(xr * ec);
        if (t & 1) xvp[t >> 1] |= f2bf(xv) << 16; else xvp[t >> 1] = f2bf(xv);
    }
    if (SAMPLE) {
#pragma unroll
        for (int t = NT; t < 16; ++t) { al[t] = 0.f; be[t] = 0.f; kt[t] = 0.f; if (!(t & 1)) xvp[t >> 1] = 0u;
            *(LAS unsigned short*)(wl + A_AT + t * IMG + kp2) = 0; *(LAS unsigned short*)(wl + A_BT + t * IMG + kp2) = 0; *(LAS unsigned short*)(wl + A_KT + t * IMG + kp2) = 0; *(LAS unsigned short*)(wl + A_RT + t * IMG + kp2) = 0; } }
    const float eL = ecl;
    u32x4 w4[4];
#pragma unroll
    for (int gg = 0; gg < 4; ++gg) { w4[gg].x = pk2(be[4 * gg] * eL, be[4 * gg + 1] * eL); w4[gg].y = pk2(be[4 * gg + 2] * eL, be[4 * gg + 3] * eL); w4[gg].z = pk2(kt[4 * gg] * eL, kt[4 * gg + 1] * eL); w4[gg].w = pk2(kt[4 * gg + 2] * eL, kt[4 * gg + 3] * eL); }
    if (!SAMPLE) { *(float*)(blk + CB_GAM + 4 * k) = eL; if (lane < 16) *(float*)(blk + CB_RK + 4 * lane) = rkv; }
    LDS_WAIT();
    f32x4 gN = (f32x4){0.f, 0.f, 0.f, 0.f}, gMk = gN, gNr = gN, gMkr = gN;
    bf16x8 frs[2];
#pragma unroll
    for (int sK = 0; sK < 2; ++sK) { const int fo = vc * IMG + sK * 64 + g * 16;
        const bf16x8 fa = *(const LAS bf16x8*)(wl + A_AT + fo), fb = *(const LAS bf16x8*)(wl + A_BT + fo), fk = *(const LAS bf16x8*)(wl + A_KT + fo), fr = *(const LAS bf16x8*)(wl + A_RT + fo);
        gN = __builtin_amdgcn_mfma_f32_16x16x32_bf16(fb, fa, gN, 0, 0, 0); gMk = __builtin_amdgcn_mfma_f32_16x16x32_bf16(fk, fa, gMk, 0, 0, 0);
        gNr = __builtin_amdgcn_mfma_f32_16x16x32_bf16(fb, fr, gNr, 0, 0, 0); gMkr = __builtin_amdgcn_mfma_f32_16x16x32_bf16(fk, fr, gMkr, 0, 0, 0);
        frs[sK] = fr;
        if (!SAMPLE) __builtin_nontemporal_store(__builtin_bit_cast(u32x4, fr), (u32x4*)(blk + CB_RT0 + sK * 1024 + vc * 64 + g * 16)); }
    { u32x4 lo_, hi_; lo_.x = pk2(al[0], al[1]); lo_.y = pk2(al[2], al[3]); lo_.z = pk2(al[4], al[5]); lo_.w = pk2(al[6], al[7]); hi_.x = pk2(al[8], al[9]); hi_.y = pk2(al[10], al[11]); hi_.z = pk2(al[12], al[13]); hi_.w = pk2(al[14], al[15]);
      *(LAS u32x4*)(wl + A_ATT + k * 32) = lo_; *(LAS u32x4*)(wl + A_ATT + k * 32 + 16) = hi_; }
    {
        LDS_WAIT();
#pragma unroll
        for (int gg = 0; gg < 4; ++gg) *(LAS u32x4*)(wl + S_BK + k * 64 + gg * 16) = w4[gg];
        *(LAS u32x4*)(wl + S_V + (k >> 4) * 512 + (k & 15) * 32) = (u32x4){xvp[0], xvp[1], xvp[2], xvp[3]}; *(LAS u32x4*)(wl + S_V + (k >> 4) * 512 + (k & 15) * 32 + 16) = (u32x4){xvp[4], xvp[5], xvp[6], xvp[7]};
        if (SAMPLE) { *(LAS float*)(wl + S_GAM + 4 * k) = eL; if (lane < 16) *(LAS float*)(wl + S_RK + 4 * lane) = rkv; }
        else { LDS_WAIT();
#pragma unroll
            for (int q = 0; q < 4; ++q) __builtin_nontemporal_store(*(const LAS u32x4*)(wl + S_BK + q * 1024 + lane * 16), (u32x4*)(blk + CB_BK + q * 1024 + lane * 16));
#pragma unroll
            for (int q = 0; q < 2; ++q) __builtin_nontemporal_store(*(const LAS u32x4*)(wl + S_V + q * 1024 + lane * 16), (u32x4*)(blk + CB_V + q * 1024 + lane * 16)); }
    }
#pragma unroll
    for (int r = 0; r < 4; ++r) { const int i = 4 * g + r; gN[r] = (i < vc) ? gN[r] : 0.f; gMk[r] = (i < vc) ? gMk[r] : 0.f; gNr[r] = (i <= vc) ? gNr[r] : 0.f; gMkr[r] = (i <= vc) ? gMkr[r] : 0.f;
        ((LAS float*)(wl + A_NS))[i * 16 + vc] = gN[r]; ((LAS float*)(wl + A_MK))[i * 16 + vc] = gMk[r]; }
    u32x4 nmw; nmw.x = pk2(gNr[0], gNr[1]); nmw.y = pk2(gNr[2], gNr[3]); nmw.z = pk2(gMkr[0], gMkr[1]); nmw.w = pk2(gMkr[2], gMkr[3]);
    if (!SAMPLE) __builtin_nontemporal_store(nmw, (u32x4*)(blk + CB_NM + vc * 64 + g * 16));
    LDS_WAIT();
    float Tc[16];
#pragma unroll
    for (int i = 15; i >= 0; --i) { float acc = (i == vc) ? 1.0f : 0.0f;
#pragma unroll
        for (int m = i + 1; m < 16; ++m) acc += ((const LAS float*)(wl + A_NS))[i * 16 + m] * Tc[m];
        Tc[i] = acc; }
    bf16x8 tfr;
    { float tb[8];
#pragma unroll
      for (int j = 0; j < 8; ++j) tb[j] = (g == 0) ? Tc[j] : ((g == 1) ? Tc[8 + j] : 0.f);
      const u32x4 w_ = (u32x4){pk2(tb[0], tb[1]), pk2(tb[2], tb[3]), pk2(tb[4], tb[5]), pk2(tb[6], tb[7])}; tfr = __builtin_bit_cast(bf16x8, w_); }
    u32x2 qw;
    { const LAS float* mp = (const LAS float*)(wl + A_MK) + vc * 16 + 8 * (g & 1); const f32x4 m0 = *(const LAS f32x4*)mp, m1 = *(const LAS f32x4*)(mp + 4);
      const u32x4 w_ = (u32x4){pk2(m0[0], m0[1]), pk2(m0[2], m0[3]), pk2(m1[0], m1[1]), pk2(m1[2], m1[3])};
      const f32x4 qd = __builtin_amdgcn_mfma_f32_16x16x32_bf16(__builtin_bit_cast(bf16x8, w_), tfr, (f32x4){0.f, 0.f, 0.f, 0.f}, 0, 0, 0);
      qw = (u32x2){pk2(qd[0], qd[1]), pk2(qd[2], qd[3])};
      if (!SAMPLE) *(u32x2*)(blk + CB_QT + vc * 32 + g * 8) = qw; }
#pragma unroll
    for (int kb = 0; kb < 4; ++kb) { const bf16x8 af = *(const LAS bf16x8*)(wl + A_ATT + (16 * kb + vc) * 32 + (g & 1) * 16);
        const f32x4 pd = __builtin_amdgcn_mfma_f32_16x16x32_bf16(af, tfr, (f32x4){0.f, 0.f, 0.f, 0.f}, 0, 0, 0);
        *(LAS u32x2*)(wl + A_PS + vc * IMG + 2 * (32 * (kb >> 1) + 8 * g + 4 * (kb & 1))) = (u32x2){pk2(pd[0], pd[1]), pk2(pd[2], pd[3])}; }
    LDS_WAIT();
    if (!SAMPLE) {
#pragma unroll
        for (int sK = 0; sK < 2; ++sK) __builtin_nontemporal_store(*(const LAS u32x4*)(wl + A_PS + vc * IMG + sK * 64 + g * 16), (u32x4*)(blk + CB_PT0 + sK * 1024 + vc * 64 + g * 16));
        LDS_WAIT();
    } else {
        const int fo = vc * IMG + g * 16;
        const bf16x8 pt0 = *(const LAS bf16x8*)(wl + A_PS + fo), pt1 = *(const LAS bf16x8*)(wl + A_PS + fo + 64), nm = __builtin_bit_cast(bf16x8, nmw);
        const f32x4 rk4 = *(const LAS f32x4*)(wl + S_RK + 16 * g);
        bf16x8 qt;
        { const s16x4 qt4 = __builtin_bit_cast(s16x4, qw);
#pragma unroll
          for (int jj = 0; jj < 4; ++jj) { qt[jj] = qt4[jj]; qt[4 + jj] = 0; } }
        bf16x8 bk[4]; f32x4 gm[4];
#pragma unroll
        for (int kb = 0; kb < 4; ++kb) { bk[kb] = *(const LAS bf16x8*)(wl + S_BK + (16 * kb + vc) * 64 + g * 16); gm[kb] = *(const LAS f32x4*)(wl + S_GAM + (16 * kb + 4 * g) * 4); }
        float* op = a.out + O_WKVS + ((size_t)task * 64 + vc) * 64 + 4 * g;
        const float* sp = a.in[2] + ((size_t)task * 64 + vc) * 64 + 4 * g;
        LAS float* yb = (LAS float*)(wl + S_YB);
        f32x4 St[4][4];
#pragma unroll
        for (int wv = 0; wv < 4; ++wv)
#pragma unroll
            for (int kb = 0; kb < 4; ++kb) St[wv][kb] = *(const f32x4*)(sp + (size_t)wv * 1024 + 16 * kb);
#pragma unroll
        for (int wv = 0; wv < 4; ++wv) {
            const s16x4 vw4 = *(const LAS s16x4*)(wl + S_V + wv * 512 + vc * 32 + g * 8);
            bf16x8 vv, sf0, sf1, uv;
#pragma unroll
            for (int jj = 0; jj < 4; ++jj) { vv[jj] = vw4[jj]; vv[4 + jj] = vw4[jj]; }
            { u32x4 w_; w_.x = pk2(St[wv][0][0], St[wv][0][1]); w_.y = pk2(St[wv][0][2], St[wv][0][3]); w_.z = pk2(St[wv][1][0], St[wv][1][1]); w_.w = pk2(St[wv][1][2], St[wv][1][3]); sf0 = __builtin_bit_cast(bf16x8, w_);
              w_.x = pk2(St[wv][2][0], St[wv][2][1]); w_.y = pk2(St[wv][2][2], St[wv][2][3]); w_.z = pk2(St[wv][3][0], St[wv][3][1]); w_.w = pk2(St[wv][3][2], St[wv][3][3]); sf1 = __builtin_bit_cast(bf16x8, w_); }
            f32x4 ut = (f32x4){0.f, 0.f, 0.f, 0.f}, y0 = ut;
            ut = __builtin_amdgcn_mfma_f32_16x16x32_bf16(pt0, sf0, ut, 0, 0, 0); y0 = __builtin_amdgcn_mfma_f32_16x16x32_bf16(frs[0], sf0, y0, 0, 0, 0);
            ut = __builtin_amdgcn_mfma_f32_16x16x32_bf16(pt1, sf1, ut, 0, 0, 0); y0 = __builtin_amdgcn_mfma_f32_16x16x32_bf16(frs[1], sf1, y0, 0, 0, 0);
            ut = __builtin_amdgcn_mfma_f32_16x16x32_bf16(qt, vv, ut, 0, 0, 0);
#pragma unroll
            for (int jj = 0; jj < 4; ++jj) uv[4 + jj] = vw4[jj];
            { const unsigned u0_ = pk2(ut[0], ut[1]), u1_ = pk2(ut[2], ut[3]); uv[0] = (short)(u0_ & 0xffffu); uv[1] = (short)(u0_ >> 16); uv[2] = (short)(u1_ & 0xffffu); uv[3] = (short)(u1_ >> 16); }
            const f32x4 yt = __builtin_amdgcn_mfma_f32_16x16x32_bf16(nm, uv, y0, 0, 0, 0);
#pragma unroll
            for (int kb = 0; kb < 4; ++kb) { const f32x4 sn = __builtin_amdgcn_mfma_f32_16x16x32_bf16(bk[kb], uv, St[wv][kb] * gm[kb], 0, 0, 0); *(f32x4*)(op + (size_t)wv * 1024 + 16 * kb) = sn; }
            if (g < 2) {
#pragma unroll
                for (int r = 0; r < 4; ++r) { yb[(4 * g + r) * 68 + 16 * wv + vc] = yt[r]; yb[544 + (4 * g + r) * 68 + 16 * wv + vc] = rk4[r] * bfs2f(vw4[r]); } }
        }
        LDS_WAIT();
        { const int pt = lane >> 3, vo = lane & 7;
          const float* gwp = a.in[15] + h * 64 + 8 * vo; const float* gbp = a.in[16] + h * 64 + 8 * vo;
          const f32x4 gw0 = *(const f32x4*)gwp, gw1 = *(const f32x4*)(gwp + 4), gb0 = *(const f32x4*)gbp, gb1 = *(const f32x4*)(gbp + 4);
          const LAS float* yp = yb + pt * 68 + 8 * vo;
          const f32x4 y0_ = *(const LAS f32x4*)yp, y1_ = *(const LAS f32x4*)(yp + 4), b0_ = *(const LAS f32x4*)(yp + 544), b1_ = *(const LAS f32x4*)(yp + 548);
          const bf16x8 gt_ = __builtin_bit_cast(bf16x8, tg[0]);
          const float mean_ = red8(((y0_[0] + y0_[1]) + (y0_[2] + y0_[3])) + ((y1_[0] + y1_[1]) + (y1_[2] + y1_[3]))) * (1.0f / 64.0f);
          const f32x4 d0_ = y0_ - mean_, d1_ = y1_ - mean_;
          const float var_ = red8(scan::dot4(d0_, d0_) + scan::dot4(d1_, d1_)) * (1.0f / 64.0f); const float rs_ = rsqrtf(var_ + GN_EPS);
          const f32x4 n0_ = d0_ * rs_ * gw0 + gb0 + b0_, n1_ = d1_ * rs_ * gw1 + gb1 + b1_; float o_[8];
#pragma unroll
          for (int i_ = 0; i_ < 4; ++i_) { const float ga_ = bfs2f(gt_[i_]), gb_ = bfs2f(gt_[4 + i_]); o_[i_] = n0_[i_] * (ga_ * frcp(1.0f + __expf(-ga_))); o_[4 + i_] = n1_[i_] * (gb_ * frcp(1.0f + __expf(-gb_))); }
          *(u32x2*)(a.ws + WS_Y + (row0 + pt) * D + h * 64 + 8 * vo) = (u32x2){pk4_fp8(o_[0], o_[1], o_[2], o_[3]), pk4_fp8(o_[4], o_[5], o_[6], o_[7])}; }
        LDS_WAIT();
    }
}

struct CFrag { bf16x8 pt0, pt1, rt0, rt1, nm, bk0, bk1, bk2, bk3; s16x4 qt4, vw4; f32x4 rk4, gm0, gm1, gm2, gm3; };
__device__ __forceinline__ void chunk_scan(const Args& a, LAS unsigned char* lds, const int tid, const int p) {
    const int wave = __builtin_amdgcn_readfirstlane(tid >> 6), lane = tid & 63, vc = lane & 15, g = lane >> 4;
    const int b = p >> 5, h = p & 31;
    const unsigned char* gblk = a.ws + WS_CB + (size_t)p * NCH * CB;
    bf16_t* Y = (bf16_t*)(a.ws + WS_Y);
#define CS_BAR() do { asm volatile("s_waitcnt lgkmcnt(0)" ::: "memory"); __builtin_amdgcn_s_barrier(); asm volatile("" ::: "memory"); } while (0)
    const unsigned char* zgt = a.ws + WS_Z + (((size_t)b * TP + (lane >> 3)) * LDZ + OFF_GR + h * 64) * 2 + (lane & 7) * 16;
#define CS_ISSUE(blkidx, slot) do { _Pragma("unroll") for (int q_ = 0; q_ < 4; ++q_) { int pc_ = (wave & 3) * 4 + q_; pc_ = (pc_ >= 14) ? pc_ - 2 : pc_; \
        const unsigned char* src_ = (pc_ < 12) ? gblk + (size_t)(blkidx) * CB + pc_ * 1024 + lane * 16 : zgt + ((size_t)(blkidx) * 16 + (pc_ - 12) * 8) * LDZ * 2; \
        __builtin_amdgcn_global_load_lds((const unsigned*)src_, (LAS unsigned*)(lds + (slot) * CB + pc_ * 1024), 16, 0, 0); } } while (0)
    f32x4 St[4];
#pragma unroll
    for (int kb = 0; kb < 4; ++kb) St[kb] = (f32x4){0.f, 0.f, 0.f, 0.f};
    const int lt = tid - 256, pt = (lt >> 4) & 15, vo = lt & 15;
    const f32x4 gw0 = *(const f32x4*)(a.in[15] + h * 64 + 4 * vo), gb0 = *(const f32x4*)(a.in[16] + h * 64 + 4 * vo);
    asm volatile("s_waitcnt vmcnt(0)" ::: "memory");
    if (wave < 4) {
#pragma unroll
        for (int i = 0; i < DEPTH; ++i) CS_ISSUE(i, i);
        asm volatile("s_waitcnt vmcnt(12)" ::: "memory");
    }
    CS_BAR();
    int slot = 0, islot = DEPTH;
#define CS_POST(cc, sl) do { const LAS float* yb_ = (const LAS float*)(lds + YB_OFF + ((cc) & 1) * YB_SZ) + pt * 68 + 4 * vo; \
        const f32x4 y0_ = *(const LAS f32x4*)yb_, b0_ = *(const LAS f32x4*)(yb_ + 1088); \
        const s16x4 gt_ = *(const LAS s16x4*)(lds + (sl) * CB + CB_GATE + pt * 128 + vo * 8); \
        const float mean_ = scan::red16((y0_[0] + y0_[1]) + (y0_[2] + y0_[3])) * (1.0f / 64.0f); \
        const f32x4 d0_ = y0_ - mean_; \
        const float var_ = scan::red16(scan::dot4(d0_, d0_)) * (1.0f / 64.0f); const float rs_ = rsqrtf(var_ + GN_EPS); \
        const f32x4 n0_ = d0_ * rs_ * gw0 + gb0 + b0_; float o_[4]; \
        _Pragma("unroll") for (int i_ = 0; i_ < 4; ++i_) { const float ga_ = bfs2f(gt_[i_]); o_[i_] = n0_[i_] * (ga_ * frcp(1.0f + __expf(-ga_))); } \
        *(unsigned*)((unsigned char*)Y + ((size_t)b * TP + 16 * (cc) + pt) * D + h * 64 + 4 * vo) = pk4_fp8(o_[0], o_[1], o_[2], o_[3]); } while (0)
    const int fo = vc * 64 + g * 16;
#define CS_LOADF(F, sl) do { const LAS unsigned char* sb_ = lds + (sl) * CB; \
        F.pt0 = *(const LAS bf16x8*)(sb_ + CB_PT0 + fo); F.pt1 = *(const LAS bf16x8*)(sb_ + CB_PT1 + fo); F.rt0 = *(const LAS bf16x8*)(sb_ + CB_RT0 + fo); F.rt1 = *(const LAS bf16x8*)(sb_ + CB_RT1 + fo); F.nm = *(const LAS bf16x8*)(sb_ + CB_NM + fo); \
        F.qt4 = *(const LAS s16x4*)(sb_ + CB_QT + vc * 32 + g * 8); F.vw4 = *(const LAS s16x4*)(sb_ + CB_V + wave * 512 + vc * 32 + g * 8); F.rk4 = *(const LAS f32x4*)(sb_ + CB_RK + 16 * g); \
        F.bk0 = *(const LAS bf16x8*)(sb_ + CB_BK + fo); F.bk1 = *(const LAS bf16x8*)(sb_ + CB_BK + 1024 + fo); F.bk2 = *(const LAS bf16x8*)(sb_ + CB_BK + 2048 + fo); F.bk3 = *(const LAS bf16x8*)(sb_ + CB_BK + 3072 + fo); \
        F.gm0 = *(const LAS f32x4*)(sb_ + CB_GAM + (4 * g) * 4); F.gm1 = *(const LAS f32x4*)(sb_ + CB_GAM + (16 + 4 * g) * 4); F.gm2 = *(const LAS f32x4*)(sb_ + CB_GAM + (32 + 4 * g) * 4); F.gm3 = *(const LAS f32x4*)(sb_ + CB_GAM + (48 + 4 * g) * 4); } while (0)
#define CS_COMPUTE(F, cc) do { bf16x8 qt, vv, sf0, sf1, uv; \
        _Pragma("unroll") for (int jj = 0; jj < 4; ++jj) { qt[jj] = F.qt4[jj]; qt[4 + jj] = 0; vv[jj] = F.vw4[jj]; vv[4 + jj] = F.vw4[jj]; } \
        { u32x4 w_; w_.x = pk2(St[0][0], St[0][1]); w_.y = pk2(St[0][2], St[0][3]); w_.z = pk2(St[1][0], St[1][1]); w_.w = pk2(St[1][2], St[1][3]); sf0 = __builtin_bit_cast(bf16x8, w_); \
          w_.x = pk2(St[2][0], St[2][1]); w_.y = pk2(St[2][2], St[2][3]); w_.z = pk2(St[3][0], St[3][1]); w_.w = pk2(St[3][2], St[3][3]); sf1 = __builtin_bit_cast(bf16x8, w_); } \
        f32x4 ut = (f32x4){0.f, 0.f, 0.f, 0.f}, y0 = ut; \
        ut = __builtin_amdgcn_mfma_f32_16x16x32_bf16(F.pt0, sf0, ut, 0, 0, 0); y0 = __builtin_amdgcn_mfma_f32_16x16x32_bf16(F.rt0, sf0, y0, 0, 0, 0); \
        ut = __builtin_amdgcn_mfma_f32_16x16x32_bf16(F.pt1, sf1, ut, 0, 0, 0); y0 = __builtin_amdgcn_mfma_f32_16x16x32_bf16(F.rt1, sf1, y0, 0, 0, 0); \
        ut = __builtin_amdgcn_mfma_f32_16x16x32_bf16(qt, vv, ut, 0, 0, 0); \
        _Pragma("unroll") for (int jj = 0; jj < 4; ++jj) uv[4 + jj] = F.vw4[jj]; \
        { const unsigned u0_ = pk2(ut[0], ut[1]), u1_ = pk2(ut[2], ut[3]); uv[0] = (short)(u0_ & 0xffffu); uv[1] = (short)(u0_ >> 16); uv[2] = (short)(u1_ & 0xffffu); uv[3] = (short)(u1_ >> 16); } \
        const f32x4 yt = __builtin_amdgcn_mfma_f32_16x16x32_bf16(F.nm, uv, y0, 0, 0, 0); \
        St[0] = __builtin_amdgcn_mfma_f32_16x16x32_bf16(F.bk0, uv, St[0] * F.gm0, 0, 0, 0); St[1] = __builtin_amdgcn_mfma_f32_16x16x32_bf16(F.bk1, uv, St[1] * F.gm1, 0, 0, 0); \
        St[2] = __builtin_amdgcn_mfma_f32_16x16x32_bf16(F.bk2, uv, St[2] * F.gm2, 0, 0, 0); St[3] = __builtin_amdgcn_mfma_f32_16x16x32_bf16(F.bk3, uv, St[3] * F.gm3, 0, 0, 0); \
        LAS float* yb = (LAS float*)(lds + YB_OFF + ((cc) & 1) * YB_SZ) + 16 * wave + vc; \
        _Pragma("unroll") for (int r = 0; r < 4; ++r) { yb[(4 * g + r) * 68] = yt[r]; yb[1088 + (4 * g + r) * 68] = F.rk4[r] * bfs2f(F.vw4[r]); } } while (0)
#define CS_STEP(FC, FN, cc) do { if (wave < 4) { const int s1 = (slot + 1 == RING) ? 0 : slot + 1; const int nb = ((cc) + DEPTH < NCH) ? (cc) + DEPTH : NCH - 1; \
            CS_ISSUE(nb, islot); CS_LOADF(FN, s1); CS_COMPUTE(FC, cc); \
            asm volatile("s_waitcnt vmcnt(12)" ::: "memory");             \
        } else { if ((cc) > 0) { const int ps = (slot == 0) ? RING - 1 : slot - 1; CS_POST((cc) - 1, ps); } } \
        CS_BAR(); slot = (slot + 1 == RING) ? 0 : slot + 1; islot = (islot + 1 == RING) ? 0 : islot + 1; } while (0)
    CFrag FA, FB;
    if (wave < 4) CS_LOADF(FA, 0);
    for (int c = 0; c < NCH; c += 2) { CS_STEP(FA, FB, c); CS_STEP(FB, FA, c + 1); }
#undef CS_LOADF
#undef CS_COMPUTE
#undef CS_STEP
    if (wave >= 4) { const int ps = (slot == 0) ? RING - 1 : slot - 1; CS_POST(NCH - 1, ps); }
    if (wave < 4) { float* op = a.out + O_WKVP + (((size_t)p) * 64 + 16 * wave + vc) * 64 + 4 * g;
#pragma unroll
        for (int kb = 0; kb < 4; ++kb) *(f32x4*)(op + 16 * kb) = St[kb]; }
    asm volatile("s_waitcnt vmcnt(0)" ::: "memory");
    CS_BAR();
#undef CS_BAR
#undef CS_ISSUE
#undef CS_POST
}
}

__device__ __forceinline__ void phase_ln(const Args& a, const int tid) {
    const int lane = tid & 63, wave = tid >> 6; const int gw = blockIdx.x * 8 + wave, NGW = gridDim.x * 8;
    const float* lg = a.in[21]; const float* lb = a.in[22]; const bf16_t* H = (const bf16_t*)(a.ws + WS_Y);
    f32x4 gg[16], bb[16];
#pragma unroll
    for (int q = 0; q < 16; ++q) { const int c = (lane + 64 * q) * 4; gg[q] = *(const f32x4*)(lg + c); bb[q] = *(const f32x4*)(lb + c); }
    const int rpw = (M + (int)gridDim.x - 1) / (int)gridDim.x, mbeg = (int)blockIdx.x * rpw, mend = (mbeg + rpw < M) ? mbeg + rpw : M; (void)gw; (void)NGW;
    for (int m = mbeg + wave; m < mend; m += 8) {
        const u32x2* hr = (const u32x2*)(H + (size_t)m * D) + lane; f32x4 v[16]; float s = 0.f;
#pragma unroll
        for (int q = 0; q < 16; ++q) { const u32x2 w = hr[64 * q];
            v[q] = (f32x4){__builtin_bit_cast(float, w.x << 16), __builtin_bit_cast(float, w.x & 0xffff0000u), __builtin_bit_cast(float, w.y << 16), __builtin_bit_cast(float, w.y & 0xffff0000u)}; }
#pragma unroll
        for (int q = 0; q < 16; ++q) s += (v[q][0] + v[q][1]) + (v[q][2] + v[q][3]);
        const float mean = wave_sum(s) * (1.0f / D); float s2 = 0.f;
#pragma unroll
        for (int q = 0; q < 16; ++q) { v[q] = v[q] - mean; s2 += (v[q][0] * v[q][0] + v[q][1] * v[q][1]) + (v[q][2] * v[q][2] + v[q][3] * v[q][3]); }
        const float rstd = rsqrtf(wave_sum(s2) * (1.0f / D) + LN_EPS);
        float* yr = a.out + O_Y + (size_t)m * D;
#pragma unroll
        for (int q = 0; q < 16; ++q) { const int c = (lane + 64 * q) * 4; __builtin_nontemporal_store(v[q] * rstd * gg[q] + bb[q], (f32x4*)(yr + c)); }
    }
}

#define XB_TMO      128
#define XB_XCNT(j)  (256  + 64 * (j))
#define XB_XSUB(j)  (1280 + 64 * (j))
#define XB_XGEN(j)  (2304 + 64 * (j))
#define XB_TOP      3328
#define XB_TOPGEN   3392
#define XCD_BAR_WORDS 3456
#define XB_SPIN_CAP (1u << 20)
__device__ __forceinline__ unsigned xb_ld(unsigned* p)              { return __hip_atomic_load(p, __ATOMIC_RELAXED, __HIP_MEMORY_SCOPE_AGENT); }
__device__ __forceinline__ unsigned xb_add(unsigned* p, unsigned v) { return __hip_atomic_fetch_add(p, v, __ATOMIC_RELAXED, __HIP_MEMORY_SCOPE_AGENT); }
__device__ __forceinline__ unsigned xb_xcc_id() { return (unsigned)__builtin_amdgcn_s_getreg((3 << 11) | 20) & 0xFu; }
#define XB_SPIN(cond, bar) do { unsigned _sp = 0; while (cond) { __builtin_amdgcn_s_sleep(1); \
    if ((++_sp & 255u) == 0u) { if (xb_ld(&(bar)[XB_TMO])) break; if (_sp > XB_SPIN_CAP) { atomicAdd(&(bar)[XB_TMO], 1u); break; } } } } while (0)
struct XcdBarrier { unsigned* bar; unsigned x; volatile LAS unsigned* st; };
__device__ __forceinline__ XcdBarrier xcd_barrier_post(unsigned* bar, volatile LAS unsigned* st, int tid) {
    XcdBarrier b; b.bar = bar; b.x = xb_xcc_id(); b.st = st;
    if (tid == 0) (void)xb_add(&bar[XB_XCNT(b.x)], 1u);
    return b;
}
__device__ __forceinline__ void xcd_barrier_complete(unsigned* bar, unsigned x, unsigned& nloc, unsigned& nx) {
    const unsigned G = gridDim.x * gridDim.y * gridDim.z;
    unsigned sum, cnt, mine, sp = 0u;
    for (;;) {
        sum = 0u; cnt = 0u; mine = 0u;
#pragma unroll
        for (unsigned j = 0; j < 16; ++j) { const unsigned c = xb_ld(&bar[XB_XCNT(j)]); sum += c; cnt += (c > 0u) ? 1u : 0u; mine = (j == x) ? c : mine; }
        if (sum == G) break;
        __builtin_amdgcn_s_sleep(1);
        if ((++sp & 255u) == 0u) { if (xb_ld(&bar[XB_TMO])) break; if (sp > XB_SPIN_CAP) { atomicAdd(&bar[XB_TMO], 1u); break; } }
    }
    nloc = mine > 0u ? mine : 1u; nx = cnt > 0u ? cnt : 1u;
}
__device__ __forceinline__ void xcd_barrier(const XcdBarrier& b, int tid) {
    asm volatile("s_waitcnt vmcnt(0)" ::: "memory");
    __syncthreads();
    if (tid == 0) {
        unsigned* bar = b.bar;
        __builtin_amdgcn_s_waitcnt(0);
        unsigned nloc = b.st[0], nx = b.st[1];
        if (nloc == 0u) { xcd_barrier_complete(bar, b.x, nloc, nx); b.st[0] = nloc; b.st[1] = nx; }
        const unsigned old = xb_add(&bar[XB_XSUB(b.x)], 1u);
        const unsigned gen = old / nloc;
        if (old + 1u == (gen + 1u) * nloc) {
            __builtin_amdgcn_fence(__ATOMIC_RELEASE, "agent");
            asm volatile("s_waitcnt vmcnt(0)" ::: "memory");
            const unsigned og = xb_add(&bar[XB_TOP], 1u);
            const unsigned tg = og / nx;
            if (og + 1u == (tg + 1u) * nx) xb_add(&bar[XB_TOPGEN], 1u);
            else XB_SPIN(xb_ld(&bar[XB_TOPGEN]) == tg, bar);
            __builtin_amdgcn_fence(__ATOMIC_ACQUIRE, "agent");
            xb_add(&bar[XB_XGEN(b.x)], 1u);
            asm volatile("s_waitcnt vmcnt(0)" ::: "memory");
        } else {
            XB_SPIN(xb_ld(&bar[XB_XGEN(b.x)]) == gen, bar);
            __builtin_amdgcn_fence(__ATOMIC_ACQUIRE, "agent");
            asm volatile("s_waitcnt vmcnt(0)" ::: "memory");
        }
    }
    __syncthreads();
}

template <bool COOP>
__global__ void __launch_bounds__(NTHREADS, 2) fwd_kernel(Args a) {
    extern __shared__ __attribute__((aligned(16))) unsigned char lds_raw[];
    LAS unsigned char* lds = (LAS unsigned char*)lds_raw;
    const int lo = a.ph_lo, hi = a.ph_hi;
    const int wid_s = __builtin_amdgcn_readfirstlane((int)(threadIdx.x >> 6));
#define TID() (wid_s * 64 + lane_id_opaque())
    unsigned char* ws = a.ws;
#define IN(k) (lo <= (k) && (k) < hi)
#define SEAM(k) do { if (COOP && IN(k) && IN((k) + 1)) { xcd_barrier(xbar, TID()); } } while (0)
    XcdBarrier xbar; xbar.bar = (unsigned*)(ws + WS_BAR); xbar.x = 0; xbar.st = (volatile LAS unsigned*)(lds + LDS_MISC);
    if (COOP) {
        if (a.ph_lo < 0) cg::this_grid().sync();
        if (threadIdx.x < 2) ((LAS unsigned*)(lds + LDS_MISC))[threadIdx.x] = 0u;
        __syncthreads();
        xbar = xcd_barrier_post((unsigned*)(ws + WS_BAR), (volatile LAS unsigned*)(lds + LDS_MISC), TID());
    }
    for (int rp_ = 0; rp_ < (PROBE_REP == 0 ? 2 : 1); ++rp_)
    if (IN(0)) { phase_convert(a, lds, TID()); __syncthreads(); }
    SEAM(0);
    for (int rp_ = 0; rp_ < (PROBE_REP == 1 ? 2 : 1); ++rp_)
    if (IN(1)) {
        const int G_ = (int)gridDim.x, c_ = (int)blockIdx.x; const bool full = (G_ == 256); const int cr_ = full ? ((c_ + 76) & 255) : c_;
        if (!full) { convert_rest(a, lds, TID(), c_, G_); __syncthreads(); }
        { pg8::Gemm g{(const bf16_t*)(ws + WS_XB), (const bf16_t*)(ws + WS_W1T), D, D, D / 64, 64, 64}; pg8::TileOrder S; S.init(M, N_BF, G_, c_, 1, D / 64);
          S.nextra = N_BFX / 256; S.ex_pm = M / 256; S.ex_pn0 = N_BF / 256;
          pg8::EpiZ E{(bf16_t*)(ws + WS_Z), LDZ, 17, 19, 2048, OFF_K, 0, 1.0f, ws + WS_G, 1 << 20};
          pg8::gemm_phase<pg8::EpiZ, true, true, false>(lds, g, S, E, TID()); }
        { pg8::Gemm g{(const bf16_t*)(ws + WS_XB8), (const bf16_t*)(ws + WS_W8T), D, D, D / 128, D / 128, D / 128}; pg8::TileOrder S; S.init(M, N_F8, G_, cr_, 1, D / 128);
          if (full) { S.gA = 76; S.tA = 11; S.nBt = S.nwg - 76 * 11; }
          pg8::EpiZ E{(bf16_t*)(ws + WS_Z), LDZ, 8, 24, 0, OFF_GR, OFF_GA, 1.0f / 64.0f, ws + WS_G, 32};
          pg8::gemm_phase<pg8::EpiZ, true, true, true>(lds, g, S, E, TID()); }
        if (full && cr_ >= 104) { __syncthreads(); convert_rest(a, lds, TID(), cr_ - 104, 152); }
    }
    SEAM(1);
    for (int rp_ = 0; rp_ < (PROBE_REP == 2 ? 2 : 1); ++rp_)
    if (IN(2)) {
        const int tid = TID();
        { const bf16_t* Z = (const bf16_t*)(ws + WS_Z);
          for (size_t i = (size_t)blockIdx.x * NTHREADS + tid; i < (size_t)(NB_P + NB_S) * (SHIFT_W / 8); i += (size_t)gridDim.x * NTHREADS) {
              const int r = (int)(i / (SHIFT_W / 8)), c = (int)(i % (SHIFT_W / 8)) * 8;
              const size_t zrow = (c < 2048) ? (size_t)(M + r) : ((r < NB_P) ? ((size_t)r * TP + TP - 1) : ((size_t)M_P + (size_t)(r - NB_P) * TS + TS - 1));
              float* op = (r < NB_P) ? a.out + O_SHP + (size_t)r * SHIFT_W + c : a.out + O_SHS + (size_t)(r - NB_P) * SHIFT_W + c;
              att::store8f(op, *(const bf16x8*)(Z + zrow * LDZ + c)); } }
        lora_sample(a, tid);
        if (COOP) { lora_a_panel(a, 0, tid, (int)blockIdx.x * NTHREADS + tid, (int)gridDim.x * NTHREADS, M_P * 32); VM_WAIT(); __syncthreads(); }
    }
    if (COOP && IN(2)) { xcd_barrier(xbar, TID()); }
    for (int rp_ = 0; rp_ < (PROBE_REP == 22 ? 2 : 1); ++rp_)
    if (IN(2)) {
        const int tid = TID();
        pg8::TileOrder S; S.init(M_P, 4096, gridDim.x, blockIdx.x, 1, 2); S.khalf_pn = 8;
        if (!COOP) { pg8::Unit u; int lastpm = -1; for (int i = 0; S.next(i, u); ++i) if (u.pm != lastpm) { lora_a_panel(a, u.pm, tid); lastpm = u.pm; } VM_WAIT(); __syncthreads(); }
        { pg8::Gemm g{(const bf16_t*)(ws + WS_AL), (const bf16_t*)(ws + WS_WLT), 256, 256, 4, 4, 4};
          pg8::EpiLora E{(bf16_t*)(ws + WS_DW), (bf16_t*)(ws + WS_AA), a.in[8], a.in[10]};
          pg8::gemm_phase<pg8::EpiLora, true, true>(lds, g, S, E, tid); }
    }
    SEAM(2);
    const bool full3 = ((int)gridDim.x == 256);
    for (int rp_ = 0; rp_ < (PROBE_REP == 3 ? 2 : 1); ++rp_)
    if (IN(3)) {
        const int tid = TID();
        if (!full3) for (int u = blockIdx.x; u < 256 + 512; u += gridDim.x) { if (u < 256) att::unit_prompt(a, lds, u, tid); else att::unit_sample(a, lds, u - 256, tid); }
        for (int r12 = 0; r12 < (PROBE_REP == 12 ? 2 : 1); ++r12)
        { const int wv = tid >> 6, NW = (int)gridDim.x * 8, gw = (int)blockIdx.x * 8 + wv; int tp = gw, tsm = gw;
          for (int i = gw % 5; ; ++i) { if (i >= 5) i -= 5;
              const bool hp = tp < 128 * cscan::NCH, hs = tsm < NB_S * NH; if (!hp && !hs) break;
              if (hs && (i == 4 || !hp)) { cscan::chunk_pre<true>(a, lds + wv * cscan::A_WAVE, tsm, tid & 63); tsm += NW; }
              else { cscan::chunk_pre<false>(a, lds + wv * cscan::A_WAVE, tp, tid & 63); tp += NW; } } }
        __syncthreads();
    }
    if (COOP && IN(3)) { xcd_barrier(xbar, TID()); }
    if (IN(3)) {
        const int tid = TID();
        if (full3) {
            if (blockIdx.x < 128) { for (int r13 = 0; r13 < (PROBE_REP == 13 ? 2 : 1); ++r13) cscan::chunk_scan(a, lds, tid, blockIdx.x);
                for (int u = (int)blockIdx.x; u < 384; u += 128) att::unit_sample(a, lds, u, tid); }
            else { const int j = (int)blockIdx.x - 128; for (int r10 = 0; r10 < (PROBE_REP == 10 ? 2 : 1); ++r10) { att::unit_prompt(a, lds, j, tid); att::unit_prompt(a, lds, j + 128, tid); att::unit_sample(a, lds, 384 + j, tid); } }
        } else {
            for (int p = blockIdx.x; p < 128; p += gridDim.x) cscan::chunk_scan(a, lds, tid, p);
        }
    }
    SEAM(3);
    for (int rp_ = 0; rp_ < (PROBE_REP == 4 ? 2 : 1); ++rp_)
    if (IN(4)) {
        pg8::Gemm g{(const bf16_t*)(ws + WS_Y), (const bf16_t*)(ws + WS_W2T), D / 2, D / 2, 16, 0, 32}; pg8::TileOrder S; S.init(M, D, gridDim.x, blockIdx.x, 2, 16, true, 0);
        pg8::EpiMix E{ws + WS_G, ws + WS_MIX};
        pg8::gemm_phase<pg8::EpiMix, true, true, true>(lds, g, S, E, TID());
        pg8::TileOrder S2; S2.init(M, D, gridDim.x, blockIdx.x, 2, 16, true, 1);
        pg8::EpiMixTail E2{ws + WS_G, ws + WS_MIX, pg8::TailCtx{(float*)(ws + WS_CB), (unsigned*)(ws + WS_TCNT), (volatile LAS unsigned*)(lds + LDS_MISC + 16)}};
        pg8::gemm_phase<pg8::EpiMixTail, true, true, true>(lds, g, S2, E2, TID());
    }
    SEAM(4);
    for (int rp_ = 0; rp_ < (PROBE_REP == 5 ? 2 : 1); ++rp_)
    if (IN(5)) {
        pg8::Gemm g{(const bf16_t*)(ws + WS_MIX), (const bf16_t*)(ws + WS_W3T), D / 2, D / 2, 32, 0, 32}; pg8::TileOrder S; S.init(M, D, gridDim.x, blockIdx.x, 1, 32, true, 0);
        pg8::EpiH E{a.in[0], a.in[1], (bf16_t*)(ws + WS_Y)};
        pg8::gemm_phase<pg8::EpiH, true, true, true>(lds, g, S, E, TID());
        pg8::TileOrder S2; S2.init(M, D, gridDim.x, blockIdx.x, 1, 32, true, 1);
        pg8::EpiHTail E2{a.in[0], a.in[1], (bf16_t*)(ws + WS_Y), pg8::TailCtx{(float*)(ws + WS_CB) + (size_t)64 * 4 * 65536, (unsigned*)(ws + WS_TCNT) + 1024, (volatile LAS unsigned*)(lds + LDS_MISC + 16)}};
        pg8::gemm_phase<pg8::EpiHTail, true, true, true>(lds, g, S2, E2, TID());
    }
    SEAM(5);
    if (IN(6)) { phase_ln(a, TID()); }
#undef IN
#undef SEAM
#undef TID
}

extern "C" void kernel_launch(void* const* d_in, const int* in_sizes, int n_in, void* d_out, int out_size, void* d_ws, size_t ws_size, hipStream_t stream) {
    static int grid = 0;
    if (grid == 0) {
        if (n_in != 23 || out_size != (int)O_END || ws_size < WS_END) { fprintf(stderr, "kernel_launch: unexpected shapes: n_in %d out %d ws %zu (need %zu)\n", n_in, out_size, ws_size, (size_t)WS_END); grid = -1; return; }
        int dev = 0, cus = 0, per_cu = 0;
        if (hipGetDevice(&dev) != hipSuccess || hipDeviceGetAttribute(&cus, hipDeviceAttributeMultiprocessorCount, dev) != hipSuccess) { grid = -1; return; }
        if (hipFuncSetAttribute((const void*)fwd_kernel<(MK_FUSED != 0)>, hipFuncAttributeMaxDynamicSharedMemorySize, LDS_BYTES) != hipSuccess) { fprintf(stderr, "kernel_launch: hipFuncSetAttribute failed\n"); grid = -1; return; }
        if (hipOccupancyMaxActiveBlocksPerMultiprocessor(&per_cu, (const void*)fwd_kernel<(MK_FUSED != 0)>, NTHREADS, LDS_BYTES) != hipSuccess || per_cu < 1) { fprintf(stderr, "kernel_launch: occupancy query says %d\n", per_cu); per_cu = 1; }
        (void)hipGetLastError();
        grid = cus;
    }
    if (grid < 0) return;
    Args a{};
    for (int i = 0; i < 23; ++i) a.in[i] = (const float*)d_in[i];
    a.out = (float*)d_out; a.ws = (unsigned char*)d_ws;
#if MK_FUSED
    a.ph_lo = 0; a.ph_hi = 7;
    if (hipMemsetAsync(d_ws, 0, 65536, stream) != hipSuccess) { fprintf(stderr, "kernel_launch: hipMemsetAsync of the control words failed\n"); return; }
    void* args[] = {&a};
    hipError_t e = hipLaunchCooperativeKernel((const void*)fwd_kernel<true>, dim3(grid), dim3(NTHREADS), args, LDS_BYTES, stream);
    if (e != hipSuccess) fprintf(stderr, "cooperative launch failed: %s (grid %d)\n", hipGetErrorString(e), grid);
#else
    for (int p = 0; p < 7; ++p) { a.ph_lo = p; a.ph_hi = p + 1; hipLaunchKernelGGL(fwd_kernel<false>, dim3(grid), dim3(NTHREADS), LDS_BYTES, stream, a); }
#endif
}
```
